# Optimizing an MI355X kernel written in HIP

```python
import math
import jax
import jax.numpy as jnp
from jax import lax
import numpy as np

D_MODEL = 1024
BATCH = 16
SEQ = 4096
DEPTH = 2

HEAD_DIM = 64
SB_HEADS = D_MODEL // (2 * HEAD_DIM)
MOBA_HEADS = D_MODEL // (2 * HEAD_DIM)
SB_WIDTH = SB_HEADS * HEAD_DIM
MOBA_WIDTH = MOBA_HEADS * HEAD_DIM
ATT_IN_WIDTH = 3 * SB_WIDTH + 3 * MOBA_WIDTH + SB_WIDTH + MOBA_WIDTH
ATT_OUT_WIDTH = SB_WIDTH + MOBA_WIDTH
SB_BLOCK = 128
MOBA_BLOCK = 256
MOBA_TOPK = 3
MOBA_Q_CHUNK = 16
ROPE_THETA = 500000.0
ROT_DIM = HEAD_DIM // 4
LRU_WIDTH = D_MODEL
LRU_BLOCKS = 8
LRU_BLOCK_WIDTH = LRU_WIDTH // LRU_BLOCKS
CONV_WIDTH = 4
LRU_C = 8.0
N_ATT_LAYERS = (DEPTH + 1) // 2
N_LRU_LAYERS = DEPTH // 2
EPS = 1e-6

kernel_name = "hybrid_sb_moba_rglru_adaln"


def rmsnorm(x, g):
    x32 = x.astype(jnp.float32)
    xn = x32 * lax.rsqrt(jnp.mean(x32 * x32, axis=-1, keepdims=True) + EPS)
    return xn * g.astype(jnp.float32)


def rope_partial(t, positions):
    half = ROT_DIM // 2
    inv = ROPE_THETA ** (-jnp.arange(0, ROT_DIM, 2, dtype=jnp.float32) / ROT_DIM)
    ang = positions.astype(jnp.float32)[:, None, :, None] * inv
    cos, sin = jnp.cos(ang), jnp.sin(ang)
    tr = t[..., :ROT_DIM].astype(jnp.float32)
    t1, t2 = tr[..., :half], tr[..., half:]
    rot = jnp.concatenate([t1 * cos - t2 * sin, t2 * cos + t1 * sin], axis=-1)
    return jnp.concatenate([rot.astype(t.dtype), t[..., ROT_DIM:]], axis=-1)


def stick_breaking_attention(q, k, v):
    S = q.shape[2]
    scale = HEAD_DIM ** -0.5
    outs = []
    for blk in range(S // SB_BLOCK):
        t0, t1 = blk * SB_BLOCK, (blk + 1) * SB_BLOCK
        qb = q[:, :, t0:t1].astype(jnp.float32)
        kb = k[:, :, :t1].astype(jnp.float32)
        vb = v[:, :, :t1].astype(jnp.float32)
        z = jnp.einsum('bhqd,bhkd->bhqk', qb, kb) * scale
        mask = jnp.arange(t1)[None, :] < jnp.arange(t0, t1)[:, None]
        log_1m = jnp.where(mask, jax.nn.log_sigmoid(-z), 0.0)
        later = lax.cumsum(log_1m, axis=3, reverse=True) - log_1m
        w = jnp.where(mask, jnp.exp(jax.nn.log_sigmoid(z) + later), 0.0)
        outs.append(jnp.einsum('bhqk,bhkd->bhqd', w, vb))
    return jnp.concatenate(outs, axis=2).astype(q.dtype)


def moba_attention(q, k, v):
    B, H, S, dh = q.shape
    nb = -(-S // MOBA_BLOCK)
    pad = nb * MOBA_BLOCK - S
    kp = jnp.pad(k, ((0, 0), (0, 0), (0, pad), (0, 0)))
    vp = jnp.pad(v, ((0, 0), (0, 0), (0, pad), (0, 0)))
    kb = kp.reshape(B, H, nb, MOBA_BLOCK, dh)
    vb = vp.reshape(B, H, nb, MOBA_BLOCK, dh)
    kmean = jnp.mean(kb.astype(jnp.float32), axis=3)
    gscore = jnp.einsum('bhsd,bhnd->bhsn', q.astype(jnp.float32), kmean)
    qblk = jnp.arange(S) // MOBA_BLOCK
    past = jnp.arange(nb)[None, :] < qblk[:, None]
    gscore = jnp.where(past, gscore, -jnp.inf)
    n_sel = min(MOBA_TOPK, nb)
    _, sel = lax.top_k(gscore, n_sel)
    sel_valid = sel < qblk[:, None]
    bi = jnp.arange(B)[:, None, None, None]
    hi = jnp.arange(H)[None, :, None, None]
    scale = dh ** -0.5

    def chunk(ci):
        t0 = ci * MOBA_Q_CHUNK
        qc = lax.dynamic_slice_in_dim(q, t0, MOBA_Q_CHUNK, axis=2).astype(jnp.float32)
        sel_c = lax.dynamic_slice_in_dim(sel, t0, MOBA_Q_CHUNK, axis=2)
        val_c = lax.dynamic_slice_in_dim(sel_valid, t0, MOBA_Q_CHUNK, axis=2)
        k_sel = kb[bi, hi, sel_c].astype(jnp.float32)
        v_sel = vb[bi, hi, sel_c].astype(jnp.float32)
        s_sel = jnp.einsum('bhqd,bhqnkd->bhqnk', qc, k_sel) * scale
        s_sel = jnp.where(val_c[..., None], s_sel, -jnp.inf)
        s_sel = s_sel.reshape(B, H, MOBA_Q_CHUNK, n_sel * MOBA_BLOCK)
        ob = t0 // MOBA_BLOCK
        k_own = lax.dynamic_index_in_dim(kb, ob, axis=2, keepdims=False).astype(jnp.float32)
        v_own = lax.dynamic_index_in_dim(vb, ob, axis=2, keepdims=False).astype(jnp.float32)
        s_own = jnp.einsum('bhqd,bhkd->bhqk', qc, k_own) * scale
        qpos = t0 + jnp.arange(MOBA_Q_CHUNK)
        kpos = ob * MOBA_BLOCK + jnp.arange(MOBA_BLOCK)
        s_own = jnp.where(kpos[None, :] <= qpos[:, None], s_own, -jnp.inf)
        p = jax.nn.softmax(jnp.concatenate([s_sel, s_own], axis=-1), axis=-1)
        p_sel = p[..., :n_sel * MOBA_BLOCK].reshape(B, H, MOBA_Q_CHUNK, n_sel, MOBA_BLOCK)
        p_own = p[..., n_sel * MOBA_BLOCK:]
        return (jnp.einsum('bhqnk,bhqnkd->bhqd', p_sel, v_sel)
                + jnp.einsum('bhqk,bhkd->bhqd', p_own, v_own))

    out = lax.map(chunk, jnp.arange(S // MOBA_Q_CHUNK))
    out = out.transpose(1, 2, 0, 3, 4).reshape(B, H, S, dh)
    return out.astype(q.dtype)


def attention_layer(h, positions, w_in, w_out):
    B, S, _ = h.shape
    u = h @ w_in
    cuts = np.cumsum([SB_WIDTH] * 3 + [MOBA_WIDTH] * 3 + [SB_WIDTH])
    q_a, k_a, v_a, q_b, k_b, v_b, g_a, g_b = jnp.split(u, list(cuts), axis=-1)

    def heads(t, n):
        return t.reshape(B, S, n, HEAD_DIM).transpose(0, 2, 1, 3)

    def merge(t):
        return t.transpose(0, 2, 1, 3).reshape(B, S, -1)

    o_a = stick_breaking_attention(heads(q_a, SB_HEADS), heads(k_a, SB_HEADS), heads(v_a, SB_HEADS))
    qr = rope_partial(heads(q_b, MOBA_HEADS), positions)
    kr = rope_partial(heads(k_b, MOBA_HEADS), positions)
    o_b = moba_attention(qr, kr, heads(v_b, MOBA_HEADS))
    y = jnp.concatenate([merge(o_a) * jax.nn.silu(g_a), merge(o_b) * jax.nn.silu(g_b)], axis=-1)
    return y @ w_out


def rglru_layer(h, w_in, conv_w, conv_b, w_a, b_a, w_x, b_x, lam, w_out):
    B, S, _ = h.shape
    u = h @ w_in
    xb, g = u[..., :LRU_WIDTH], u[..., LRU_WIDTH:]
    xc = lax.conv_general_dilated(
        xb, conv_w[:, None, :].astype(xb.dtype), window_strides=(1,),
        padding=[(CONV_WIDTH - 1, 0)], dimension_numbers=('NWC', 'WIO', 'NWC'),
        feature_group_count=LRU_WIDTH) + conv_b
    xg = xc.reshape(B, S, LRU_BLOCKS, LRU_BLOCK_WIDTH)
    r = jax.nn.sigmoid(jnp.einsum('bsnc,ncd->bsnd', xg, w_a).reshape(B, S, LRU_WIDTH) + b_a)
    i = jax.nn.sigmoid(jnp.einsum('bsnc,ncd->bsnd', xg, w_x).reshape(B, S, LRU_WIDTH) + b_x)
    log_a = LRU_C * r.astype(jnp.float32) * jax.nn.log_sigmoid(lam.astype(jnp.float32))
    a = jnp.exp(log_a)
    mult = jnp.sqrt(-jnp.expm1(2.0 * log_a))
    bterm = mult * (i * xc).astype(jnp.float32)

    def combine(e1, e2):
        a1, b1 = e1
        a2, b2 = e2
        return a1 * a2, a2 * b1 + b2

    _, hs = lax.associative_scan(combine, (a, bterm), axis=1)
    y = hs.astype(h.dtype) * jax.nn.silu(g)
    return y @ w_out


def setup_inputs(seed: int = 0) -> dict:
    key = jax.random.key(seed)
    ks = jax.random.split(key, 20)
    f32 = jnp.float32
    D = D_MODEL
    x = jax.random.normal(ks[0], (BATCH, SEQ, D), f32)
    c = jax.random.normal(ks[1], (BATCH, D), f32)
    positions = jnp.broadcast_to(jnp.arange(SEQ, dtype=jnp.int32)[None, :], (BATCH, SEQ))
    norm_g = 1.0 + 0.02 * jax.random.normal(ks[2], (DEPTH, D), f32)
    w_mod = 0.5 * D ** -0.5 * jax.random.normal(ks[3], (DEPTH, D, 3 * D), f32)
    b_mod = 0.02 * jax.random.normal(ks[4], (DEPTH, 3 * D), f32)
    attn_w_in = D ** -0.5 * jax.random.normal(ks[5], (N_ATT_LAYERS, D, ATT_IN_WIDTH), f32)
    attn_w_out = ATT_OUT_WIDTH ** -0.5 * jax.random.normal(ks[6], (N_ATT_LAYERS, ATT_OUT_WIDTH, D), f32)
    lru_w_in = D ** -0.5 * jax.random.normal(ks[7], (N_LRU_LAYERS, D, 2 * LRU_WIDTH), f32)
    lru_conv_w = CONV_WIDTH ** -0.5 * jax.random.normal(ks[8], (N_LRU_LAYERS, CONV_WIDTH, LRU_WIDTH), f32)
    lru_conv_b = 0.02 * jax.random.normal(ks[9], (N_LRU_LAYERS, LRU_WIDTH), f32)
    lru_w_a = LRU_BLOCK_WIDTH ** -0.5 * jax.random.normal(
        ks[10], (N_LRU_LAYERS, LRU_BLOCKS, LRU_BLOCK_WIDTH, LRU_BLOCK_WIDTH), f32)
    lru_b_a = 0.02 * jax.random.normal(ks[11], (N_LRU_LAYERS, LRU_WIDTH), f32)
    lru_w_x = LRU_BLOCK_WIDTH ** -0.5 * jax.random.normal(
        ks[12], (N_LRU_LAYERS, LRU_BLOCKS, LRU_BLOCK_WIDTH, LRU_BLOCK_WIDTH), f32)
    lru_b_x = 0.02 * jax.random.normal(ks[13], (N_LRU_LAYERS, LRU_WIDTH), f32)
    a0 = jax.random.uniform(ks[14], (N_LRU_LAYERS, LRU_WIDTH), f32, minval=0.9, maxval=0.999)
    p = a0 ** (1.0 / LRU_C)
    lru_lambda = jnp.log(p) - jnp.log1p(-p)
    lru_w_out = LRU_WIDTH ** -0.5 * jax.random.normal(ks[15], (N_LRU_LAYERS, LRU_WIDTH, D), f32)
    final_g = 1.0 + 0.02 * jax.random.normal(ks[16], (D,), f32)
    return {"x": x, "c": c, "positions": positions, "norm_g": norm_g,
            "w_mod": w_mod, "b_mod": b_mod,
            "attn_w_in": attn_w_in, "attn_w_out": attn_w_out,
            "lru_w_in": lru_w_in, "lru_conv_w": lru_conv_w, "lru_conv_b": lru_conv_b,
            "lru_w_a": lru_w_a, "lru_b_a": lru_b_a, "lru_w_x": lru_w_x, "lru_b_x": lru_b_x,
            "lru_lambda": lru_lambda, "lru_w_out": lru_w_out, "final_g": final_g}


def reference(x, c, positions, norm_g, w_mod, b_mod, attn_w_in, attn_w_out,
              lru_w_in, lru_conv_w, lru_conv_b, lru_w_a, lru_b_a, lru_w_x, lru_b_x,
              lru_lambda, lru_w_out, final_g):
    for l in range(DEPTH):
        mod = c @ w_mod[l] + b_mod[l]
        shift, scale, gate = jnp.split(mod[:, None, :], 3, axis=-1)
        h = (rmsnorm(x, norm_g[l]) * (1.0 + scale.astype(jnp.float32))
             + shift.astype(jnp.float32)).astype(x.dtype)
        j = l // 2
        if l % 2 == 0:
            y = attention_layer(h, positions, attn_w_in[j], attn_w_out[j])
        else:
            y = rglru_layer(h, lru_w_in[j], lru_conv_w[j], lru_conv_b[j], lru_w_a[j],
                            lru_b_a[j], lru_w_x[j], lru_b_x[j], lru_lambda[j], lru_w_out[j])
        x = x + gate * y
    return rmsnorm(x, final_g).astype(x.dtype)
```

```cpp
#include <hip/hip_runtime.h>
#include <hip/hip_cooperative_groups.h>
#include <stdint.h>
#include <cstdio>
namespace cg = cooperative_groups;

#define DEVI __device__ __forceinline__
typedef unsigned short bf16_t;
typedef short bf16x8 __attribute__((ext_vector_type(8)));
typedef short bf16x4 __attribute__((ext_vector_type(4)));
typedef float f32x4 __attribute__((ext_vector_type(4)));

constexpr int NB = 16, SEQ = 4096, DM = 1024, NTOK = NB * SEQ;

struct Params {
    const float *x, *c; const int* positions;
    const float *norm_g, *w_mod, *b_mod, *attn_w_in, *attn_w_out, *lru_w_in, *lru_conv_w, *lru_conv_b,
        *lru_w_a, *lru_b_a, *lru_w_x, *lru_b_x, *lru_lambda, *lru_w_out, *final_g;
    float* out;
    bf16_t *wt_in0, *wt_out0, *wt_in1, *wt_out1, *wa_t, *wx_t;
    float *mod, *kmean, *part_ml; unsigned* bar; int* mcnt; unsigned short* mlist; bf16_t* part_o;
    bf16_t *h, *qa, *ka, *vta, *qb, *kb, *vtb, *gates, *ypre, *xb, *gl;
};

DEVI bf16_t f2bf(float f) { unsigned u = __float_as_uint(f); u += 0x7fffu + ((u >> 16) & 1u); return (bf16_t)(u >> 16); }
DEVI float bf2f(bf16_t h) { return __uint_as_float(((unsigned)h) << 16); }
DEVI float bfs2f(short h) { return __uint_as_float(((unsigned)(unsigned short)h) << 16); }
typedef __bf16 bf16x2_t __attribute__((ext_vector_type(2)));
typedef float f32x2_t __attribute__((ext_vector_type(2)));
DEVI unsigned pack2(float a, float b) { const f32x2_t v = {a, b}; const bf16x2_t h = __builtin_convertvector(v, bf16x2_t); return __builtin_bit_cast(unsigned, h); }
DEVI float wave_sum(float v) {
#pragma unroll
    for (int o = 32; o > 0; o >>= 1) v += __shfl_xor(v, o);
    return v;
}
DEVI float sx16(float x, int fq) { const auto r = __builtin_amdgcn_permlane16_swap(__float_as_uint(x), __float_as_uint(x), false, false); return __uint_as_float((fq & 1) ? r[0] : r[1]); }
DEVI float sx32(float x, int fq) { const auto r = __builtin_amdgcn_permlane32_swap(__float_as_uint(x), __float_as_uint(x), false, false); return __uint_as_float((fq & 2) ? r[0] : r[1]); }
DEVI float sigmoidf_(float x) { return __builtin_amdgcn_rcpf(1.0f + __expf(-x)); }

DEVI void transpose_tile(const float* __restrict__ W, bf16_t* Wt, int K, int N, int tile, float* lds) {
    const int tn = N >> 6; const int tk = tile / tn, tnn = tile - tk * tn; const int k0 = tk * 64, n0 = tnn * 64;
    const int tid = threadIdx.x;
#pragma unroll
    for (int i = 0; i < 2; ++i) {
        const int r = (tid >> 4) + i * 32, c4 = tid & 15;
        const float4 v = *(const float4*)(W + (size_t)(k0 + r) * N + n0 + c4 * 4);
        float* d = lds + r * 65 + c4 * 4; d[0] = v.x; d[1] = v.y; d[2] = v.z; d[3] = v.w;
    }
    __syncthreads();
    const int n = tid >> 3, kc = tid & 7;
    unsigned pk[4];
#pragma unroll
    for (int j = 0; j < 4; ++j) pk[j] = pack2(lds[(kc * 8 + 2 * j) * 65 + n], lds[(kc * 8 + 2 * j + 1) * 65 + n]);
    *(uint4*)(Wt + (size_t)(n0 + n) * K + k0 + kc * 8) = make_uint4(pk[0], pk[1], pk[2], pk[3]);
    __syncthreads();
}

DEVI void mod_unit(const Params& p, int unit, float* lds) {
    float* cl = lds;
    float* red = lds + 16384;
    const int tid = threadIdx.x;
    for (int i = tid; i < 4096; i += 512) ((float4*)cl)[i] = ((const float4*)p.c)[i];
    __syncthreads();
    const int l = unit / 96, n0 = (unit % 96) * 32; const int ks = tid >> 5, col = tid & 31;
    float acc[16];
#pragma unroll
    for (int b = 0; b < 16; ++b) acc[b] = 0.f;
    const float* w = p.w_mod + (size_t)l * 1024 * 3072 + n0 + col;
#pragma unroll 8
    for (int k = ks * 64; k < ks * 64 + 64; ++k) {
        const float wv = w[(size_t)k * 3072];
#pragma unroll
        for (int b = 0; b < 16; ++b) acc[b] += cl[b * 1024 + k] * wv;
    }
#pragma unroll
    for (int b = 0; b < 16; ++b) red[(ks * 16 + b) * 32 + col] = acc[b];
    __syncthreads();
    {
        const int b = tid >> 5; float s = 0.f;
#pragma unroll
        for (int k2 = 0; k2 < 16; ++k2) s += red[(k2 * 16 + b) * 32 + col];
        p.mod[(l * 16 + b) * 3072 + n0 + col] = s + p.b_mod[l * 3072 + n0 + col];
    }
    __syncthreads();
}

DEVI void phase_a(const Params& p, char* smem) {
    float* lds = (float*)smem;
    constexpr int U_MOD = 192, T_IN0 = 16 * 64, T_OUT0 = 16 * 16, T_IN1 = 16 * 32, T_OUT1 = 16 * 16, T_G = 8 * 4;
    constexpr int TOTAL = U_MOD + T_IN0 + T_OUT0 + T_IN1 + T_OUT1 + 2 * T_G;
    for (int u = blockIdx.x; u < TOTAL; u += gridDim.x) {
        int v = u;
        if (v < U_MOD) { mod_unit(p, v, lds); continue; } v -= U_MOD;
        if (v < T_IN0) { transpose_tile(p.attn_w_in, p.wt_in0, 1024, 4096, v, lds); continue; } v -= T_IN0;
        if (v < T_OUT0) { transpose_tile(p.attn_w_out, p.wt_out0, 1024, 1024, v, lds); continue; } v -= T_OUT0;
        if (v < T_IN1) { transpose_tile(p.lru_w_in, p.wt_in1, 1024, 2048, v, lds); continue; } v -= T_IN1;
        if (v < T_OUT1) { transpose_tile(p.lru_w_out, p.wt_out1, 1024, 1024, v, lds); continue; } v -= T_OUT1;
        if (v < T_G) { const int blk = v >> 2; transpose_tile(p.lru_w_a + blk * 16384, p.wa_t + blk * 16384, 128, 128, v & 3, lds); continue; } v -= T_G;
        { const int blk = v >> 2; transpose_tile(p.lru_w_x + blk * 16384, p.wx_t + blk * 16384, 128, 128, v & 3, lds); }
    }
    for (int i = blockIdx.x * 512 + threadIdx.x; i < 16 * 8 * 16 * 64; i += gridDim.x * 512) __hip_atomic_store(p.kmean + i, 0.f, __ATOMIC_RELAXED, __HIP_MEMORY_SCOPE_AGENT);
    for (int i = blockIdx.x * 512 + threadIdx.x; i < 128 * 16; i += gridDim.x * 512) __hip_atomic_store(p.mcnt + i, 0, __ATOMIC_RELAXED, __HIP_MEMORY_SCOPE_AGENT);
}

DEVI void prenorm_phase(const float* xin, const float* __restrict__ g, const float* modl, bf16_t* hout) {
    const int wave = threadIdx.x >> 6, lane = threadIdx.x & 63;
    const int stride = gridDim.x * 8;
    int row = blockIdx.x * 8 + wave;
    float4 nx[4];
#pragma unroll
    for (int i = 0; i < 4; ++i) nx[i] = ((const float4*)(xin + (size_t)(row < NTOK ? row : 0) * DM))[lane + 64 * i];
    for (; row < NTOK; row += stride) {
        float4 v[4]; float ss = 0.f;
#pragma unroll
        for (int i = 0; i < 4; ++i) { v[i] = nx[i]; ss += v[i].x * v[i].x + v[i].y * v[i].y + v[i].z * v[i].z + v[i].w * v[i].w; }
        { const int rn = (row + stride < NTOK) ? row + stride : row;
#pragma unroll
          for (int i = 0; i < 4; ++i) nx[i] = ((const float4*)(xin + (size_t)rn * DM))[lane + 64 * i]; }
        ss = wave_sum(ss);
        const float rinv = rsqrtf(ss * (1.0f / 1024.0f) + 1e-6f);
        const float* md = modl + (row >> 12) * 3072;
#pragma unroll
        for (int i = 0; i < 4; ++i) {
            const int k = (lane + 64 * i) * 4;
            const float4 gg = *(const float4*)(g + k), sh = *(const float4*)(md + k), sc = *(const float4*)(md + 1024 + k);
            const float o0 = v[i].x * rinv * gg.x * (1.f + sc.x) + sh.x, o1 = v[i].y * rinv * gg.y * (1.f + sc.y) + sh.y;
            const float o2 = v[i].z * rinv * gg.z * (1.f + sc.z) + sh.z, o3 = v[i].w * rinv * gg.w * (1.f + sc.w) + sh.w;
            *(uint2*)(hout + (size_t)row * DM + k) = make_uint2(pack2(o0, o1), pack2(o2, o3));
        }
    }
}

DEVI void bf8_to_f(const uint4 u, float (&f)[8]) {
    f[0] = __uint_as_float(u.x << 16); f[1] = __uint_as_float(u.x & 0xffff0000u); f[2] = __uint_as_float(u.y << 16); f[3] = __uint_as_float(u.y & 0xffff0000u);
    f[4] = __uint_as_float(u.z << 16); f[5] = __uint_as_float(u.z & 0xffff0000u); f[6] = __uint_as_float(u.w << 16); f[7] = __uint_as_float(u.w & 0xffff0000u);
}
DEVI void prenorm_bf_phase(const bf16_t* xin, const float* __restrict__ g, const float* modl, bf16_t* hout) {
    const int wave = threadIdx.x >> 6, lane = threadIdx.x & 63;
    const int stride = gridDim.x * 8;
    int row = blockIdx.x * 8 + wave;
    uint4 nx0 = ((const uint4*)(xin + (size_t)(row < NTOK ? row : 0) * DM))[lane], nx1 = ((const uint4*)(xin + (size_t)(row < NTOK ? row : 0) * DM))[lane + 64];
    for (; row < NTOK; row += stride) {
        float v[2][8]; float ss = 0.f;
        bf8_to_f(nx0, v[0]); bf8_to_f(nx1, v[1]);
        { const int rn = (row + stride < NTOK) ? row + stride : row;
          nx0 = ((const uint4*)(xin + (size_t)rn * DM))[lane]; nx1 = ((const uint4*)(xin + (size_t)rn * DM))[lane + 64]; }
#pragma unroll
        for (int i = 0; i < 2; ++i)
#pragma unroll
            for (int e = 0; e < 8; ++e) ss += v[i][e] * v[i][e];
        ss = wave_sum(ss);
        const float rinv = rsqrtf(ss * (1.0f / 1024.0f) + 1e-6f);
        const float* md = modl + (row >> 12) * 3072;
#pragma unroll
        for (int i = 0; i < 2; ++i) {
            const int k = (lane + 64 * i) * 8;
            float o[8];
#pragma unroll
            for (int h2 = 0; h2 < 2; ++h2) {
                const float4 gg = *(const float4*)(g + k + 4 * h2), sh = *(const float4*)(md + k + 4 * h2), sc = *(const float4*)(md + 1024 + k + 4 * h2);
                o[4 * h2 + 0] = v[i][4 * h2 + 0] * rinv * gg.x * (1.f + sc.x) + sh.x; o[4 * h2 + 1] = v[i][4 * h2 + 1] * rinv * gg.y * (1.f + sc.y) + sh.y;
                o[4 * h2 + 2] = v[i][4 * h2 + 2] * rinv * gg.z * (1.f + sc.z) + sh.z; o[4 * h2 + 3] = v[i][4 * h2 + 3] * rinv * gg.w * (1.f + sc.w) + sh.w;
            }
            *(uint4*)(hout + (size_t)row * DM + k) = make_uint4(pack2(o[0], o[1]), pack2(o[2], o[3]), pack2(o[4], o[5]), pack2(o[6], o[7]));
        }
    }
}
DEVI void final_norm_bf_phase(const bf16_t* xin, float* out, const float* __restrict__ g) {
    const int wave = threadIdx.x >> 6, lane = threadIdx.x & 63;
    const int stride = gridDim.x * 8;
    int row = blockIdx.x * 8 + wave;
    uint4 nx0 = ((const uint4*)(xin + (size_t)(row < NTOK ? row : 0) * DM))[lane], nx1 = ((const uint4*)(xin + (size_t)(row < NTOK ? row : 0) * DM))[lane + 64];
    for (; row < NTOK; row += stride) {
        float v[2][8]; float ss = 0.f;
        bf8_to_f(nx0, v[0]); bf8_to_f(nx1, v[1]);
        { const int rn = (row + stride < NTOK) ? row + stride : row;
          nx0 = ((const uint4*)(xin + (size_t)rn * DM))[lane]; nx1 = ((const uint4*)(xin + (size_t)rn * DM))[lane + 64]; }
#pragma unroll
        for (int i = 0; i < 2; ++i)
#pragma unroll
            for (int e = 0; e < 8; ++e) ss += v[i][e] * v[i][e];
        ss = wave_sum(ss);
        const float rinv = rsqrtf(ss * (1.0f / 1024.0f) + 1e-6f);
#pragma unroll
        for (int i = 0; i < 2; ++i) {
            const int k = (lane + 64 * i) * 8;
#pragma unroll
            for (int h2 = 0; h2 < 2; ++h2) {
                const float4 gg = *(const float4*)(g + k + 4 * h2);
                float4 o; o.x = v[i][4 * h2 + 0] * rinv * gg.x; o.y = v[i][4 * h2 + 1] * rinv * gg.y; o.z = v[i][4 * h2 + 2] * rinv * gg.z; o.w = v[i][4 * h2 + 3] * rinv * gg.w;
                *(float4*)(out + (size_t)row * DM + k + 4 * h2) = o;
            }
        }
    }
}

DEVI void final_norm_phase(float* xio, const float* __restrict__ g) {
    const int wave = threadIdx.x >> 6, lane = threadIdx.x & 63;
    for (int row = blockIdx.x * 8 + wave; row < NTOK; row += gridDim.x * 8) {
        float4* xr = (float4*)(xio + (size_t)row * DM);
        float4 v[4]; float ss = 0.f;
#pragma unroll
        for (int i = 0; i < 4; ++i) { v[i] = xr[lane + 64 * i]; ss += v[i].x * v[i].x + v[i].y * v[i].y + v[i].z * v[i].z + v[i].w * v[i].w; }
        ss = wave_sum(ss);
        const float rinv = rsqrtf(ss * (1.0f / 1024.0f) + 1e-6f);
#pragma unroll
        for (int i = 0; i < 4; ++i) {
            const float4 gg = *(const float4*)(g + (lane + 64 * i) * 4);
            float4 o; o.x = v[i].x * rinv * gg.x; o.y = v[i].y * rinv * gg.y; o.z = v[i].z * rinv * gg.z; o.w = v[i].w * rinv * gg.w;
            xr[lane + 64 * i] = o;
        }
    }
}

#define LAS __attribute__((address_space(3)))
constexpr int BM = 256, BK = 64, HALF = 128, HTB = HALF * BK * 2, NXCD = 8, WGM = 8;
DEVI int lds_byte(int r, int c) { const int st = (r >> 4) * 2 + (c >> 5), rr = r & 15, cc = c & 31, ob = rr * 64 + cc * 2; return st * 1024 + (ob ^ (((ob >> 9) & 1) << 5)); }
DEVI void stage_rc(int b, int& R, int& C) { const int st = b / 1024, sb = b % 1024, swz = sb ^ (((sb >> 9) & 1) << 5); R = (st >> 1) * 16 + swz / 64; C = (st & 1) * 32 + (swz % 64) / 2; }
DEVI int perm32(int rho) { const int n = rho >> 4, i = rho & 15; return 8 * (i >> 2) + 4 * n + (i & 3); }
struct Unit { int pm, pn; };
struct StaticOrder {
    int nM, nN, nwg, G, c;
    DEVI void init(int M, int N, int G_, int c_) { nM = M / BM; nN = N / BM; nwg = nM * nN; G = G_; c = c_; }
    DEVI bool next(int i, Unit& u) const {
        const long L = (long)i * G + c; if (L >= nwg) return false;
        int wgid = (int)L; { const int q = nwg / NXCD, r = nwg % NXCD, xcd = wgid % NXCD, off = wgid / NXCD; wgid = (xcd < r ? xcd * (q + 1) : r * (q + 1) + (xcd - r) * q) + off; }
        const int nig = WGM * nN, gid = wgid / nig, fm = gid * WGM, gsz = (nM - fm) < WGM ? (nM - fm) : WGM;
        u.pm = fm + ((wgid % nig) % gsz); u.pn = (wgid % nig) / gsz; return true;
    }
};

template <class Epi>
DEVI void gemm_phase(const bf16_t* gA, const bf16_t* gBt, const int M, const int N, const int K, char* smem, const Epi& E) {
    LAS unsigned char* lds = (LAS unsigned char*)smem;
    StaticOrder S; S.init(M, N, gridDim.x, blockIdx.x);
    int tid = threadIdx.x; asm volatile("" : "+v"(tid));
    const int wid = __builtin_amdgcn_readfirstlane(tid >> 6), lane = tid & 63, wr = wid >> 2, wc = wid & 3, fr = lane & 15, fq = lane >> 4;
    const int nt = K / BK;
    unsigned voffA[2], voffB[2];
#pragma unroll
    for (int i = 0; i < 2; ++i) { int R, C; stage_rc(tid * 16 + i * 8192, R, C); voffA[i] = (unsigned)(R * K + C) * 2u;
        const int Rb = Epi::PERM ? ((R & ~31) + perm32(R & 31)) : R; voffB[i] = (unsigned)(Rb * K + C) * 2u; }
    const size_t kstep = (size_t)(BK * 2);
    const size_t hstep = (size_t)HALF * K * 2;
    const size_t tstep = 2 * hstep;
    const unsigned ldsw = (unsigned)wid * 1024u;
    const int aoff = lds_byte(wr * 64 + fr, fq * 8), boff = lds_byte(wc * 32 + fr, fq * 8);
#define PG8_SA(b, h) (((b) * 2 + (h)) * HTB)
#define PG8_SB(b, h) ((4 + (b) * 2 + (h)) * HTB)
#define PG8_STAGE(bufoff, gbase, voff) do { _Pragma("unroll") for (int _i = 0; _i < 2; ++_i) \
        __builtin_amdgcn_global_load_lds((const __attribute__((address_space(1))) unsigned*)((const char*)(gbase) + (voff)[_i]), (LAS unsigned*)(lds + (bufoff) + ldsw + _i * 8192), 16, 0, 0); } while (0)
#define PG8_LDA(dst, b, h) do { _Pragma("unroll") for (int m = 0; m < 4; ++m) _Pragma("unroll") for (int k = 0; k < 2; ++k) dst[m][k] = *(const LAS bf16x8*)(lds + PG8_SA(b, h) + aoff + m * 2048 + k * 1024); } while (0)
#define PG8_LDB(dst, b, h) do { _Pragma("unroll") for (int n = 0; n < 2; ++n) _Pragma("unroll") for (int k = 0; k < 2; ++k) dst[n][k] = *(const LAS bf16x8*)(lds + PG8_SB(b, h) + boff + n * 2048 + k * 1024); } while (0)
#define PG8_MMA(ai, bj, At, Bt) do { __builtin_amdgcn_s_setprio(1); _Pragma("unroll") for (int m = 0; m < 4; ++m) _Pragma("unroll") for (int n = 0; n < 2; ++n) _Pragma("unroll") for (int k = 0; k < 2; ++k) \
        acc[ai][bj][m][n] = __builtin_amdgcn_mfma_f32_16x16x32_bf16(Bt[n][k], At[m][k], acc[ai][bj][m][n], 0, 0, 0); __builtin_amdgcn_s_setprio(0); } while (0)
#define PG8_WAIT_V(n) asm volatile("s_waitcnt vmcnt(" #n ")" ::: "memory")
#define PG8_WAIT_L(n) asm volatile("s_waitcnt lgkmcnt(" #n ")" ::: "memory")
#define PG8_BAR __builtin_amdgcn_s_barrier()
#define PG8_SCHED __builtin_amdgcn_sched_barrier(0)
    Unit cur, nxt; int ui = 0;
    if (!S.next(0, cur)) return;
    f32x4 acc[2][2][4][2];
#pragma unroll
    for (int a = 0; a < 2; ++a)
#pragma unroll
        for (int b = 0; b < 2; ++b)
#pragma unroll
            for (int m = 0; m < 4; ++m)
#pragma unroll
                for (int n = 0; n < 2; ++n) acc[a][b][m][n] = (f32x4){0.f, 0.f, 0.f, 0.f};
    bf16x8 At[4][2], B0[2][2], B1[2][2];
    const char* cA = (const char*)gA + (size_t)cur.pm * tstep; const char* cB = (const char*)gBt + (size_t)cur.pn * tstep;
    PG8_STAGE(PG8_SB(0, 0), cB, voffB); PG8_STAGE(PG8_SB(0, 1), cB + hstep, voffB); PG8_STAGE(PG8_SA(0, 0), cA, voffA); PG8_STAGE(PG8_SA(0, 1), cA + hstep, voffA);
    if (wr == 1) PG8_BAR;
    PG8_WAIT_V(2); PG8_BAR;
    PG8_STAGE(PG8_SB(1, 0), cB + kstep, voffB); PG8_STAGE(PG8_SA(1, 0), cA + kstep, voffA); PG8_STAGE(PG8_SB(1, 1), cB + hstep + kstep, voffB);
    PG8_WAIT_V(6); PG8_BAR;
    for (;;) {
        const bool has_next = S.next(ui + 1, nxt);
        const char* nA = has_next ? (const char*)gA + (size_t)nxt.pm * tstep : cA; const char* nB = has_next ? (const char*)gBt + (size_t)nxt.pn * tstep : cB;
        for (int t = 0; t < nt; t += 2) {
            const bool last = (t == nt - 2);
            const char* a1 = cA + (size_t)(t + 1) * kstep;
            const char* a2 = last ? nA : cA + (size_t)(t + 2) * kstep; const char* b2 = last ? nB : cB + (size_t)(t + 2) * kstep;
            const char* a3 = a2 + kstep; const char* b3 = b2 + kstep;
            PG8_LDB(B0, 0, 0); PG8_LDB(B1, 0, 1); PG8_SCHED; PG8_LDA(At, 0, 0); PG8_STAGE(PG8_SA(1, 1), a1 + hstep, voffA);
            PG8_WAIT_V(8); PG8_WAIT_L(0); PG8_BAR; PG8_MMA(0, 0, At, B0); PG8_MMA(0, 1, At, B1); PG8_BAR; PG8_SCHED;
            PG8_LDA(At, 0, 1); PG8_STAGE(PG8_SB(0, 0), b2, voffB); PG8_STAGE(PG8_SB(0, 1), b2 + hstep, voffB); PG8_STAGE(PG8_SA(0, 0), a2, voffA);
            PG8_WAIT_V(8); PG8_WAIT_L(0); PG8_BAR; PG8_MMA(1, 0, At, B0); PG8_MMA(1, 1, At, B1); PG8_BAR; PG8_SCHED;
            PG8_LDB(B0, 1, 0); PG8_LDB(B1, 1, 1); PG8_SCHED; PG8_LDA(At, 1, 0); PG8_STAGE(PG8_SA(0, 1), a2 + hstep, voffA);
            PG8_WAIT_V(8); PG8_WAIT_L(0); PG8_BAR; PG8_MMA(0, 0, At, B0); PG8_MMA(0, 1, At, B1); PG8_BAR; PG8_SCHED;
            PG8_LDA(At, 1, 1); PG8_STAGE(PG8_SB(1, 0), b3, voffB); PG8_STAGE(PG8_SB(1, 1), b3 + hstep, voffB); PG8_STAGE(PG8_SA(1, 0), a3, voffA);
            PG8_WAIT_V(8); PG8_WAIT_L(0); PG8_BAR; PG8_MMA(1, 0, At, B0); PG8_MMA(1, 1, At, B1); PG8_BAR; PG8_SCHED;
        }
        if (wr == 0) PG8_BAR;
        E(acc, cur.pm * BM, cur.pn * BM, wr, wc, fr, fq);
        PG8_WAIT_V(0);
        if (!has_next) break;
#pragma unroll
        for (int a = 0; a < 2; ++a)
#pragma unroll
            for (int b = 0; b < 2; ++b)
#pragma unroll
                for (int m = 0; m < 4; ++m)
#pragma unroll
                    for (int n = 0; n < 2; ++n) acc[a][b][m][n] = (f32x4){0.f, 0.f, 0.f, 0.f};
        cur = nxt; cA = nA; cB = nB; ++ui;
        if (wr == 1) PG8_BAR;
    }
    PG8_WAIT_V(0);
    PG8_BAR;
#undef PG8_SA
#undef PG8_SB
#undef PG8_STAGE
#undef PG8_LDA
#undef PG8_LDB
#undef PG8_MMA
}

constexpr size_t HD = (size_t)16 * 8 * 4096 * 64;
struct Epi1P { const int* positions; float* kmean; bf16_t* gates; bf16_t* qkv; };
struct Epi1 {
    static constexpr bool PERM = true;
    Epi1P p;
    DEVI void operator()(f32x4 (&acc)[2][2][4][2], int brow, int bcol, int wr, int wc, int fr, int fq) const {
        const int grp = bcol >> 9, cbase = bcol & 511;
        const int b = brow >> 12, s0 = brow & 4095;
        if ((grp == 3 || grp == 4) && ((wc & 1) == 0)) {
            const float invt[8] = {1.0f, 0.19392274474868576f, 0.03760603093086393f, 0.007292664737217109f,
                                   0.001414213562373095f, 0.0002742481756762073f, 5.318295896944988e-05f, 1.031338537721246e-05f};
#pragma unroll
            for (int ai = 0; ai < 2; ++ai)
#pragma unroll
                for (int m = 0; m < 4; ++m) {
                    const int s = s0 + ai * 128 + wr * 64 + m * 16 + fr;
                    const float pos = (float)p.positions[b * 4096 + s];
#pragma unroll
                    for (int n = 0; n < 2; ++n)
#pragma unroll
                        for (int j = 0; j < 4; ++j) {
                            const float ang = pos * invt[n * 4 + j];
                            const float rvf = __builtin_amdgcn_fractf(ang * 0.15915494309189535f);
                            const float sn = __builtin_amdgcn_sinf(rvf), cs = __builtin_amdgcn_cosf(rvf);
#pragma unroll
                            for (int bj = 0; bj < 2; ++bj) {
                                const float v = acc[ai][bj][m][n][j];
                                const float pr = sx16(v, fq);
                                const float rot = (fq == 0) ? (v * cs - pr * sn) : (v * cs + pr * sn);
                                acc[ai][bj][m][n][j] = (fq < 2) ? rot : v;
                            }
                        }
                }
        }
        if (grp == 4) {
            const int nblk = s0 >> 8;
#pragma unroll
            for (int bj = 0; bj < 2; ++bj)
#pragma unroll
                for (int n = 0; n < 2; ++n)
#pragma unroll
                    for (int j = 0; j < 4; ++j) {
                        float cs = 0.f;
#pragma unroll
                        for (int ai = 0; ai < 2; ++ai)
#pragma unroll
                            for (int m = 0; m < 4; ++m) cs += acc[ai][bj][m][n][j];
                        cs += __shfl_xor(cs, 1); cs += __shfl_xor(cs, 2); cs += __shfl_xor(cs, 4); cs += __shfl_xor(cs, 8);
                        if (fr == 0) {
                            const int colg = cbase + bj * 128 + wc * 32 + fq * 8 + n * 4 + j;
                            atomicAdd(p.kmean + ((size_t)((b * 8 + (colg >> 6)) * 16 + nblk)) * 64 + (colg & 63), cs);
                        }
                    }
        }
        if (grp >= 6) {
#pragma unroll
            for (int ai = 0; ai < 2; ++ai)
#pragma unroll
                for (int m = 0; m < 4; ++m) {
                    const size_t tok = (size_t)brow + ai * 128 + wr * 64 + m * 16 + fr;
#pragma unroll
                    for (int bj = 0; bj < 2; ++bj) {
                        const int gc = (grp - 6) * 512 + cbase + bj * 128 + wc * 32 + fq * 8;
                        const f32x4 v0 = acc[ai][bj][m][0], v1 = acc[ai][bj][m][1];
                        *(uint4*)(p.gates + tok * 1024 + gc) = make_uint4(pack2(v0[0], v0[1]), pack2(v0[2], v0[3]), pack2(v1[0], v1[1]), pack2(v1[2], v1[3]));
                    }
                }
        } else if (grp == 2 || grp == 5) {
            bf16_t* dst = p.qkv + (size_t)grp * HD;
#pragma unroll
            for (int ai = 0; ai < 2; ++ai)
#pragma unroll
                for (int m = 0; m < 4; ++m) {
                    const int s = s0 + ai * 128 + wr * 64 + m * 16 + fr;
#pragma unroll
                    for (int bj = 0; bj < 2; ++bj)
#pragma unroll
                        for (int n = 0; n < 2; ++n) {
                            const int colg = cbase + bj * 128 + wc * 32 + fq * 8 + n * 4;
                            const f32x4 v = acc[ai][bj][m][n];
                            bf16_t* d0 = dst + ((size_t)((b * 8 + (colg >> 6)) * 64 + (colg & 63))) * 4096 + s;
#pragma unroll
                            for (int j = 0; j < 4; ++j) d0[(size_t)j * 4096] = f2bf(v[j]);
                        }
                }
        } else {
            bf16_t* dst = p.qkv + (size_t)grp * HD;
            const float qsc = (grp == 0) ? 0.125f : (grp == 3) ? (0.125f * 1.4426950408889634f) : 1.0f;
#pragma unroll
            for (int ai = 0; ai < 2; ++ai)
#pragma unroll
                for (int m = 0; m < 4; ++m) {
                    const int s = s0 + ai * 128 + wr * 64 + m * 16 + fr;
#pragma unroll
                    for (int bj = 0; bj < 2; ++bj) {
                        const int colg = cbase + bj * 128 + wc * 32 + fq * 8;
                        const f32x4 v0 = acc[ai][bj][m][0], v1 = acc[ai][bj][m][1];
                        *(uint4*)(dst + ((size_t)((b * 8 + (colg >> 6)) * 4096 + s)) * 64 + (colg & 63)) =
                            make_uint4(pack2(v0[0] * qsc, v0[1] * qsc), pack2(v0[2] * qsc, v0[3] * qsc), pack2(v1[0] * qsc, v1[1] * qsc), pack2(v1[2] * qsc, v1[3] * qsc));
                    }
                }
        }
    }
};

struct EpiRes {
    static constexpr bool PERM = false;
    const float* base; float* out; const float* gate;
    DEVI void operator()(f32x4 (&acc)[2][2][4][2], int brow, int bcol, int wr, int wc, int fr, int fq) const {
        const float* gt = gate + (brow >> 12) * 3072;
#pragma unroll
        for (int ai = 0; ai < 2; ++ai)
#pragma unroll
            for (int m = 0; m < 4; ++m) {
                const size_t row = (size_t)brow + ai * 128 + wr * 64 + m * 16 + fr;
#pragma unroll
                for (int bj = 0; bj < 2; ++bj)
#pragma unroll
                    for (int n = 0; n < 2; ++n) {
                        const int col = bcol + bj * 128 + wc * 32 + n * 16 + fq * 4;
                        const float4 bs = *(const float4*)(base + row * DM + col);
                        const float4 g = *(const float4*)(gt + col);
                        const f32x4 v = acc[ai][bj][m][n];
                        float4 o; o.x = bs.x + g.x * v[0]; o.y = bs.y + g.y * v[1]; o.z = bs.z + g.z * v[2]; o.w = bs.w + g.w * v[3];
                        *(float4*)(out + row * DM + col) = o;
                    }
            }
    }
};

template <bool BASE_BF16> struct EpiResP {
    static constexpr bool PERM = true;
    const void* base; bf16_t* outb; const float* gate;
    DEVI void operator()(f32x4 (&acc)[2][2][4][2], int brow, int bcol, int wr, int wc, int fr, int fq) const {
        const float* gt = gate + (brow >> 12) * 3072;
#pragma unroll
        for (int ai = 0; ai < 2; ++ai)
#pragma unroll
            for (int m = 0; m < 4; ++m) {
                const size_t row = (size_t)brow + ai * 128 + wr * 64 + m * 16 + fr;
#pragma unroll
                for (int bj = 0; bj < 2; ++bj) {
                    const int col = bcol + bj * 128 + wc * 32 + fq * 8;
                    float b[8];
                    if (BASE_BF16) bf8_to_f(*(const uint4*)((const bf16_t*)base + row * DM + col), b);
                    else { const float4 b0 = *(const float4*)((const float*)base + row * DM + col), b1 = *(const float4*)((const float*)base + row * DM + col + 4);
                           b[0] = b0.x; b[1] = b0.y; b[2] = b0.z; b[3] = b0.w; b[4] = b1.x; b[5] = b1.y; b[6] = b1.z; b[7] = b1.w; }
                    const float4 g0 = *(const float4*)(gt + col), g1 = *(const float4*)(gt + col + 4);
                    const f32x4 v0 = acc[ai][bj][m][0], v1 = acc[ai][bj][m][1];
                    *(uint4*)(outb + row * DM + col) = make_uint4(pack2(b[0] + g0.x * v0[0], b[1] + g0.y * v0[1]), pack2(b[2] + g0.z * v0[2], b[3] + g0.w * v0[3]),
                                                                   pack2(b[4] + g1.x * v1[0], b[5] + g1.y * v1[1]), pack2(b[6] + g1.z * v1[2], b[7] + g1.w * v1[3]));
                }
            }
    }
};
struct Epi3P {
    static constexpr bool PERM = true;
    bf16_t *xb, *gl;
    DEVI void operator()(f32x4 (&acc)[2][2][4][2], int brow, int bcol, int wr, int wc, int fr, int fq) const {
        bf16_t* dst = (bcol < 1024) ? xb : gl; const int cb = bcol & 1023;
#pragma unroll
        for (int ai = 0; ai < 2; ++ai)
#pragma unroll
            for (int m = 0; m < 4; ++m) {
                const size_t row = (size_t)brow + ai * 128 + wr * 64 + m * 16 + fr;
#pragma unroll
                for (int bj = 0; bj < 2; ++bj) {
                    const int col = cb + bj * 128 + wc * 32 + fq * 8;
                    const f32x4 v0 = acc[ai][bj][m][0], v1 = acc[ai][bj][m][1];
                    *(uint4*)(dst + row * DM + col) = make_uint4(pack2(v0[0], v0[1]), pack2(v0[2], v0[3]), pack2(v1[0], v1[1]), pack2(v1[2], v1[3]));
                }
            }
    }
};

template <bool BASE_BF16> struct EpiResB {   static constexpr bool PERM = false;
    const void* base; bf16_t* outb; const float* gate;
    DEVI void operator()(f32x4 (&acc)[2][2][4][2], int brow, int bcol, int wr, int wc, int fr, int fq) const {
        const float* gt = gate + (brow >> 12) * 3072;
#pragma unroll
        for (int ai = 0; ai < 2; ++ai)
#pragma unroll
            for (int m = 0; m < 4; ++m) {
                const size_t row = (size_t)brow + ai * 128 + wr * 64 + m * 16 + fr;
#pragma unroll
                for (int bj = 0; bj < 2; ++bj)
#pragma unroll
                    for (int n = 0; n < 2; ++n) {
                        const int col = bcol + bj * 128 + wc * 32 + n * 16 + fq * 4;
                        float b0, b1, b2, b3;
                        if (BASE_BF16) { const uint2 u = *(const uint2*)((const bf16_t*)base + row * DM + col);
                            b0 = __uint_as_float(u.x << 16); b1 = __uint_as_float(u.x & 0xffff0000u); b2 = __uint_as_float(u.y << 16); b3 = __uint_as_float(u.y & 0xffff0000u); }
                        else { const float4 bs = *(const float4*)((const float*)base + row * DM + col); b0 = bs.x; b1 = bs.y; b2 = bs.z; b3 = bs.w; }
                        const float4 g = *(const float4*)(gt + col);
                        const f32x4 v = acc[ai][bj][m][n];
                        *(uint2*)(outb + row * DM + col) = make_uint2(pack2(b0 + g.x * v[0], b1 + g.y * v[1]), pack2(b2 + g.z * v[2], b3 + g.w * v[3]));
                    }
            }
    }
};

struct Epi3 {   static constexpr bool PERM = false;
    bf16_t *xb, *gl;
    DEVI void operator()(f32x4 (&acc)[2][2][4][2], int brow, int bcol, int wr, int wc, int fr, int fq) const {
        bf16_t* dst = (bcol < 1024) ? xb : gl; const int cb = bcol & 1023;
#pragma unroll
        for (int ai = 0; ai < 2; ++ai)
#pragma unroll
            for (int m = 0; m < 4; ++m) {
                const size_t row = (size_t)brow + ai * 128 + wr * 64 + m * 16 + fr;
#pragma unroll
                for (int bj = 0; bj < 2; ++bj)
#pragma unroll
                    for (int n = 0; n < 2; ++n) {
                        const int col = cb + bj * 128 + wc * 32 + n * 16 + fq * 4;
                        const f32x4 v = acc[ai][bj][m][n];
                        *(uint2*)(dst + row * DM + col) = make_uint2(pack2(v[0], v[1]), pack2(v[2], v[3]));
                    }
            }
    }
};

constexpr float SB_EXIT = -40.0f;
DEVI void sb_tile(const bf16x8 (&kf)[2][2], const bf16x4 (&vlo)[4], const bf16x4 (&vhi)[4], const bf16x8 (&qf)[2], f32x4 (&o)[4], float& carry, const int k0, const int t, const int fq) {
    f32x4 st[2];
#pragma unroll
    for (int u2 = 0; u2 < 2; ++u2) {
        st[u2] = (f32x4){0.f, 0.f, 0.f, 0.f};
#pragma unroll
        for (int kk = 0; kk < 2; ++kk) st[u2] = __builtin_amdgcn_mfma_f32_16x16x32_bf16(kf[u2][kk], qf[kk], st[u2], 0, 0, 0);
    }
    float w[2][4];
#pragma unroll
    for (int u2 = 1; u2 >= 0; --u2) {
        float z[4], c[4]; bool valid[4];
#pragma unroll
        for (int j = 0; j < 4; ++j) {
            const int key = k0 + 16 * u2 + fq * 4 + j;
            z[j] = st[u2][j]; valid[j] = key < t;
            const float sp = fmaxf(z[j], 0.f) + 0.6931471805599453f * __builtin_amdgcn_logf(1.0f + __builtin_amdgcn_exp2f(-1.4426950408889634f * fabsf(z[j])));
            c[j] = valid[j] ? -sp : 0.f;
        }
        c[2] += c[3]; c[1] += c[2]; c[0] += c[1];
        const float T = c[0];
        const float a = T + sx16(T, fq);
        const float b2 = sx32(a, fq);
        const float above = ((fq & 1) ? 0.f : 1.f) * (a - T) + ((fq & 2) ? 0.f : 1.f) * b2;
        const float base = carry + above;
#pragma unroll
        for (int j = 0; j < 4; ++j) w[u2][j] = valid[j] ? __builtin_amdgcn_exp2f(1.4426950408889634f * (z[j] + base + c[j])) : 0.f;
        carry += a + b2;
    }
    bf16x8 pf;
    { const uint4 pu = make_uint4(pack2(w[0][0], w[0][1]), pack2(w[0][2], w[0][3]), pack2(w[1][0], w[1][1]), pack2(w[1][2], w[1][3])); pf = *(const bf16x8*)&pu; }
#pragma unroll
    for (int dt = 0; dt < 4; ++dt) {
        bf16x8 vf;
        vf[0] = vlo[dt][0]; vf[1] = vlo[dt][1]; vf[2] = vlo[dt][2]; vf[3] = vlo[dt][3];
        vf[4] = vhi[dt][0]; vf[5] = vhi[dt][1]; vf[6] = vhi[dt][2]; vf[7] = vhi[dt][3];
        o[dt] = __builtin_amdgcn_mfma_f32_16x16x32_bf16(vf, pf, o[dt], 0, 0, 0);
    }
}

DEVI void sb_tile2(const bf16x8 (&kf)[2][2], const bf16x4 (&vlo)[4], const bf16x4 (&vhi)[4], const bf16x8 (&qf)[2][2], f32x4 (&o)[4][2], float (&carry)[2], const int k0, const int tq0, const int fr, const int fq, const bool masked) {
    f32x4 st[2][2];
#pragma unroll
    for (int u2 = 0; u2 < 2; ++u2)
#pragma unroll
        for (int qt = 0; qt < 2; ++qt) st[u2][qt] = __builtin_amdgcn_mfma_f32_16x16x32_bf16(kf[u2][0], qf[qt][0], (f32x4){0.f, 0.f, 0.f, 0.f}, 0, 0, 0);
#pragma unroll
    for (int u2 = 0; u2 < 2; ++u2)
#pragma unroll
        for (int qt = 0; qt < 2; ++qt) st[u2][qt] = __builtin_amdgcn_mfma_f32_16x16x32_bf16(kf[u2][1], qf[qt][1], st[u2][qt], 0, 0, 0);
    float c[2][2][4]; bool valid[2][2][4];
#pragma unroll
    for (int u2 = 0; u2 < 2; ++u2)
#pragma unroll
        for (int qt = 0; qt < 2; ++qt)
#pragma unroll
            for (int j = 0; j < 4; ++j) {
                const float z = st[u2][qt][j];
                const float sp = fmaxf(z, 0.f) + 0.6931471805599453f * __builtin_amdgcn_logf(1.0f + __builtin_amdgcn_exp2f(-1.4426950408889634f * fabsf(z)));
                valid[u2][qt][j] = masked ? ((k0 + 16 * u2 + fq * 4 + j) < (tq0 + qt * 16 + fr)) : true;
                c[u2][qt][j] = valid[u2][qt][j] ? -sp : 0.f;
            }
#pragma unroll
    for (int u2 = 0; u2 < 2; ++u2)
#pragma unroll
        for (int qt = 0; qt < 2; ++qt) { c[u2][qt][2] += c[u2][qt][3]; c[u2][qt][1] += c[u2][qt][2]; c[u2][qt][0] += c[u2][qt][1]; }
    float a[2][2], b2[2][2];
#pragma unroll
    for (int u2 = 0; u2 < 2; ++u2)
#pragma unroll
        for (int qt = 0; qt < 2; ++qt) a[u2][qt] = c[u2][qt][0] + sx16(c[u2][qt][0], fq);
#pragma unroll
    for (int u2 = 0; u2 < 2; ++u2)
#pragma unroll
        for (int qt = 0; qt < 2; ++qt) b2[u2][qt] = sx32(a[u2][qt], fq);
    const float m1 = (fq & 1) ? 0.f : 1.f, m2 = (fq & 2) ? 0.f : 1.f;
    float w[2][2][4];
#pragma unroll
    for (int qt = 0; qt < 2; ++qt) {
        const float tot1 = a[1][qt] + b2[1][qt], tot0 = a[0][qt] + b2[0][qt];
        const float base1 = carry[qt] + m1 * (a[1][qt] - c[1][qt][0]) + m2 * b2[1][qt];
        const float base0 = carry[qt] + tot1 + m1 * (a[0][qt] - c[0][qt][0]) + m2 * b2[0][qt];
#pragma unroll
        for (int j = 0; j < 4; ++j) {
            const float e1 = __builtin_amdgcn_exp2f(1.4426950408889634f * (st[1][qt][j] + base1 + c[1][qt][j]));
            const float e0 = __builtin_amdgcn_exp2f(1.4426950408889634f * (st[0][qt][j] + base0 + c[0][qt][j]));
            w[1][qt][j] = valid[1][qt][j] ? e1 : 0.f; w[0][qt][j] = valid[0][qt][j] ? e0 : 0.f;
        }
        carry[qt] += tot1 + tot0;
    }
    bf16x8 pf[2];
#pragma unroll
    for (int qt = 0; qt < 2; ++qt) {
        const uint4 pu = make_uint4(pack2(w[0][qt][0], w[0][qt][1]), pack2(w[0][qt][2], w[0][qt][3]), pack2(w[1][qt][0], w[1][qt][1]), pack2(w[1][qt][2], w[1][qt][3]));
        pf[qt] = *(const bf16x8*)&pu;
    }
#pragma unroll
    for (int dt = 0; dt < 4; ++dt) {
        bf16x8 vf;
        vf[0] = vlo[dt][0]; vf[1] = vlo[dt][1]; vf[2] = vlo[dt][2]; vf[3] = vlo[dt][3];
        vf[4] = vhi[dt][0]; vf[5] = vhi[dt][1]; vf[6] = vhi[dt][2]; vf[7] = vhi[dt][3];
        o[dt][0] = __builtin_amdgcn_mfma_f32_16x16x32_bf16(vf, pf[0], o[dt][0], 0, 0, 0);
        o[dt][1] = __builtin_amdgcn_mfma_f32_16x16x32_bf16(vf, pf[1], o[dt][1], 0, 0, 0);
    }
}

DEVI void sb_phase(const Params& p, char* smem) {
    bf16_t* Ks = (bf16_t*)smem;
    bf16_t* Vs = (bf16_t*)(smem + 55296);
    const int tid = threadIdx.x, wave = tid >> 6, lane = tid & 63, fr = lane & 15, fq = lane >> 4;
    uint4 kq0, kq1, kq2, kq3, kq4, kq5, vq0, vq1, vq2, vq3, vq4, vq5;
#define SB_KG(q_) ((kb_ + ((tid + (q_) * 512) >> 3)) >= 0 ? *(const uint4*)(Kp_ + (size_t)(kb_ + ((tid + (q_) * 512) >> 3)) * 64 + ((tid + (q_) * 512) & 7) * 8) : make_uint4(0, 0, 0, 0))
#define SB_VG(q_) ((kb_ + ((tid + (q_) * 512) % 48) * 8) >= 0 ? *(const uint4*)(Vt_ + (size_t)((tid + (q_) * 512) / 48) * 4096 + kb_ + ((tid + (q_) * 512) % 48) * 8) : make_uint4(0, 0, 0, 0))
#define SB_LOAD(u_) do { const int bh_ = (u_) >> 4, kb_ = ((u_) & 15) * 256 - 128; \
        const bf16_t* Kp_ = p.ka + (size_t)bh_ * 4096 * 64; const bf16_t* Vt_ = p.vta + (size_t)bh_ * 64 * 4096; \
        kq0 = SB_KG(0); kq1 = SB_KG(1); kq2 = SB_KG(2); kq3 = SB_KG(3); kq4 = SB_KG(4); kq5 = SB_KG(5); \
        vq0 = SB_VG(0); vq1 = SB_VG(1); vq2 = SB_VG(2); vq3 = SB_VG(3); vq4 = SB_VG(4); vq5 = SB_VG(5); } while (0)
#define SB_KS(q_) (*(uint4*)(Ks + ((tid + (q_) * 512) >> 3) * 72 + ((tid + (q_) * 512) & 7) * 8))
#define SB_VS(q_) (*(uint4*)(Vs + ((tid + (q_) * 512) / 48) * 392 + ((tid + (q_) * 512) % 48) * 8))
    int u = blockIdx.x;
    { const int u0 = u < 2048 ? u : 0; SB_LOAD(u0); }
    for (; u < 2048; u += gridDim.x) {
        const int bh = u >> 4, t0 = (u & 15) * 256, kbase = t0 - 128;
        __syncthreads();
        SB_KS(0) = kq0; SB_KS(1) = kq1; SB_KS(2) = kq2; SB_KS(3) = kq3; SB_KS(4) = kq4; SB_KS(5) = kq5;
        SB_VS(0) = vq0; SB_VS(1) = vq1; SB_VS(2) = vq2; SB_VS(3) = vq3; SB_VS(4) = vq4; SB_VS(5) = vq5;
        __syncthreads();
        { const int un = (u + (int)gridDim.x < 2048) ? u + (int)gridDim.x : u; SB_LOAD(un); }
        const int q0 = t0 + wave * 32;
        const bf16_t* Q = p.qa + (size_t)bh * 4096 * 64;
        bf16x8 qf[2][2];
#pragma unroll
        for (int qt = 0; qt < 2; ++qt)
#pragma unroll
            for (int kk = 0; kk < 2; ++kk) qf[qt][kk] = *(const bf16x8*)(Q + (size_t)(q0 + qt * 16 + fr) * 64 + kk * 32 + fq * 8);
        f32x4 o[4][2];
#pragma unroll
        for (int dt = 0; dt < 4; ++dt) { o[dt][0] = (f32x4){0.f, 0.f, 0.f, 0.f}; o[dt][1] = (f32x4){0.f, 0.f, 0.f, 0.f}; }
        float carry[2] = {0.f, 0.f};
        const int lo = kbase > 0 ? kbase : 0;
        bool done = false;
        for (int k0 = q0; k0 >= lo; k0 -= 32) {
            const int kl = k0 - kbase;
            bf16x8 kf[2][2]; bf16x4 vlo[4], vhi[4];
#pragma unroll
            for (int u2 = 0; u2 < 2; ++u2)
#pragma unroll
                for (int kk = 0; kk < 2; ++kk) kf[u2][kk] = *(const bf16x8*)(Ks + (kl + 16 * u2 + fr) * 72 + kk * 32 + fq * 8);
#pragma unroll
            for (int dt = 0; dt < 4; ++dt) {
                vlo[dt] = *(const bf16x4*)(Vs + (dt * 16 + fr) * 392 + kl + fq * 4);
                vhi[dt] = *(const bf16x4*)(Vs + (dt * 16 + fr) * 392 + kl + 16 + fq * 4);
            }
            sb_tile2(kf, vlo, vhi, qf, o, carry, k0, q0, fr, fq, k0 == q0);
            if (__all(carry[0] < SB_EXIT && carry[1] < SB_EXIT)) { done = true; break; }
        }
        if (!done && lo > 0) {
            const bf16_t* Kp = p.ka + (size_t)bh * 4096 * 64;
            const bf16_t* Vt = p.vta + (size_t)bh * 64 * 4096;
            for (int k0 = lo - 32; k0 >= 0; k0 -= 32) {
                bf16x8 kf[2][2]; bf16x4 vlo[4], vhi[4];
#pragma unroll
                for (int u2 = 0; u2 < 2; ++u2)
#pragma unroll
                    for (int kk = 0; kk < 2; ++kk) kf[u2][kk] = *(const bf16x8*)(Kp + (size_t)(k0 + 16 * u2 + fr) * 64 + kk * 32 + fq * 8);
#pragma unroll
                for (int dt = 0; dt < 4; ++dt) {
                    vlo[dt] = *(const bf16x4*)(Vt + (size_t)(dt * 16 + fr) * 4096 + k0 + fq * 4);
                    vhi[dt] = *(const bf16x4*)(Vt + (size_t)(dt * 16 + fr) * 4096 + k0 + 16 + fq * 4);
                }
                sb_tile2(kf, vlo, vhi, qf, o, carry, k0, q0, fr, fq, false);
                if (__all(carry[0] < SB_EXIT && carry[1] < SB_EXIT)) break;
            }
        }
        const int hcol = (bh & 7) * 64;
#pragma unroll
        for (int qt = 0; qt < 2; ++qt) {
            const size_t tok = (size_t)(bh >> 3) * 4096 + q0 + qt * 16 + fr;
#pragma unroll
            for (int dt = 0; dt < 4; ++dt) {
                const int dh = dt * 16 + fq * 4;
                const uint2 gu = *(const uint2*)(p.gates + tok * 1024 + hcol + dh);
                const float g0 = bf2f((bf16_t)(gu.x & 0xffff)), g1 = bf2f((bf16_t)(gu.x >> 16)), g2 = bf2f((bf16_t)(gu.y & 0xffff)), g3 = bf2f((bf16_t)(gu.y >> 16));
                const float y0 = o[dt][qt][0] * g0 * sigmoidf_(g0), y1 = o[dt][qt][1] * g1 * sigmoidf_(g1), y2 = o[dt][qt][2] * g2 * sigmoidf_(g2), y3 = o[dt][qt][3] * g3 * sigmoidf_(g3);
                *(uint2*)(p.ypre + tok * 1024 + hcol + dh) = make_uint2(pack2(y0, y1), pack2(y2, y3));
            }
        }
    }
#undef SB_LOAD
#undef SB_KG
#undef SB_VG
#undef SB_KS
#undef SB_VS
}

constexpr float SM_C = 0.125f * 1.4426950408889634f;
constexpr int LCAP = 4096;

DEVI void moba_select_phase(const Params& p, char* smem) {
    float* km = (float*)smem;
    const int tid = threadIdx.x, wave = tid >> 6, lane = tid & 63;
    for (int w = blockIdx.x; w < 256; w += gridDim.x) {
        const int bh = w >> 1, hf = w & 1;
        __syncthreads();
        for (int i = tid; i < 1024; i += 512) km[i] = p.kmean[(size_t)bh * 1024 + i];
        __syncthreads();
        bf16x8 qv[8];
        { const bf16_t* qrow = p.qb + ((size_t)bh * 4096 + wave * 256 + hf * 128 + (lane & 31)) * 64;
#pragma unroll
          for (int c = 0; c < 8; ++c) qv[c] = *(const bf16x8*)(qrow + c * 8); }
#pragma unroll 1
        for (int ws8 = 0; ws8 < 8; ++ws8) {
            const int qb = (ws8 < 4) ? wave : 15 - wave;
            const int q = qb * 256 + (hf * 4 + (ws8 & 3)) * 32 + (lane & 31);
            bf16x8 qn[8];
            { const int wn = ws8 < 7 ? ws8 + 1 : ws8; const int qbn = (wn < 4) ? wave : 15 - wave;
              const bf16_t* qrow = p.qb + ((size_t)bh * 4096 + qbn * 256 + (hf * 4 + (wn & 3)) * 32 + (lane & 31)) * 64;
#pragma unroll
              for (int c = 0; c < 8; ++c) qn[c] = *(const bf16x8*)(qrow + c * 8); }
            float b0 = -INFINITY, b1 = -INFINITY, b2 = -INFINITY; int i0 = -1, i1 = -1, i2 = -1;
            for (int n = 0; n < qb; ++n) {
                float s = 0.f;
#pragma unroll
                for (int c = 0; c < 8; ++c) {
                    const f32x4 k0 = *(const f32x4*)(km + n * 64 + c * 8), k1 = *(const f32x4*)(km + n * 64 + c * 8 + 4);
                    s += bfs2f(qv[c][0]) * k0[0]; s += bfs2f(qv[c][1]) * k0[1]; s += bfs2f(qv[c][2]) * k0[2]; s += bfs2f(qv[c][3]) * k0[3];
                    s += bfs2f(qv[c][4]) * k1[0]; s += bfs2f(qv[c][5]) * k1[1]; s += bfs2f(qv[c][6]) * k1[2]; s += bfs2f(qv[c][7]) * k1[3];
                }
                if (s > b0) { b2 = b1; i2 = i1; b1 = b0; i1 = i0; b0 = s; i0 = n; }
                else if (s > b1) { b2 = b1; i2 = i1; b1 = s; i1 = n; }
                else if (s > b2) { b2 = s; i2 = n; }
            }
            for (int n = 0; n < qb; ++n) {
                const bool pred = (lane < 32) && (i0 == n || i1 == n || i2 == n);
                const unsigned long long mask = __ballot(pred);
                if (mask == 0ull) continue;
                const int leader = __ffsll((long long)mask) - 1;
                int base = 0;
                if (lane == leader) base = atomicAdd(p.mcnt + bh * 16 + n, __popcll(mask));
                base = __shfl(base, leader);
                if (pred) {
                    const int pos = base + __popcll(mask & ((1ull << lane) - 1ull));
                    const int j = (i0 == n) ? 0 : (i1 == n) ? 1 : 2;
                    __hip_atomic_store(p.mlist + (size_t)(bh * 16 + n) * LCAP + pos, (unsigned short)(q | (j << 12)), __ATOMIC_RELAXED, __HIP_MEMORY_SCOPE_AGENT);
                }
            }
#pragma unroll
            for (int c = 0; c < 8; ++c) qv[c] = qn[c];
        }
    }
}

template <bool MASK>
DEVI void moba_subtile(const bf16_t* Kt  , const bf16_t* Vt  , const int vstr,
                       const bf16x8 (&qf)[2][2], f32x4 (&o)[4][2], float (&mrun)[2], float (&lrun)[2], const int kl0, const int ql0, const int fr, const int fq) {
    f32x4 st[4][2];
#pragma unroll
    for (int kt = 0; kt < 4; ++kt) {
        st[kt][0] = (f32x4){0.f, 0.f, 0.f, 0.f}; st[kt][1] = (f32x4){0.f, 0.f, 0.f, 0.f};
#pragma unroll
        for (int kk = 0; kk < 2; ++kk) {
            const bf16x8 kf = *(const bf16x8*)(Kt + (kt * 16 + fr) * 72 + kk * 32 + fq * 8);
            st[kt][0] = __builtin_amdgcn_mfma_f32_16x16x32_bf16(kf, qf[0][kk], st[kt][0], 0, 0, 0);
            st[kt][1] = __builtin_amdgcn_mfma_f32_16x16x32_bf16(kf, qf[1][kk], st[kt][1], 0, 0, 0);
        }
    }
    bf16x8 pf[2][2];
    float sv[2][4][4], tmax[2], mnew[2], alpha[2], psum[2];
#pragma unroll
    for (int qt = 0; qt < 2; ++qt) {
        const int ql = ql0 + qt * 16 + fr;
        tmax[qt] = -1e30f;
#pragma unroll
        for (int kt = 0; kt < 4; ++kt)
#pragma unroll
            for (int j = 0; j < 4; ++j) {
                float v = st[kt][qt][j];
                if (MASK) { const int kl = kl0 + kt * 16 + fq * 4 + j; v = (kl <= ql) ? v : -1e30f; }
                sv[qt][kt][j] = v; tmax[qt] = fmaxf(tmax[qt], v);
            }
    }
#pragma unroll
    for (int qt = 0; qt < 2; ++qt) tmax[qt] = fmaxf(tmax[qt], sx16(tmax[qt], fq));
#pragma unroll
    for (int qt = 0; qt < 2; ++qt) tmax[qt] = fmaxf(tmax[qt], sx32(tmax[qt], fq));
#pragma unroll
    for (int qt = 0; qt < 2; ++qt) { mnew[qt] = fmaxf(mrun[qt], tmax[qt]); alpha[qt] = __builtin_amdgcn_exp2f(mrun[qt] - mnew[qt]); mrun[qt] = mnew[qt]; psum[qt] = 0.f; }
#pragma unroll
    for (int kt = 0; kt < 4; ++kt)
#pragma unroll
        for (int j = 0; j < 4; ++j)
#pragma unroll
            for (int qt = 0; qt < 2; ++qt) {
                float pv = __builtin_amdgcn_exp2f(sv[qt][kt][j] - mnew[qt]);
                if (MASK) pv = (sv[qt][kt][j] > -1e29f) ? pv : 0.f;
                sv[qt][kt][j] = pv; psum[qt] += pv;
            }
#pragma unroll
    for (int qt = 0; qt < 2; ++qt) psum[qt] += sx16(psum[qt], fq);
#pragma unroll
    for (int qt = 0; qt < 2; ++qt) psum[qt] += sx32(psum[qt], fq);
#pragma unroll
    for (int qt = 0; qt < 2; ++qt) {
        lrun[qt] = lrun[qt] * alpha[qt] + psum[qt];
#pragma unroll
        for (int dt = 0; dt < 4; ++dt) o[dt][qt] *= alpha[qt];
#pragma unroll
        for (int kk2 = 0; kk2 < 2; ++kk2) {
            const uint4 pu = make_uint4(pack2(sv[qt][2 * kk2][0], sv[qt][2 * kk2][1]), pack2(sv[qt][2 * kk2][2], sv[qt][2 * kk2][3]),
                                        pack2(sv[qt][2 * kk2 + 1][0], sv[qt][2 * kk2 + 1][1]), pack2(sv[qt][2 * kk2 + 1][2], sv[qt][2 * kk2 + 1][3]));
            pf[kk2][qt] = *(const bf16x8*)&pu;
        }
    }
#pragma unroll
    for (int dt = 0; dt < 4; ++dt)
#pragma unroll
        for (int kk2 = 0; kk2 < 2; ++kk2) {
            const uint2 lo = *(const uint2*)(Vt + (dt * 16 + fr) * vstr + kk2 * 32 + fq * 4);
            const uint2 hi = *(const uint2*)(Vt + (dt * 16 + fr) * vstr + kk2 * 32 + 16 + fq * 4);
            const uint4 vu = make_uint4(lo.x, lo.y, hi.x, hi.y);
            const bf16x8 vf = *(const bf16x8*)&vu;
            o[dt][0] = __builtin_amdgcn_mfma_f32_16x16x32_bf16(vf, pf[kk2][0], o[dt][0], 0, 0, 0);
            o[dt][1] = __builtin_amdgcn_mfma_f32_16x16x32_bf16(vf, pf[kk2][1], o[dt][1], 0, 0, 0);
        }
}

DEVI void moba_past_item(const Params& p, const int bh, const int n, char* smem) {
    bf16_t* Ks = (bf16_t*)smem;
    bf16_t* Vs = (bf16_t*)(smem + 36864);
    const int tid = threadIdx.x, wave = tid >> 6, lane = tid & 63, fr = lane & 15, fq = lane >> 4;
    const bf16_t* Qg = p.qb + (size_t)bh * 4096 * 64;
    const bf16_t* Kg = p.kb + ((size_t)bh * 4096 + (size_t)n * 256) * 64;
    const bf16_t* Vtg = p.vtb + (size_t)bh * 64 * 4096 + n * 256;
    __syncthreads();
#pragma unroll
    for (int q = 0; q < 4; ++q) {
        const int i = tid + q * 512;
        *(uint4*)(Ks + (i >> 3) * 72 + (i & 7) * 8) = *(const uint4*)(Kg + (size_t)(i >> 3) * 64 + (i & 7) * 8);
        *(uint4*)(Vs + (i >> 5) * 264 + (i & 31) * 8) = *(const uint4*)(Vtg + (size_t)(i >> 5) * 4096 + (i & 31) * 8);
    }
    __syncthreads();
    const int cnt = p.mcnt[bh * 16 + n];
    const unsigned short* lst = p.mlist + (size_t)(bh * 16 + n) * LCAP;
    const int ngroups = (cnt + 31) >> 5;
    int qidx[2], slot[2]; bool valid[2];
    bf16x8 qf[2][2];
#define D2_FETCH(g_) do { _Pragma("unroll") for (int qt = 0; qt < 2; ++qt) { const int idx = (g_) * 32 + qt * 16 + fr; valid[qt] = idx < cnt; \
        const unsigned e = lst[valid[qt] ? idx : 0]; qidx[qt] = e & 4095; slot[qt] = e >> 12; \
        _Pragma("unroll") for (int kk = 0; kk < 2; ++kk) qf[qt][kk] = *(const bf16x8*)(Qg + (size_t)qidx[qt] * 64 + kk * 32 + fq * 8); } } while (0)
    if (wave < ngroups) D2_FETCH(wave);
    for (int g = wave; g < ngroups; g += 8) {
        int cq[2], cs[2]; bool cv[2]; bf16x8 cf[2][2];
#pragma unroll
        for (int qt = 0; qt < 2; ++qt) { cq[qt] = qidx[qt]; cs[qt] = slot[qt]; cv[qt] = valid[qt]; cf[qt][0] = qf[qt][0]; cf[qt][1] = qf[qt][1]; }
        { const int gn = (g + 8 < ngroups) ? g + 8 : g; D2_FETCH(gn); }
        f32x4 o[4][2];
#pragma unroll
        for (int dt = 0; dt < 4; ++dt) { o[dt][0] = (f32x4){0.f, 0.f, 0.f, 0.f}; o[dt][1] = (f32x4){0.f, 0.f, 0.f, 0.f}; }
        float mrun[2] = {-1e30f, -1e30f}, lrun[2] = {0.f, 0.f};
#pragma unroll 1
        for (int jt = 0; jt < 4; ++jt)
            moba_subtile<false>(Ks + jt * 64 * 72, Vs + jt * 64, 264, cf, o, mrun, lrun, 0, 0, fr, fq);
#pragma unroll
        for (int qt = 0; qt < 2; ++qt) {
            if (cv[qt]) {
                const size_t pair = ((size_t)bh * 4096 + cq[qt]) * 3 + cs[qt];
                const float linv = __builtin_amdgcn_rcpf(lrun[qt]);
#pragma unroll
                for (int dt = 0; dt < 4; ++dt) {
                    const f32x4 v = o[dt][qt];
                    *(uint2*)(p.part_o + pair * 64 + dt * 16 + fq * 4) = make_uint2(pack2(v[0] * linv, v[1] * linv), pack2(v[2] * linv, v[3] * linv));
                }
                if (fq == 0) __hip_atomic_store((unsigned long long*)(p.part_ml + pair * 2), ((unsigned long long)__float_as_uint(lrun[qt]) << 32) | (unsigned long long)__float_as_uint(mrun[qt]), __ATOMIC_RELAXED, __HIP_MEMORY_SCOPE_AGENT);
            }
        }
    }
#undef D2_FETCH
}

DEVI void moba_past_phase(const Params& p, char* smem) {
    for (int w = blockIdx.x; w < 256; w += gridDim.x) {
        const int bh = w >> 1, set = w & 1;
#pragma unroll 1
        for (int n = 0; n < 15; ++n) {
            const int inA = (n == 0) | (n == 3) | (n == 4) | (n == 7) | (n == 8) | (n == 11) | (n == 12);
            if (inA == set) continue;
            moba_past_item(p, bh, n, smem);
        }
    }
}

DEVI void moba_own_item(const Params& p, const int bh, const int qb, char* smem) {
    bf16_t* Ks = (bf16_t*)smem;
    bf16_t* Vs = (bf16_t*)(smem + 36864);
    const int tid = threadIdx.x, wave = tid >> 6, lane = tid & 63, fr = lane & 15, fq = lane >> 4;
    const bf16_t* Qg = p.qb + ((size_t)bh * 4096 + (size_t)qb * 256) * 64;
    const bf16_t* Kg = p.kb + ((size_t)bh * 4096 + (size_t)qb * 256) * 64;
    const bf16_t* Vtg = p.vtb + (size_t)bh * 64 * 4096 + qb * 256;
#define OWN_K(q_) (*(const uint4*)(Kg + (size_t)((tid + (q_) * 512) >> 3) * 64 + ((tid + (q_) * 512) & 7) * 8))
#define OWN_V(q_) (*(const uint4*)(Vtg + (size_t)((tid + (q_) * 512) >> 5) * 4096 + ((tid + (q_) * 512) & 31) * 8))
    const uint4 kq0 = OWN_K(0), kq1 = OWN_K(1), kq2 = OWN_K(2), kq3 = OWN_K(3);
    const uint4 vq0 = OWN_V(0), vq1 = OWN_V(1), vq2 = OWN_V(2), vq3 = OWN_V(3);
#undef OWN_K
#undef OWN_V
    bf16x8 qf[2][2];
#pragma unroll
    for (int qt = 0; qt < 2; ++qt)
#pragma unroll
        for (int kk = 0; kk < 2; ++kk) qf[qt][kk] = *(const bf16x8*)(Qg + (size_t)(wave * 32 + qt * 16 + fr) * 64 + kk * 32 + fq * 8);
    f32x4 o[4][2];
#pragma unroll
    for (int dt = 0; dt < 4; ++dt) { o[dt][0] = (f32x4){0.f, 0.f, 0.f, 0.f}; o[dt][1] = (f32x4){0.f, 0.f, 0.f, 0.f}; }
    float mrun[2] = {-1e30f, -1e30f}, lrun[2] = {0.f, 0.f};
    const int hcol = 512 + (bh & 7) * 64;
    const int nsel = qb < 3 ? qb : 3;
    float2 pml[2][3]; uint2 po[2][3][4];
#pragma unroll
    for (int qt = 0; qt < 2; ++qt) {
        const int qs = qb * 256 + wave * 32 + qt * 16 + fr;
#pragma unroll
        for (int j = 0; j < 3; ++j) {
            const size_t pair = ((size_t)bh * 4096 + qs) * 3 + j;
            pml[qt][j] = make_float2(-1e30f, 0.f);
#pragma unroll
            for (int dt = 0; dt < 4; ++dt) po[qt][j][dt] = make_uint2(0u, 0u);
            if (j < nsel) {
                pml[qt][j] = *(const float2*)(p.part_ml + pair * 2);
#pragma unroll
                for (int dt = 0; dt < 4; ++dt) po[qt][j][dt] = *(const uint2*)(p.part_o + pair * 64 + dt * 16 + fq * 4);
            }
        }
    }
    __syncthreads();
#define OWN_KS(q_) (*(uint4*)(Ks + ((tid + (q_) * 512) >> 3) * 72 + ((tid + (q_) * 512) & 7) * 8))
#define OWN_VS(q_) (*(uint4*)(Vs + ((tid + (q_) * 512) >> 5) * 264 + ((tid + (q_) * 512) & 31) * 8))
    OWN_KS(0) = kq0; OWN_KS(1) = kq1; OWN_KS(2) = kq2; OWN_KS(3) = kq3;
    OWN_VS(0) = vq0; OWN_VS(1) = vq1; OWN_VS(2) = vq2; OWN_VS(3) = vq3;
#undef OWN_KS
#undef OWN_VS
    __syncthreads();
#pragma unroll 1
    for (int jt = 0; jt < 4; ++jt) {
        if (jt * 64 + 63 <= wave * 32)        moba_subtile<false>(Ks + jt * 64 * 72, Vs + jt * 64, 264, qf, o, mrun, lrun, 0, 0, fr, fq);
        else if (jt * 64 <= wave * 32 + 31)   moba_subtile<true>(Ks + jt * 64 * 72, Vs + jt * 64, 264, qf, o, mrun, lrun, jt * 64, wave * 32, fr, fq);
    }
#pragma unroll
    for (int qt = 0; qt < 2; ++qt) {
        float m = mrun[qt], l = lrun[qt];
        f32x4 acc[4];
#pragma unroll
        for (int dt = 0; dt < 4; ++dt) acc[dt] = o[dt][qt];
#pragma unroll
        for (int j = 0; j < 3; ++j) {
            const float2 ml = pml[qt][j];
            const float M = fmaxf(m, ml.x);
            const float wo = __builtin_amdgcn_exp2f(m - M), wj = ml.y * __builtin_amdgcn_exp2f(ml.x - M);
#pragma unroll
            for (int dt = 0; dt < 4; ++dt) {
                const uint2 ou = po[qt][j][dt];
                acc[dt][0] = acc[dt][0] * wo + wj * bf2f((bf16_t)(ou.x & 0xffff)); acc[dt][1] = acc[dt][1] * wo + wj * bf2f((bf16_t)(ou.x >> 16));
                acc[dt][2] = acc[dt][2] * wo + wj * bf2f((bf16_t)(ou.y & 0xffff)); acc[dt][3] = acc[dt][3] * wo + wj * bf2f((bf16_t)(ou.y >> 16));
            }
            l = l * wo + wj; m = M;
        }
        const float linv = __builtin_amdgcn_rcpf(l);
        const size_t tok = (size_t)(bh >> 3) * 4096 + qb * 256 + wave * 32 + qt * 16 + fr;
#pragma unroll
        for (int dt = 0; dt < 4; ++dt) {
            const int dh = dt * 16 + fq * 4;
            const uint2 gu = *(const uint2*)(p.gates + tok * 1024 + hcol + dh);
            const float g0 = bf2f((bf16_t)(gu.x & 0xffff)), g1 = bf2f((bf16_t)(gu.x >> 16)), g2 = bf2f((bf16_t)(gu.y & 0xffff)), g3 = bf2f((bf16_t)(gu.y >> 16));
            const float y0 = acc[dt][0] * linv * g0 * sigmoidf_(g0), y1 = acc[dt][1] * linv * g1 * sigmoidf_(g1);
            const float y2 = acc[dt][2] * linv * g2 * sigmoidf_(g2), y3 = acc[dt][3] * linv * g3 * sigmoidf_(g3);
            *(uint2*)(p.ypre + tok * 1024 + hcol + dh) = make_uint2(pack2(y0, y1), pack2(y2, y3));
        }
    }
}

DEVI void moba_own_phase(const Params& p, char* smem) {
    for (int it = blockIdx.x; it < 2048; it += gridDim.x) moba_own_item(p, it >> 4, it & 15, smem);
}

DEVI void lru_item(const Params& p, const int item, char* smem) {
    const int b = item >> 4, n = (item >> 1) & 7, half = item & 1;
    const int tid = threadIdx.x, wave = tid >> 6, lane = tid & 63, fr = lane & 15, fq = lane >> 4;
    bf16_t* xs = (bf16_t*)smem;
    bf16_t* wa = (bf16_t*)(smem + 35840);
    bf16_t* wx = (bf16_t*)(smem + 35840 + 17408);
    float* cw = (float*)(smem + 70656);
    float* agg = cw + 640;
    float* xcw = (float*)(smem + 81408) + wave * (16 * 68);
    bf16_t* gs = (bf16_t*)(smem + 81408 + 8 * 16 * 68 * 4);
    __syncthreads();
    for (int i = tid; i < 64 * 16; i += 512) {
        const int r = i >> 4, c = i & 15;
        *(uint4*)(wa + r * 136 + c * 8) = *(const uint4*)(p.wa_t + ((size_t)(n * 128 + half * 64 + r)) * 128 + c * 8);
        *(uint4*)(wx + r * 136 + c * 8) = *(const uint4*)(p.wx_t + ((size_t)(n * 128 + half * 64 + r)) * 128 + c * 8);
    }
    cw[tid] = p.lru_conv_w[(tid >> 7) * 1024 + n * 128 + (tid & 127)];
    if (tid < 128) cw[512 + tid] = p.lru_conv_b[n * 128 + tid];
    float ba[4], bx[4], lsl[4], hstart[4];
#pragma unroll
    for (int ct = 0; ct < 4; ++ct) {
        const int C = n * 128 + half * 64 + ct * 16 + fr;
        ba[ct] = p.lru_b_a[C]; bx[ct] = p.lru_b_x[C];
        const float lam = p.lru_lambda[C];
        lsl[ct] = -8.0f * (fmaxf(-lam, 0.f) + log1pf(expf(-fabsf(lam))));
        hstart[ct] = 0.f;
    }
    const bf16_t* xbase = p.xb + ((size_t)b * 4096) * 1024 + n * 128;
    const bf16_t* gbase = p.gl + ((size_t)b * 4096) * 1024 + n * 128 + half * 64;
    uint4 xr[5], gr0, gr1;
#define LRU_LOAD(t0_) do { \
        _Pragma("unroll") for (int q = 0; q < 5; ++q) { const int i = tid + q * 512; const int r = i >> 4, c = i & 15; const int t = (t0_) - 3 + r; \
            xr[q] = make_uint4(0, 0, 0, 0); if (i < 131 * 16 && t >= 0) xr[q] = *(const uint4*)(xbase + (size_t)t * 1024 + c * 8); } \
        gr0 = *(const uint4*)(gbase + (size_t)((t0_) + (tid >> 3)) * 1024 + (tid & 7) * 8); \
        gr1 = *(const uint4*)(gbase + (size_t)((t0_) + 64 + (tid >> 3)) * 1024 + (tid & 7) * 8); } while (0)
#define LRU_STORE() do { \
        _Pragma("unroll") for (int q = 0; q < 5; ++q) { const int i = tid + q * 512; const int r = i >> 4, c = i & 15; if (i < 131 * 16) *(uint4*)(xs + r * 136 + c * 8) = xr[q]; } \
        *(uint4*)(gs + (tid >> 3) * 72 + (tid & 7) * 8) = gr0; *(uint4*)(gs + (64 + (tid >> 3)) * 72 + (tid & 7) * 8) = gr1; } while (0)
    LRU_LOAD(0);
    LRU_STORE();
    __syncthreads();
    int par = 0;
    for (int ch = 0; ch < 32; ++ch) {
        const int t0 = ch * 128;
        { const int tn = (ch + 1 < 32) ? t0 + 128 : t0; LRU_LOAD(tn); }
        f32x4 ar[4], ax[4];
#pragma unroll
        for (int ct = 0; ct < 4; ++ct) { ar[ct] = (f32x4){0.f, 0.f, 0.f, 0.f}; ax[ct] = (f32x4){0.f, 0.f, 0.f, 0.f}; }
#pragma unroll
        for (int kk = 0; kk < 4; ++kk) {
            const int c0 = kk * 32 + fq * 8;
            float xcv[8];
            { const f32x4 b0 = *(const f32x4*)(cw + 512 + c0), b1 = *(const f32x4*)(cw + 512 + c0 + 4);
              xcv[0] = b0[0]; xcv[1] = b0[1]; xcv[2] = b0[2]; xcv[3] = b0[3]; xcv[4] = b1[0]; xcv[5] = b1[1]; xcv[6] = b1[2]; xcv[7] = b1[3]; }
#pragma unroll
            for (int tap = 0; tap < 4; ++tap) {
                const bf16x8 xv = *(const bf16x8*)(xs + (wave * 16 + fr + tap) * 136 + c0);
                const f32x4 w0 = *(const f32x4*)(cw + tap * 128 + c0), w1 = *(const f32x4*)(cw + tap * 128 + c0 + 4);
#pragma unroll
                for (int e = 0; e < 4; ++e) { xcv[e] += w0[e] * bfs2f(xv[e]); xcv[4 + e] += w1[e] * bfs2f(xv[4 + e]); }
            }
            if ((kk >> 1) == half) {
                float* d = xcw + fr * 68 + (kk & 1) * 32 + fq * 8;
                *(f32x4*)d = (f32x4){xcv[0], xcv[1], xcv[2], xcv[3]}; *(f32x4*)(d + 4) = (f32x4){xcv[4], xcv[5], xcv[6], xcv[7]};
            }
            const uint4 au = make_uint4(pack2(xcv[0], xcv[1]), pack2(xcv[2], xcv[3]), pack2(xcv[4], xcv[5]), pack2(xcv[6], xcv[7]));
            const bf16x8 af = *(const bf16x8*)&au;
#pragma unroll
            for (int ct = 0; ct < 4; ++ct) {
                const bf16x8 fa = *(const bf16x8*)(wa + (ct * 16 + fr) * 136 + c0);
                const bf16x8 fx = *(const bf16x8*)(wx + (ct * 16 + fr) * 136 + c0);
                ar[ct] = __builtin_amdgcn_mfma_f32_16x16x32_bf16(af, fa, ar[ct], 0, 0, 0);
                ax[ct] = __builtin_amdgcn_mfma_f32_16x16x32_bf16(af, fx, ax[ct], 0, 0, 0);
            }
        }
        float pa[4][4], pb[4][4];
#pragma unroll
        for (int ct = 0; ct < 4; ++ct) {
            float A[4], B[4];
#pragma unroll
            for (int j = 0; j < 4; ++j) {
                const float xc = xcw[(fq * 4 + j) * 68 + ct * 16 + fr];
                const float r = sigmoidf_(ar[ct][j] + ba[ct]);
                const float ig = sigmoidf_(ax[ct][j] + bx[ct]);
                const float av = __expf(lsl[ct] * r);
                const float mult = __builtin_amdgcn_sqrtf(fmaxf(1.0f - av * av, 0.f));
                A[j] = av; B[j] = mult * ig * xc;
            }
#pragma unroll
            for (int j = 1; j < 4; ++j) { B[j] = A[j] * B[j - 1] + B[j]; A[j] = A[j] * A[j - 1]; }
            float EA = 1.f, EB = 0.f, TA = 1.f, TB = 0.f;
#pragma unroll
            for (int g = 0; g < 4; ++g) {
                const float Ag = __shfl(A[3], fr + 16 * g), Bg = __shfl(B[3], fr + 16 * g);
                if (g < fq) { EB = Ag * EB + Bg; EA = Ag * EA; }
                TB = Ag * TB + Bg; TA = Ag * TA;
            }
#pragma unroll
            for (int j = 0; j < 4; ++j) { pa[ct][j] = A[j] * EA; pb[ct][j] = A[j] * EB + B[j]; }
            if (fq == 0) { float* ag = agg + ((par * 8 + wave) * 64 + ct * 16 + fr) * 2; ag[0] = TA; ag[1] = TB; }
        }
        __syncthreads();
#pragma unroll
        for (int ct = 0; ct < 4; ++ct) {
            float h = hstart[ct], hin = 0.f;
#pragma unroll
            for (int w = 0; w < 8; ++w) {
                const float2 ab = *(const float2*)(agg + ((par * 8 + w) * 64 + ct * 16 + fr) * 2);
                if (w == wave) hin = h;
                h = ab.x * h + ab.y;
            }
            hstart[ct] = h;
            const int C = n * 128 + half * 64 + ct * 16 + fr;
#pragma unroll
            for (int j = 0; j < 4; ++j) {
                const int tl = wave * 16 + fq * 4 + j;
                const size_t tok = (size_t)b * 4096 + t0 + tl;
                const float hs = pa[ct][j] * hin + pb[ct][j];
                const float g = bf2f(gs[tl * 72 + ct * 16 + fr]);
                p.ypre[tok * 1024 + C] = f2bf(hs * g * sigmoidf_(g));
            }
        }
        __syncthreads();
        LRU_STORE();
        __syncthreads();
        par ^= 1;
    }
#undef LRU_LOAD
#undef LRU_STORE
}

DEVI void lru_phase(const Params& p, char* smem) {
    for (int it = blockIdx.x; it < 256; it += gridDim.x) lru_item(p, it, smem);
}

#define GRID_SYNC_CG() do { asm volatile("s_waitcnt vmcnt(0) lgkmcnt(0)" ::: "memory"); grid.sync(); \
    if (threadIdx.x < 64) { __builtin_amdgcn_fence(__ATOMIC_ACQUIRE, "agent"); asm volatile("s_waitcnt vmcnt(0) lgkmcnt(0)" ::: "memory"); } __syncthreads(); } while (0)
DEVI void grid_barrier(unsigned* bar, const unsigned k, const unsigned xcc, const unsigned nx, const unsigned nxcd) {
    asm volatile("s_waitcnt vmcnt(0) lgkmcnt(0)" ::: "memory");
    __syncthreads();
    if (threadIdx.x == 0) {
        const unsigned old = __hip_atomic_fetch_add(bar + 64 * (17 + xcc), 1u, __ATOMIC_RELAXED, __HIP_MEMORY_SCOPE_AGENT);
        if (old + 1 == k * nx) {
            __builtin_amdgcn_fence(__ATOMIC_RELEASE, "agent");
            asm volatile("s_waitcnt vmcnt(0) lgkmcnt(0)" ::: "memory");
            __hip_atomic_fetch_add(bar, 1u, __ATOMIC_RELAXED, __HIP_MEMORY_SCOPE_AGENT);
        }
        while (__hip_atomic_load(bar, __ATOMIC_RELAXED, __HIP_MEMORY_SCOPE_AGENT) < k * nxcd) __builtin_amdgcn_s_sleep(1);
        __builtin_amdgcn_fence(__ATOMIC_ACQUIRE, "agent");
        asm volatile("s_waitcnt vmcnt(0) lgkmcnt(0)" ::: "memory");
    }
    __syncthreads();
}
#define GRID_SYNC() do { ++bar_k; grid_barrier(p.bar, bar_k, xcc, nx, nxcd); } while (0)
__global__ void __launch_bounds__(512, 2) mega_fwd(Params p) {
    extern __shared__ __attribute__((aligned(16))) char smem[];
    cg::grid_group grid = cg::this_grid();
    unsigned bar_k = 0;
    const unsigned xcc = (unsigned)__builtin_amdgcn_s_getreg((3 << 11) | 20) & 0xFu;
    if (threadIdx.x == 0) __hip_atomic_fetch_add(p.bar + 64 * (1 + xcc), 1u, __ATOMIC_RELAXED, __HIP_MEMORY_SCOPE_AGENT);
    phase_a(p, smem);
    GRID_SYNC_CG();
    unsigned nx = 0, nxcd = 0;
    for (unsigned j = 0; j < 16; ++j) { const unsigned c = __hip_atomic_load(p.bar + 64 * (1 + j), __ATOMIC_RELAXED, __HIP_MEMORY_SCOPE_AGENT); nxcd += (c != 0u); if (j == xcc) nx = c; }
    prenorm_phase(p.x, p.norm_g, p.mod, p.h);
    GRID_SYNC();
    gemm_phase(p.h, p.wt_in0, NTOK, 4096, 1024, smem, Epi1{Epi1P{p.positions, p.kmean, p.gates, p.qa}});
    GRID_SYNC();
    moba_select_phase(p, smem);
    sb_phase(p, smem);
    GRID_SYNC();
    moba_past_phase(p, smem);
    GRID_SYNC();
    moba_own_phase(p, smem);
    GRID_SYNC();
    gemm_phase(p.ypre, p.wt_out0, NTOK, 1024, 1024, smem, EpiResP<false>{p.x, p.kb  , p.mod + 2048});
    GRID_SYNC();
    prenorm_bf_phase(p.kb, p.norm_g + 1024, p.mod + 16 * 3072, p.h);
    GRID_SYNC();
    gemm_phase(p.h, p.wt_in1, NTOK, 2048, 1024, smem, Epi3P{p.xb, p.gl});
    GRID_SYNC();
    lru_phase(p, smem);
    GRID_SYNC();
    gemm_phase(p.ypre, p.wt_out1, NTOK, 1024, 1024, smem, EpiResP<true>{p.kb, p.gates  , p.mod + 16 * 3072 + 2048});
    GRID_SYNC();
    final_norm_bf_phase(p.gates, p.out, p.final_g);
}

extern "C" void kernel_launch(void* const* d_in, const int* in_sizes, int n_in, void* d_out, int out_size, void* d_ws, size_t ws_size, hipStream_t stream) {
    constexpr size_t kDynLds = 147456;
    static int grid_blocks = 0;
    if (!grid_blocks) {
        hipFuncSetAttribute((const void*)mega_fwd, hipFuncAttributeMaxDynamicSharedMemorySize, (int)kDynLds);
        int dev = 0, cus = 0, per_cu = 0;
        hipGetDevice(&dev);
        hipDeviceGetAttribute(&cus, hipDeviceAttributeMultiprocessorCount, dev);
        hipOccupancyMaxActiveBlocksPerMultiprocessor(&per_cu, mega_fwd, 512, kDynLds);
        if (per_cu < 1) per_cu = 1;
        grid_blocks = cus * 1;
    }
    Params p{};
    p.x = (const float*)d_in[0]; p.c = (const float*)d_in[1]; p.positions = (const int*)d_in[2];
    p.norm_g = (const float*)d_in[3]; p.w_mod = (const float*)d_in[4]; p.b_mod = (const float*)d_in[5];
    p.attn_w_in = (const float*)d_in[6]; p.attn_w_out = (const float*)d_in[7]; p.lru_w_in = (const float*)d_in[8];
    p.lru_conv_w = (const float*)d_in[9]; p.lru_conv_b = (const float*)d_in[10]; p.lru_w_a = (const float*)d_in[11];
    p.lru_b_a = (const float*)d_in[12]; p.lru_w_x = (const float*)d_in[13]; p.lru_b_x = (const float*)d_in[14];
    p.lru_lambda = (const float*)d_in[15]; p.lru_w_out = (const float*)d_in[16]; p.final_g = (const float*)d_in[17];
    p.out = (float*)d_out;
    char* w = (char*)d_ws; size_t off = 0;
    auto take = [&](size_t bytes) { char* r = w + off; off += (bytes + 255) & ~(size_t)255; return r; };
    p.wt_in0 = (bf16_t*)take((size_t)4096 * 1024 * 2);
    p.wt_out0 = (bf16_t*)take((size_t)1024 * 1024 * 2);
    p.wt_in1 = (bf16_t*)take((size_t)2048 * 1024 * 2);
    p.wt_out1 = (bf16_t*)take((size_t)1024 * 1024 * 2);
    p.wa_t = (bf16_t*)take((size_t)8 * 128 * 128 * 2);
    p.wx_t = (bf16_t*)take((size_t)8 * 128 * 128 * 2);
    p.mod = (float*)take((size_t)2 * 16 * 3072 * 4);
    p.kmean = (float*)take((size_t)16 * 8 * 16 * 64 * 4);
    p.h = (bf16_t*)take((size_t)NTOK * 1024 * 2);
    const size_t hd = (size_t)16 * 8 * 4096 * 64 * 2;
    p.qa = (bf16_t*)take(hd); p.ka = (bf16_t*)take(hd); p.vta = (bf16_t*)take(hd);
    p.qb = (bf16_t*)take(hd); p.kb = (bf16_t*)take(hd); p.vtb = (bf16_t*)take(hd);
    p.gates = (bf16_t*)take((size_t)NTOK * 1024 * 2);
    p.ypre = (bf16_t*)take((size_t)NTOK * 1024 * 2);
    p.bar = (unsigned*)take(16384);
    p.mcnt = (int*)take((size_t)128 * 16 * 4);
    p.mlist = (unsigned short*)take((size_t)128 * 16 * LCAP * 2);
    p.part_ml = (float*)take((size_t)128 * 4096 * 3 * 2 * 4);
    p.part_o = (bf16_t*)take((size_t)128 * 4096 * 3 * 64 * 2);
    p.xb = p.qa;
    p.gl = p.vta;
    hipMemsetAsync(p.bar, 0, 16384, stream);
    void* args[] = {&p};
    hipError_t e = hipLaunchCooperativeKernel((const void*)mega_fwd, dim3(grid_blocks), dim3(512), args, kDynLds, stream);
    if (e != hipSuccess) fprintf(stderr, "cooperative launch failed: %s (grid %d)\n", hipGetErrorString(e), grid_blocks);
}
```

```cpp
#include <hip/hip_runtime.h>
#include <hip/hip_cooperative_groups.h>
#include <stdint.h>
#include <cstdio>
namespace cg = cooperative_groups;

#define DEVI __device__ __forceinline__
typedef unsigned short bf16_t;
typedef short bf16x8 __attribute__((ext_vector_type(8)));
typedef short bf16x4 __attribute__((ext_vector_type(4)));
typedef float f32x4 __attribute__((ext_vector_type(4)));

constexpr int NB = 16, SEQ = 4096, DM = 1024, NTOK = NB * SEQ;

struct Params {
    const float *x, *c; const int* positions;
    const float *norm_g, *w_mod, *b_mod, *attn_w_in, *attn_w_out, *lru_w_in, *lru_conv_w, *lru_conv_b,
        *lru_w_a, *lru_b_a, *lru_w_x, *lru_b_x, *lru_lambda, *lru_w_out, *final_g;
    float* out;
    bf16_t *wt_in0, *wt_out0, *wt_in1, *wt_out1, *wa_t, *wx_t;
    float *mod, *kmean, *part_ml; unsigned* bar; int* mcnt; unsigned short* mlist; bf16_t* part_o;
    bf16_t *h, *qa, *ka, *vta, *qb, *kb, *vtb, *gates, *ypre, *xb, *gl;
};

DEVI bf16_t f2bf(float f) { unsigned u = __float_as_uint(f); u += 0x7fffu + ((u >> 16) & 1u); return (bf16_t)(u >> 16); }
DEVI float bf2f(bf16_t h) { return __uint_as_float(((unsigned)h) << 16); }
DEVI float bfs2f(short h) { return __uint_as_float(((unsigned)(unsigned short)h) << 16); }
typedef __bf16 bf16x2_t __attribute__((ext_vector_type(2)));
typedef float f32x2_t __attribute__((ext_vector_type(2)));
DEVI unsigned pack2(float a, float b) { const f32x2_t v = {a, b}; const bf16x2_t h = __builtin_convertvector(v, bf16x2_t); return __builtin_bit_cast(unsigned, h); }
DEVI float wave_sum(float v) {
#pragma unroll
    for (int o = 32; o > 0; o >>= 1) v += __shfl_xor(v, o);
    return v;
}
DEVI float sx16(float x, int fq) { const auto r = __builtin_amdgcn_permlane16_swap(__float_as_uint(x), __float_as_uint(x), false, false); return __uint_as_float((fq & 1) ? r[0] : r[1]); }
DEVI float sx32(float x, int fq) { const auto r = __builtin_amdgcn_permlane32_swap(__float_as_uint(x), __float_as_uint(x), false, false); return __uint_as_float((fq & 2) ? r[0] : r[1]); }
DEVI float sigmoidf_(float x) { return __builtin_amdgcn_rcpf(1.0f + __expf(-x)); }

DEVI void transpose_tile(const float* __restrict__ W, bf16_t* Wt, int K, int N, int tile, float* lds) {
    const int tn = N >> 6; const int tk = tile / tn, tnn = tile - tk * tn; const int k0 = tk * 64, n0 = tnn * 64;
    const int tid = threadIdx.x;
#pragma unroll
    for (int i = 0; i < 2; ++i) {
        const int r = (tid >> 4) + i * 32, c4 = tid & 15;
        const float4 v = *(const float4*)(W + (size_t)(k0 + r) * N + n0 + c4 * 4);
        float* d = lds + r * 65 + c4 * 4; d[0] = v.x; d[1] = v.y; d[2] = v.z; d[3] = v.w;
    }
    __syncthreads();
    const int n = tid >> 3, kc = tid & 7;
    unsigned pk[4];
#pragma unroll
    for (int j = 0; j < 4; ++j) pk[j] = pack2(lds[(kc * 8 + 2 * j) * 65 + n], lds[(kc * 8 + 2 * j + 1) * 65 + n]);
    *(uint4*)(Wt + (size_t)(n0 + n) * K + k0 + kc * 8) = make_uint4(pk[0], pk[1], pk[2], pk[3]);
    __syncthreads();
}

DEVI void mod_unit(const Params& p, int unit, float* lds) {
    float* cl = lds;
    float* red = lds + 16384;
    const int tid = threadIdx.x;
    for (int i = tid; i < 4096; i += 512) ((float4*)cl)[i] = ((const float4*)p.c)[i];
    __syncthreads();
    const int l = unit / 96, n0 = (unit % 96) * 32; const int ks = tid >> 5, col = tid & 31;
    float acc[16];
#pragma unroll
    for (int b = 0; b < 16; ++b) acc[b] = 0.f;
    const float* w = p.w_mod + (size_t)l * 1024 * 3072 + n0 + col;
#pragma unroll 8
    for (int k = ks * 64; k < ks * 64 + 64; ++k) {
        const float wv = w[(size_t)k * 3072];
#pragma unroll
        for (int b = 0; b < 16; ++b) acc[b] += cl[b * 1024 + k] * wv;
    }
#pragma unroll
    for (int b = 0; b < 16; ++b) red[(ks * 16 + b) * 32 + col] = acc[b];
    __syncthreads();
    {
        const int b = tid >> 5; float s = 0.f;
#pragma unroll
        for (int k2 = 0; k2 < 16; ++k2) s += red[(k2 * 16 + b) * 32 + col];
        p.mod[(l * 16 + b) * 3072 + n0 + col] = s + p.b_mod[l * 3072 + n0 + col];
    }
    __syncthreads();
}

DEVI void phase_a(const Params& p, char* smem) {
    float* lds = (float*)smem;
    constexpr int U_MOD = 192, T_IN0 = 16 * 64, T_OUT0 = 16 * 16, T_IN1 = 16 * 32, T_OUT1 = 16 * 16, T_G = 8 * 4;
    constexpr int TOTAL = U_MOD + T_IN0 + T_OUT0 + T_IN1 + T_OUT1 + 2 * T_G;
    for (int u = blockIdx.x; u < TOTAL; u += gridDim.x) {
        int v = u;
        if (v < U_MOD) { mod_unit(p, v, lds); continue; } v -= U_MOD;
        if (v < T_IN0) { transpose_tile(p.attn_w_in, p.wt_in0, 1024, 4096, v, lds); continue; } v -= T_IN0;
        if (v < T_OUT0) { transpose_tile(p.attn_w_out, p.wt_out0, 1024, 1024, v, lds); continue; } v -= T_OUT0;
        if (v < T_IN1) { transpose_tile(p.lru_w_in, p.wt_in1, 1024, 2048, v, lds); continue; } v -= T_IN1;
        if (v < T_OUT1) { transpose_tile(p.lru_w_out, p.wt_out1, 1024, 1024, v, lds); continue; } v -= T_OUT1;
        if (v < T_G) { const int blk = v >> 2; transpose_tile(p.lru_w_a + blk * 16384, p.wa_t + blk * 16384, 128, 128, v & 3, lds); continue; } v -= T_G;
        { const int blk = v >> 2; transpose_tile(p.lru_w_x + blk * 16384, p.wx_t + blk * 16384, 128, 128, v & 3, lds); }
    }
    for (int i = blockIdx.x * 512 + threadIdx.x; i < 16 * 8 * 16 * 64; i += gridDim.x * 512) __hip_atomic_store(p.kmean + i, 0.f, __ATOMIC_RELAXED, __HIP_MEMORY_SCOPE_AGENT);
    for (int i = blockIdx.x * 512 + threadIdx.x; i < 128 * 16; i += gridDim.x * 512) __hip_atomic_store(p.mcnt + i, 0, __ATOMIC_RELAXED, __HIP_MEMORY_SCOPE_AGENT);
}

DEVI void prenorm_phase(const float* xin, const float* __restrict__ g, const float* modl, bf16_t* hout) {
    const int wave = threadIdx.x >> 6, lane = threadIdx.x & 63;
    const int stride = gridDim.x * 8;
    int row = blockIdx.x * 8 + wave;
    float4 nx[4];
#pragma unroll
    for (int i = 0; i < 4; ++i) nx[i] = ((const float4*)(xin + (size_t)(row < NTOK ? row : 0) * DM))[lane + 64 * i];
    for (; row < NTOK; row += stride) {
        float4 v[4]; float ss = 0.f;
#pragma unroll
        for (int i = 0; i < 4; ++i) { v[i] = nx[i]; ss += v[i].x * v[i].x + v[i].y * v[i].y + v[i].z * v[i].z + v[i].w * v[i].w; }
        { const int rn = (row + stride < NTOK) ? row + stride : row;
#pragma unroll
          for (int i = 0; i < 4; ++i) nx[i] = ((const float4*)(xin + (size_t)rn * DM))[lane + 64 * i]; }
        ss = wave_sum(ss);
        const float rinv = rsqrtf(ss * (1.0f / 1024.0f) + 1e-6f);
        const float* md = modl + (row >> 12) * 3072;
#pragma unroll
        for (int i = 0; i < 4; ++i) {
            const int k = (lane + 64 * i) * 4;
            const float4 gg = *(const float4*)(g + k), sh = *(const float4*)(md + k), sc = *(const float4*)(md + 1024 + k);
            const float o0 = v[i].x * rinv * gg.x * (1.f + sc.x) + sh.x, o1 = v[i].y * rinv * gg.y * (1.f + sc.y) + sh.y;
            const float o2 = v[i].z * rinv * gg.z * (1.f + sc.z) + sh.z, o3 = v[i].w * rinv * gg.w * (1.f + sc.w) + sh.w;
            *(uint2*)(hout + (size_t)row * DM + k) = make_uint2(pack2(o0, o1), pack2(o2, o3));
        }
    }
}

DEVI void bf8_to_f(const uint4 u, float (&f)[8]) {
    f[0] = __uint_as_float(u.x << 16); f[1] = __uint_as_float(u.x & 0xffff0000u); f[2] = __uint_as_float(u.y << 16); f[3] = __uint_as_float(u.y & 0xffff0000u);
    f[4] = __uint_as_float(u.z << 16); f[5] = __uint_as_float(u.z & 0xffff0000u); f[6] = __uint_as_float(u.w << 16); f[7] = __uint_as_float(u.w & 0xffff0000u);
}
DEVI void prenorm_bf_phase(const bf16_t* xin, const float* __restrict__ g, const float* modl, bf16_t* hout) {
    const int wave = threadIdx.x >> 6, lane = threadIdx.x & 63;
    const int stride = gridDim.x * 8;
    int row = blockIdx.x * 8 + wave;
    uint4 nx0 = ((const uint4*)(xin + (size_t)(row < NTOK ? row : 0) * DM))[lane], nx1 = ((const uint4*)(xin + (size_t)(row < NTOK ? row : 0) * DM))[lane + 64];
    for (; row < NTOK; row += stride) {
        float v[2][8]; float ss = 0.f;
        bf8_to_f(nx0, v[0]); bf8_to_f(nx1, v[1]);
        { const int rn = (row + stride < NTOK) ? row + stride : row;
          nx0 = ((const uint4*)(xin + (size_t)rn * DM))[lane]; nx1 = ((const uint4*)(xin + (size_t)rn * DM))[lane + 64]; }
#pragma unroll
        for (int i = 0; i < 2; ++i)
#pragma unroll
            for (int e = 0; e < 8; ++e) ss += v[i][e] * v[i][e];
        ss = wave_sum(ss);
        const float rinv = rsqrtf(ss * (1.0f / 1024.0f) + 1e-6f);
        const float* md = modl + (row >> 12) * 3072;
#pragma unroll
        for (int i = 0; i < 2; ++i) {
            const int k = (lane + 64 * i) * 8;
            float o[8];
#pragma unroll
            for (int h2 = 0; h2 < 2; ++h2) {
                const float4 gg = *(const float4*)(g + k + 4 * h2), sh = *(const float4*)(md + k + 4 * h2), sc = *(const float4*)(md + 1024 + k + 4 * h2);
                o[4 * h2 + 0] = v[i][4 * h2 + 0] * rinv * gg.x * (1.f + sc.x) + sh.x; o[4 * h2 + 1] = v[i][4 * h2 + 1] * rinv * gg.y * (1.f + sc.y) + sh.y;
                o[4 * h2 + 2] = v[i][4 * h2 + 2] * rinv * gg.z * (1.f + sc.z) + sh.z; o[4 * h2 + 3] = v[i][4 * h2 + 3] * rinv * gg.w * (1.f + sc.w) + sh.w;
            }
            *(uint4*)(hout + (size_t)row * DM + k) = make_uint4(pack2(o[0], o[1]), pack2(o[2], o[3]), pack2(o[4], o[5]), pack2(o[6], o[7]));
        }
    }
}
DEVI void final_norm_bf_phase(const bf16_t* xin, float* out, const float* __restrict__ g) {
    const int wave = threadIdx.x >> 6, lane = threadIdx.x & 63;
    const int stride = gridDim.x * 8;
    int row = blockIdx.x * 8 + wave;
    uint4 nx0 = ((const uint4*)(xin + (size_t)(row < NTOK ? row : 0) * DM))[lane], nx1 = ((const uint4*)(xin + (size_t)(row < NTOK ? row : 0) * DM))[lane + 64];
    for (; row < NTOK; row += stride) {
        float v[2][8]; float ss = 0.f;
        bf8_to_f(nx0, v[0]); bf8_to_f(nx1, v[1]);
        { const int rn = (row + stride < NTOK) ? row + stride : row;
          nx0 = ((const uint4*)(xin + (size_t)rn * DM))[lane]; nx1 = ((const uint4*)(xin + (size_t)rn * DM))[lane + 64]; }
#pragma unroll
        for (int i = 0; i < 2; ++i)
#pragma unroll
            for (int e = 0; e < 8; ++e) ss += v[i][e] * v[i][e];
        ss = wave_sum(ss);
        const float rinv = rsqrtf(ss * (1.0f / 1024.0f) + 1e-6f);
#pragma unroll
        for (int i = 0; i < 2; ++i) {
            const int k = (lane + 64 * i) * 8;
#pragma unroll
            for (int h2 = 0; h2 < 2; ++h2) {
                const float4 gg = *(const float4*)(g + k + 4 * h2);
                float4 o; o.x = v[i][4 * h2 + 0] * rinv * gg.x; o.y = v[i][4 * h2 + 1] * rinv * gg.y; o.z = v[i][4 * h2 + 2] * rinv * gg.z; o.w = v[i][4 * h2 + 3] * rinv * gg.w;
                *(float4*)(out + (size_t)row * DM + k + 4 * h2) = o;
            }
        }
    }
}

DEVI void final_norm_phase(float* xio, const float* __restrict__ g) {
    const int wave = threadIdx.x >> 6, lane = threadIdx.x & 63;
    for (int row = blockIdx.x * 8 + wave; row < NTOK; row += gridDim.x * 8) {
        float4* xr = (float4*)(xio + (size_t)row * DM);
        float4 v[4]; float ss = 0.f;
#pragma unroll
        for (int i = 0; i < 4; ++i) { v[i] = xr[lane + 64 * i]; ss += v[i].x * v[i].x + v[i].y * v[i].y + v[i].z * v[i].z + v[i].w * v[i].w; }
        ss = wave_sum(ss);
        const float rinv = rsqrtf(ss * (1.0f / 1024.0f) + 1e-6f);
#pragma unroll
        for (int i = 0; i < 4; ++i) {
            const float4 gg = *(const float4*)(g + (lane + 64 * i) * 4);
            float4 o; o.x = v[i].x * rinv * gg.x; o.y = v[i].y * rinv * gg.y; o.z = v[i].z * rinv * gg.z; o.w = v[i].w * rinv * gg.w;
            xr[lane + 64 * i] = o;
        }
    }
}

#define LAS __attribute__((address_space(3)))
constexpr int BM = 256, BK = 64, HALF = 128, HTB = HALF * BK * 2, NXCD = 8, WGM = 8;
DEVI int lds_byte(int r, int c) { const int st = (r >> 4) * 2 + (c >> 5), rr = r & 15, cc = c & 31, ob = rr * 64 + cc * 2; return st * 1024 + (ob ^ (((ob >> 9) & 1) << 5)); }
DEVI void stage_rc(int b, int& R, int& C) { const int st = b / 1024, sb = b % 1024, swz = sb ^ (((sb >> 9) & 1) << 5); R = (st >> 1) * 16 + swz / 64; C = (st & 1) * 32 + (swz % 64) / 2; }
DEVI int perm32(int rho) { const int n = rho >> 4, i = rho & 15; return 8 * (i >> 2) + 4 * n + (i & 3); }
struct Unit { int pm, pn; };
struct StaticOrder {
    int nM, nN, nwg, G, c;
    DEVI void init(int M, int N, int G_, int c_) { nM = M / BM; nN = N / BM; nwg = nM * nN; G = G_; c = c_; }
    DEVI bool next(int i, Unit& u) const {
        const long L = (long)i * G + c; if (L >= nwg) return false;
        int wgid = (int)L; { const int q = nwg / NXCD, r = nwg % NXCD, xcd = wgid % NXCD, off = wgid / NXCD; wgid = (xcd < r ? xcd * (q + 1) : r * (q + 1) + (xcd - r) * q) + off; }
        const int nig = WGM * nN, gid = wgid / nig, fm = gid * WGM, gsz = (nM - fm) < WGM ? (nM - fm) : WGM;
        u.pm = fm + ((wgid % nig) % gsz); u.pn = (wgid % nig) / gsz; return true;
    }
};

template <class Epi>
DEVI void gemm_phase(const bf16_t* gA, const bf16_t* gBt, const int M, const int N, const int K, char* smem, const Epi& E) {
    LAS unsigned char* lds = (LAS unsigned char*)smem;
    StaticOrder S; S.init(M, N, gridDim.x, blockIdx.x);
    int tid = threadIdx.x; asm volatile("" : "+v"(tid));
    const int wid = __builtin_amdgcn_readfirstlane(tid >> 6), lane = tid & 63, wr = wid >> 2, wc = wid & 3, fr = lane & 15, fq = lane >> 4;
    const int nt = K / BK;
    unsigned voffA[2], voffB[2];
#pragma unroll
    for (int i = 0; i < 2; ++i) { int R, C; stage_rc(tid * 16 + i * 8192, R, C); voffA[i] = (unsigned)(R * K + C) * 2u;
        const int Rb = Epi::PERM ? ((R & ~31) + perm32(R & 31)) : R; voffB[i] = (unsigned)(Rb * K + C) * 2u; }
    const size_t kstep = (size_t)(BK * 2);
    const size_t hstep = (size_t)HALF * K * 2;
    const size_t tstep = 2 * hstep;
    const unsigned ldsw = (unsigned)wid * 1024u;
    const int aoff = lds_byte(wr * 64 + fr, fq * 8), boff = lds_byte(wc * 32 + fr, fq * 8);
#define PG8_SA(b, h) (((b) * 2 + (h)) * HTB)
#define PG8_SB(b, h) ((4 + (b) * 2 + (h)) * HTB)
#define PG8_STAGE(bufoff, gbase, voff) do { _Pragma("unroll") for (int _i = 0; _i < 2; ++_i) \
        __builtin_amdgcn_global_load_lds((const __attribute__((address_space(1))) unsigned*)((const char*)(gbase) + (voff)[_i]), (LAS unsigned*)(lds + (bufoff) + ldsw + _i * 8192), 16, 0, 0); } while (0)
#define PG8_LDA(dst, b, h) do { _Pragma("unroll") for (int m = 0; m < 4; ++m) _Pragma("unroll") for (int k = 0; k < 2; ++k) dst[m][k] = *(const LAS bf16x8*)(lds + PG8_SA(b, h) + aoff + m * 2048 + k * 1024); } while (0)
#define PG8_LDB(dst, b, h) do { _Pragma("unroll") for (int n = 0; n < 2; ++n) _Pragma("unroll") for (int k = 0; k < 2; ++k) dst[n][k] = *(const LAS bf16x8*)(lds + PG8_SB(b, h) + boff + n * 2048 + k * 1024); } while (0)
#define PG8_MMA(ai, bj, At, Bt) do { __builtin_amdgcn_s_setprio(1); _Pragma("unroll") for (int m = 0; m < 4; ++m) _Pragma("unroll") for (int n = 0; n < 2; ++n) _Pragma("unroll") for (int k = 0; k < 2; ++k) \
        acc[ai][bj][m][n] = __builtin_amdgcn_mfma_f32_16x16x32_bf16(Bt[n][k], At[m][k], acc[ai][bj][m][n], 0, 0, 0); __builtin_amdgcn_s_setprio(0); } while (0)
#define PG8_WAIT_V(n) asm volatile("s_waitcnt vmcnt(" #n ")" ::: "memory")
#define PG8_WAIT_L(n) asm volatile("s_waitcnt lgkmcnt(" #n ")" ::: "memory")
#define PG8_BAR __builtin_amdgcn_s_barrier()
#define PG8_SCHED __builtin_amdgcn_sched_barrier(0)
    Unit cur, nxt; int ui = 0;
    if (!S.next(0, cur)) return;
    f32x4 acc[2][2][4][2];
#pragma unroll
    for (int a = 0; a < 2; ++a)
#pragma unroll
        for (int b = 0; b < 2; ++b)
#pragma unroll
            for (int m = 0; m < 4; ++m)
#pragma unroll
                for (int n = 0; n < 2; ++n) acc[a][b][m][n] = (f32x4){0.f, 0.f, 0.f, 0.f};
    bf16x8 At[4][2], B0[2][2], B1[2][2];
    const char* cA = (const char*)gA + (size_t)cur.pm * tstep; const char* cB = (const char*)gBt + (size_t)cur.pn * tstep;
    PG8_STAGE(PG8_SB(0, 0), cB, voffB); PG8_STAGE(PG8_SB(0, 1), cB + hstep, voffB); PG8_STAGE(PG8_SA(0, 0), cA, voffA); PG8_STAGE(PG8_SA(0, 1), cA + hstep, voffA);
    if (wr == 1) PG8_BAR;
    PG8_WAIT_V(2); PG8_BAR;
    PG8_STAGE(PG8_SB(1, 0), cB + kstep, voffB); PG8_STAGE(PG8_SA(1, 0), cA + kstep, voffA); PG8_STAGE(PG8_SB(1, 1), cB + hstep + kstep, voffB);
    PG8_WAIT_V(6); PG8_BAR;
    for (;;) {
        const bool has_next = S.next(ui + 1, nxt);
        const char* nA = has_next ? (const char*)gA + (size_t)nxt.pm * tstep : cA; const char* nB = has_next ? (const char*)gBt + (size_t)nxt.pn * tstep : cB;
        for (int t = 0; t < nt; t += 2) {
            const bool last = (t == nt - 2);
            const char* a1 = cA + (size_t)(t + 1) * kstep;
            const char* a2 = last ? nA : cA + (size_t)(t + 2) * kstep; const char* b2 = last ? nB : cB + (size_t)(t + 2) * kstep;
            const char* a3 = a2 + kstep; const char* b3 = b2 + kstep;
            PG8_LDB(B0, 0, 0); PG8_LDB(B1, 0, 1); PG8_SCHED; PG8_LDA(At, 0, 0); PG8_STAGE(PG8_SA(1, 1), a1 + hstep, voffA);
            PG8_WAIT_V(8); PG8_WAIT_L(0); PG8_BAR; PG8_MMA(0, 0, At, B0); PG8_MMA(0, 1, At, B1); PG8_BAR; PG8_SCHED;
            PG8_LDA(At, 0, 1); PG8_STAGE(PG8_SB(0, 0), b2, voffB); PG8_STAGE(PG8_SB(0, 1), b2 + hstep, voffB); PG8_STAGE(PG8_SA(0, 0), a2, voffA);
            PG8_WAIT_V(8); PG8_WAIT_L(0); PG8_BAR; PG8_MMA(1, 0, At, B0); PG8_MMA(1, 1, At, B1); PG8_BAR; PG8_SCHED;
            PG8_LDB(B0, 1, 0); PG8_LDB(B1, 1, 1); PG8_SCHED; PG8_LDA(At, 1, 0); PG8_STAGE(PG8_SA(0, 1), a2 + hstep, voffA);
            PG8_WAIT_V(8); PG8_WAIT_L(0); PG8_BAR; PG8_MMA(0, 0, At, B0); PG8_MMA(0, 1, At, B1); PG8_BAR; PG8_SCHED;
            PG8_LDA(At, 1, 1); PG8_STAGE(PG8_SB(1, 0), b3, voffB); PG8_STAGE(PG8_SB(1, 1), b3 + hstep, voffB); PG8_STAGE(PG8_SA(1, 0), a3, voffA);
            PG8_WAIT_V(8); PG8_WAIT_L(0); PG8_BAR; PG8_MMA(1, 0, At, B0); PG8_MMA(1, 1, At, B1); PG8_BAR; PG8_SCHED;
        }
        if (wr == 0) PG8_BAR;
        E(acc, cur.pm * BM, cur.pn * BM, wr, wc, fr, fq);
        PG8_WAIT_V(0);
        if (!has_next) break;
#pragma unroll
        for (int a = 0; a < 2; ++a)
#pragma unroll
            for (int b = 0; b < 2; ++b)
#pragma unroll
                for (int m = 0; m < 4; ++m)
#pragma unroll
                    for (int n = 0; n < 2; ++n) acc[a][b][m][n] = (f32x4){0.f, 0.f, 0.f, 0.f};
        cur = nxt; cA = nA; cB = nB; ++ui;
        if (wr == 1) PG8_BAR;
    }
    PG8_WAIT_V(0);
    PG8_BAR;
#undef PG8_SA
#undef PG8_SB
#undef PG8_STAGE
#undef PG8_LDA
#undef PG8_LDB
#undef PG8_MMA
}

constexpr size_t HD = (size_t)16 * 8 * 4096 * 64;
struct Epi1P { const int* positions; float* kmean; bf16_t* gates; bf16_t* qkv; };
struct Epi1 {
    static constexpr bool PERM = true;
    Epi1P p;
    DEVI void operator()(f32x4 (&acc)[2][2][4][2], int brow, int bcol, int wr, int wc, int fr, int fq) const {
        const int grp = bcol >> 9, cbase = bcol & 511;
        const int b = brow >> 12, s0 = brow & 4095;
        if ((grp == 3 || grp == 4) && ((wc & 1) == 0)) {
            const float invt[8] = {1.0f, 0.19392274474868576f, 0.03760603093086393f, 0.007292664737217109f,
                                   0.001414213562373095f, 0.0002742481756762073f, 5.318295896944988e-05f, 1.031338537721246e-05f};
#pragma unroll
            for (int ai = 0; ai < 2; ++ai)
#pragma unroll
                for (int m = 0; m < 4; ++m) {
                    const int s = s0 + ai * 128 + wr * 64 + m * 16 + fr;
                    const float pos = (float)p.positions[b * 4096 + s];
#pragma unroll
                    for (int n = 0; n < 2; ++n)
#pragma unroll
                        for (int j = 0; j < 4; ++j) {
                            const float ang = pos * invt[n * 4 + j];
                            const float rvf = __builtin_amdgcn_fractf(ang * 0.15915494309189535f);
                            const float sn = __builtin_amdgcn_sinf(rvf), cs = __builtin_amdgcn_cosf(rvf);
#pragma unroll
                            for (int bj = 0; bj < 2; ++bj) {
                                const float v = acc[ai][bj][m][n][j];
                                const float pr = sx16(v, fq);
                                const float rot = (fq == 0) ? (v * cs - pr * sn) : (v * cs + pr * sn);
                                acc[ai][bj][m][n][j] = (fq < 2) ? rot : v;
                            }
                        }
                }
        }
        if (grp == 4) {
            const int nblk = s0 >> 8;
#pragma unroll
            for (int bj = 0; bj < 2; ++bj)
#pragma unroll
                for (int n = 0; n < 2; ++n)
#pragma unroll
                    for (int j = 0; j < 4; ++j) {
                        float cs = 0.f;
#pragma unroll
                        for (int ai = 0; ai < 2; ++ai)
#pragma unroll
                            for (int m = 0; m < 4; ++m) cs += acc[ai][bj][m][n][j];
                        cs += __shfl_xor(cs, 1); cs += __shfl_xor(cs, 2); cs += __shfl_xor(cs, 4); cs += __shfl_xor(cs, 8);
                        if (fr == 0) {
                            const int colg = cbase + bj * 128 + wc * 32 + fq * 8 + n * 4 + j;
                            atomicAdd(p.kmean + ((size_t)((b * 8 + (colg >> 6)) * 16 + nblk)) * 64 + (colg & 63), cs);
                        }
                    }
        }
        if (grp >= 6) {
#pragma unroll
            for (int ai = 0; ai < 2; ++ai)
#pragma unroll
                for (int m = 0; m < 4; ++m) {
                    const size_t tok = (size_t)brow + ai * 128 + wr * 64 + m * 16 + fr;
#pragma unroll
                    for (int bj = 0; bj < 2; ++bj) {
                        const int gc = (grp - 6) * 512 + cbase + bj * 128 + wc * 32 + fq * 8;
                        const f32x4 v0 = acc[ai][bj][m][0], v1 = acc[ai][bj][m][1];
                        *(uint4*)(p.gates + tok * 1024 + gc) = make_uint4(pack2(v0[0], v0[1]), pack2(v0[2], v0[3]), pack2(v1[0], v1[1]), pack2(v1[2], v1[3]));
                    }
                }
        } else if (grp == 2 || grp == 5) {
            bf16_t* dst = p.qkv + (size_t)grp * HD;
#pragma unroll
            for (int ai = 0; ai < 2; ++ai)
#pragma unroll
                for (int m = 0; m < 4; ++m) {
                    const int s = s0 + ai * 128 + wr * 64 + m * 16 + fr;
#pragma unroll
                    for (int bj = 0; bj < 2; ++bj)
#pragma unroll
                        for (int n = 0; n < 2; ++n) {
                            const int colg = cbase + bj * 128 + wc * 32 + fq * 8 + n * 4;
                            const f32x4 v = acc[ai][bj][m][n];
                            bf16_t* d0 = dst + ((size_t)((b * 8 + (colg >> 6)) * 64 + (colg & 63))) * 4096 + s;
#pragma unroll
                            for (int j = 0; j < 4; ++j) d0[(size_t)j * 4096] = f2bf(v[j]);
                        }
                }
        } else {
            bf16_t* dst = p.qkv + (size_t)grp * HD;
            const float qsc = (grp == 0) ? 0.125f : (grp == 3) ? (0.125f * 1.4426950408889634f) : 1.0f;
#pragma unroll
            for (int ai = 0; ai < 2; ++ai)
#pragma unroll
                for (int m = 0; m < 4; ++m) {
                    const int s = s0 + ai * 128 + wr * 64 + m * 16 + fr;
#pragma unroll
                    for (int bj = 0; bj < 2; ++bj) {
                        const int colg = cbase + bj * 128 + wc * 32 + fq * 8;
                        const f32x4 v0 = acc[ai][bj][m][0], v1 = acc[ai][bj][m][1];
                        *(uint4*)(dst + ((size_t)((b * 8 + (colg >> 6)) * 4096 + s)) * 64 + (colg & 63)) =
                            make_uint4(pack2(v0[0] * qsc, v0[1] * qsc), pack2(v0[2] * qsc, v0[3] * qsc), pack2(v1[0] * qsc, v1[1] * qsc), pack2(v1[2] * qsc, v1[3] * qsc));
                    }
                }
        }
    }
};

struct EpiRes {
    static constexpr bool PERM = false;
    const float* base; float* out; const float* gate;
    DEVI void operator()(f32x4 (&acc)[2][2][4][2], int brow, int bcol, int wr, int wc, int fr, int fq) const {
        const float* gt = gate + (brow >> 12) * 3072;
#pragma unroll
        for (int ai = 0; ai < 2; ++ai)
#pragma unroll
            for (int m = 0; m < 4; ++m) {
                const size_t row = (size_t)brow + ai * 128 + wr * 64 + m * 16 + fr;
#pragma unroll
                for (int bj = 0; bj < 2; ++bj)
#pragma unroll
                    for (int n = 0; n < 2; ++n) {
                        const int col = bcol + bj * 128 + wc * 32 + n * 16 + fq * 4;
                        const float4 bs = *(const float4*)(base + row * DM + col);
                        const float4 g = *(const float4*)(gt + col);
                        const f32x4 v = acc[ai][bj][m][n];
                        float4 o; o.x = bs.x + g.x * v[0]; o.y = bs.y + g.y * v[1]; o.z = bs.z + g.z * v[2]; o.w = bs.w + g.w * v[3];
                        *(float4*)(out + row * DM + col) = o;
                    }
            }
    }
};

template <bool BASE_BF16> struct EpiResP {
    static constexpr bool PERM = true;
    const void* base; bf16_t* outb; const float* gate;
    DEVI void operator()(f32x4 (&acc)[2][2][4][2], int brow, int bcol, int wr, int wc, int fr, int fq) const {
        const float* gt = gate + (brow >> 12) * 3072;
#pragma unroll
        for (int ai = 0; ai < 2; ++ai)
#pragma unroll
            for (int m = 0; m < 4; ++m) {
                const size_t row = (size_t)brow + ai * 128 + wr * 64 + m * 16 + fr;
#pragma unroll
                for (int bj = 0; bj < 2; ++bj) {
                    const int col = bcol + bj * 128 + wc * 32 + fq * 8;
                    float b[8];
                    if (BASE_BF16) bf8_to_f(*(const uint4*)((const bf16_t*)base + row * DM + col), b);
                    else { const float4 b0 = *(const float4*)((const float*)base + row * DM + col), b1 = *(const float4*)((const float*)base + row * DM + col + 4);
                           b[0] = b0.x; b[1] = b0.y; b[2] = b0.z; b[3] = b0.w; b[4] = b1.x; b[5] = b1.y; b[6] = b1.z; b[7] = b1.w; }
                    const float4 g0 = *(const float4*)(gt + col), g1 = *(const float4*)(gt + col + 4);
                    const f32x4 v0 = acc[ai][bj][m][0], v1 = acc[ai][bj][m][1];
                    *(uint4*)(outb + row * DM + col) = make_uint4(pack2(b[0] + g0.x * v0[0], b[1] + g0.y * v0[1]), pack2(b[2] + g0.z * v0[2], b[3] + g0.w * v0[3]),
                                                                   pack2(b[4] + g1.x * v1[0], b[5] + g1.y * v1[1]), pack2(b[6] + g1.z * v1[2], b[7] + g1.w * v1[3]));
                }
            }
    }
};
struct Epi3P {
    static constexpr bool PERM = true;
    bf16_t *xb, *gl;
    DEVI void operator()(f32x4 (&acc)[2][2][4][2], int brow, int bcol, int wr, int wc, int fr, int fq) const {
        bf16_t* dst = (bcol < 1024) ? xb : gl; const int cb = bcol & 1023;
#pragma unroll
        for (int ai = 0; ai < 2; ++ai)
#pragma unroll
            for (int m = 0; m < 4; ++m) {
                const size_t row = (size_t)brow + ai * 128 + wr * 64 + m * 16 + fr;
#pragma unroll
                for (int bj = 0; bj < 2; ++bj) {
                    const int col = cb + bj * 128 + wc * 32 + fq * 8;
                    const f32x4 v0 = acc[ai][bj][m][0], v1 = acc[ai][bj][m][1];
                    *(uint4*)(dst + row * DM + col) = make_uint4(pack2(v0[0], v0[1]), pack2(v0[2], v0[3]), pack2(v1[0], v1[1]), pack2(v1[2], v1[3]));
                }
            }
    }
};

template <bool BASE_BF16> struct EpiResB {   static constexpr bool PERM = false;
    const void* base; bf16_t* outb; const float* gate;
    DEVI void operator()(f32x4 (&acc)[2][2][4][2], int brow, int bcol, int wr, int wc, int fr, int fq) const {
        const float* gt = gate + (brow >> 12) * 3072;
#pragma unroll
        for (int ai = 0; ai < 2; ++ai)
#pragma unroll
            for (int m = 0; m < 4; ++m) {
                const size_t row = (size_t)brow + ai * 128 + wr * 64 + m * 16 + fr;
#pragma unroll
                for (int bj = 0; bj < 2; ++bj)
#pragma unroll
                    for (int n = 0; n < 2; ++n) {
                        const int col = bcol + bj * 128 + wc * 32 + n * 16 + fq * 4;
                        float b0, b1, b2, b3;
                        if (BASE_BF16) { const uint2 u = *(const uint2*)((const bf16_t*)base + row * DM + col);
                            b0 = __uint_as_float(u.x << 16); b1 = __uint_as_float(u.x & 0xffff0000u); b2 = __uint_as_float(u.y << 16); b3 = __uint_as_float(u.y & 0xffff0000u); }
                        else { const float4 bs = *(const float4*)((const float*)base + row * DM + col); b0 = bs.x; b1 = bs.y; b2 = bs.z; b3 = bs.w; }
                        const float4 g = *(const float4*)(gt + col);
                        const f32x4 v = acc[ai][bj][m][n];
                        *(uint2*)(outb + row * DM + col) = make_uint2(pack2(b0 + g.x * v[0], b1 + g.y * v[1]), pack2(b2 + g.z * v[2], b3 + g.w * v[3]));
                    }
            }
    }
};

struct Epi3 {   static constexpr bool PERM = false;
    bf16_t *xb, *gl;
    DEVI void operator()(f32x4 (&acc)[2][2][4][2], int brow, int bcol, int wr, int wc, int fr, int fq) const {
        bf16_t* dst = (bcol < 1024) ? xb : gl; const int cb = bcol & 1023;
#pragma unroll
        for (int ai = 0; ai < 2; ++ai)
#pragma unroll
            for (int m = 0; m < 4; ++m) {
                const size_t row = (size_t)brow + ai * 128 + wr * 64 + m * 16 + fr;
#pragma unroll
                for (int bj = 0; bj < 2; ++bj)
#pragma unroll
                    for (int n = 0; n < 2; ++n) {
                        const int col = cb + bj * 128 + wc * 32 + n * 16 + fq * 4;
                        const f32x4 v = acc[ai][bj][m][n];
                        *(uint2*)(dst + row * DM + col) = make_uint2(pack2(v[0], v[1]), pack2(v[2], v[3]));
                    }
            }
    }
};

constexpr float SB_EXIT = -40.0f;
DEVI void sb_tile(const bf16x8 (&kf)[2][2], const bf16x4 (&vlo)[4], const bf16x4 (&vhi)[4], const bf16x8 (&qf)[2], f32x4 (&o)[4], float& carry, const int k0, const int t, const int fq) {
    f32x4 st[2];
#pragma unroll
    for (int u2 = 0; u2 < 2; ++u2) {
        st[u2] = (f32x4){0.f, 0.f, 0.f, 0.f};
#pragma unroll
        for (int kk = 0; kk < 2; ++kk) st[u2] = __builtin_amdgcn_mfma_f32_16x16x32_bf16(kf[u2][kk], qf[kk], st[u2], 0, 0, 0);
    }
    float w[2][4];
#pragma unroll
    for (int u2 = 1; u2 >= 0; --u2) {
        float z[4], c[4]; bool valid[4];
#pragma unroll
        for (int j = 0; j < 4; ++j) {
            const int key = k0 + 16 * u2 + fq * 4 + j;
            z[j] = st[u2][j]; valid[j] = key < t;
            const float sp = fmaxf(z[j], 0.f) + 0.6931471805599453f * __builtin_amdgcn_logf(1.0f + __builtin_amdgcn_exp2f(-1.4426950408889634f * fabsf(z[j])));
            c[j] = valid[j] ? -sp : 0.f;
        }
        c[2] += c[3]; c[1] += c[2]; c[0] += c[1];
        const float T = c[0];
        const float a = T + sx16(T, fq);
        const float b2 = sx32(a, fq);
        const float above = ((fq & 1) ? 0.f : 1.f) * (a - T) + ((fq & 2) ? 0.f : 1.f) * b2;
        const float base = carry + above;
#pragma unroll
        for (int j = 0; j < 4; ++j) w[u2][j] = valid[j] ? __builtin_amdgcn_exp2f(1.4426950408889634f * (z[j] + base + c[j])) : 0.f;
        carry += a + b2;
    }
    bf16x8 pf;
    { const uint4 pu = make_uint4(pack2(w[0][0], w[0][1]), pack2(w[0][2], w[0][3]), pack2(w[1][0], w[1][1]), pack2(w[1][2], w[1][3])); pf = *(const bf16x8*)&pu; }
#pragma unroll
    for (int dt = 0; dt < 4; ++dt) {
        bf16x8 vf;
        vf[0] = vlo[dt][0]; vf[1] = vlo[dt][1]; vf[2] = vlo[dt][2]; vf[3] = vlo[dt][3];
        vf[4] = vhi[dt][0]; vf[5] = vhi[dt][1]; vf[6] = vhi[dt][2]; vf[7] = vhi[dt][3];
        o[dt] = __builtin_amdgcn_mfma_f32_16x16x32_bf16(vf, pf, o[dt], 0, 0, 0);
    }
}

DEVI void sb_tile2(const bf16x8 (&kf)[2][2], const bf16x4 (&vlo)[4], const bf16x4 (&vhi)[4], const bf16x8 (&qf)[2][2], f32x4 (&o)[4][2], float (&carry)[2], const int k0, const int tq0, const int fr, const int fq, const bool masked) {
    f32x4 st[2][2];
#pragma unroll
    for (int u2 = 0; u2 < 2; ++u2)
#pragma unroll
        for (int qt = 0; qt < 2; ++qt) st[u2][qt] = __builtin_amdgcn_mfma_f32_16x16x32_bf16(kf[u2][0], qf[qt][0], (f32x4){0.f, 0.f, 0.f, 0.f}, 0, 0, 0);
#pragma unroll
    for (int u2 = 0; u2 < 2; ++u2)
#pragma unroll
        for (int qt = 0; qt < 2; ++qt) st[u2][qt] = __builtin_amdgcn_mfma_f32_16x16x32_bf16(kf[u2][1], qf[qt][1], st[u2][qt], 0, 0, 0);
    float c[2][2][4]; bool valid[2][2][4];
#pragma unroll
    for (int u2 = 0; u2 < 2; ++u2)
#pragma unroll
        for (int qt = 0; qt < 2; ++qt)
#pragma unroll
            for (int j = 0; j < 4; ++j) {
                const float z = st[u2][qt][j];
                const float sp = fmaxf(z, 0.f) + 0.6931471805599453f * __builtin_amdgcn_logf(1.0f + __builtin_amdgcn_exp2f(-1.4426950408889634f * fabsf(z)));
                valid[u2][qt][j] = masked ? ((k0 + 16 * u2 + fq * 4 + j) < (tq0 + qt * 16 + fr)) : true;
                c[u2][qt][j] = valid[u2][qt][j] ? -sp : 0.f;
            }
#pragma unroll
    for (int u2 = 0; u2 < 2; ++u2)
#pragma unroll
        for (int qt = 0; qt < 2; ++qt) { c[u2][qt][2] += c[u2][qt][3]; c[u2][qt][1] += c[u2][qt][2]; c[u2][qt][0] += c[u2][qt][1]; }
    float a[2][2], b2[2][2];
#pragma unroll
    for (int u2 = 0; u2 < 2; ++u2)
#pragma unroll
        for (int qt = 0; qt < 2; ++qt) a[u2][qt] = c[u2][qt][0] + sx16(c[u2][qt][0], fq);
#pragma unroll
    for (int u2 = 0; u2 < 2; ++u2)
#pragma unroll
        for (int qt = 0; qt < 2; ++qt) b2[u2][qt] = sx32(a[u2][qt], fq);
    const float m1 = (fq & 1) ? 0.f : 1.f, m2 = (fq & 2) ? 0.f : 1.f;
    float w[2][2][4];
#pragma unroll
    for (int qt = 0; qt < 2; ++qt) {
        const float tot1 = a[1][qt] + b2[1][qt], tot0 = a[0][qt] + b2[0][qt];
        const float base1 = carry[qt] + m1 * (a[1][qt] - c[1][qt][0]) + m2 * b2[1][qt];
        const float base0 = carry[qt] + tot1 + m1 * (a[0][qt] - c[0][qt][0]) + m2 * b2[0][qt];
#pragma unroll
        for (int j = 0; j < 4; ++j) {
            const float e1 = __builtin_amdgcn_exp2f(1.4426950408889634f * (st[1][qt][j] + base1 + c[1][qt][j]));
            const float e0 = __builtin_amdgcn_exp2f(1.4426950408889634f * (st[0][qt][j] + base0 + c[0][qt][j]));
            w[1][qt][j] = valid[1][qt][j] ? e1 : 0.f; w[0][qt][j] = valid[0][qt][j] ? e0 : 0.f;
        }
        carry[qt] += tot1 + tot0;
    }
    bf16x8 pf[2];
#pragma unroll
    for (int qt = 0; qt < 2; ++qt) {
        const uint4 pu = make_uint4(pack2(w[0][qt][0], w[0][qt][1]), pack2(w[0][qt][2], w[0][qt][3]), pack2(w[1][qt][0], w[1][qt][1]), pack2(w[1][qt][2], w[1][qt][3]));
        pf[qt] = *(const bf16x8*)&pu;
    }
#pragma unroll
    for (int dt = 0; dt < 4; ++dt) {
        bf16x8 vf;
        vf[0] = vlo[dt][0]; vf[1] = vlo[dt][1]; vf[2] = vlo[dt][2]; vf[3] = vlo[dt][3];
        vf[4] = vhi[dt][0]; vf[5] = vhi[dt][1]; vf[6] = vhi[dt][2]; vf[7] = vhi[dt][3];
        o[dt][0] = __builtin_amdgcn_mfma_f32_16x16x32_bf16(vf, pf[0], o[dt][0], 0, 0, 0);
        o[dt][1] = __builtin_amdgcn_mfma_f32_16x16x32_bf16(vf, pf[1], o[dt][1], 0, 0, 0);
    }
}

DEVI void sb_phase(const Params& p, char* smem) {
    bf16_t* Ks = (bf16_t*)smem;
    bf16_t* Vs = (bf16_t*)(smem + 55296);
    const int tid = threadIdx.x, wave = tid >> 6, lane = tid & 63, fr = lane & 15, fq = lane >> 4;
    uint4 kq0, kq1, kq2, kq3, kq4, kq5, vq0, vq1, vq2, vq3, vq4, vq5;
#define SB_KG(q_) ((kb_ + ((tid + (q_) * 512) >> 3)) >= 0 ? *(const uint4*)(Kp_ + (size_t)(kb_ + ((tid + (q_) * 512) >> 3)) * 64 + ((tid + (q_) * 512) & 7) * 8) : make_uint4(0, 0, 0, 0))
#define SB_VG(q_) ((kb_ + ((tid + (q_) * 512) % 48) * 8) >= 0 ? *(const uint4*)(Vt_ + (size_t)((tid + (q_) * 512) / 48) * 4096 + kb_ + ((tid + (q_) * 512) % 48) * 8) : make_uint4(0, 0, 0, 0))
#define SB_LOAD(u_) do { const int bh_ = (u_) >> 4, kb_ = ((u_) & 15) * 256 - 128; \
        const bf16_t* Kp_ = p.ka + (size_t)bh_ * 4096 * 64; const bf16_t* Vt_ = p.vta + (size_t)bh_ * 64 * 4096; \
        kq0 = SB_KG(0); kq1 = SB_KG(1); kq2 = SB_KG(2); kq3 = SB_KG(3); kq4 = SB_KG(4); kq5 = SB_KG(5); \
        vq0 = SB_VG(0); vq1 = SB_VG(1); vq2 = SB_VG(2); vq3 = SB_VG(3); vq4 = SB_VG(4); vq5 = SB_VG(5); } while (0)
#define SB_KS(q_) (*(uint4*)(Ks + ((tid + (q_) * 512) >> 3) * 72 + ((tid + (q_) * 512) & 7) * 8))
#define SB_VS(q_) (*(uint4*)(Vs + ((tid + (q_) * 512) / 48) * 392 + ((tid + (q_) * 512) % 48) * 8))
    int u = blockIdx.x;
    { const int u0 = u < 2048 ? u : 0; SB_LOAD(u0); }
    for (; u < 2048; u += gridDim.x) {
        const int bh = u >> 4, t0 = (u & 15) * 256, kbase = t0 - 128;
        __syncthreads();
        SB_KS(0) = kq0; SB_KS(1) = kq1; SB_KS(2) = kq2; SB_KS(3) = kq3; SB_KS(4) = kq4; SB_KS(5) = kq5;
        SB_VS(0) = vq0; SB_VS(1) = vq1; SB_VS(2) = vq2; SB_VS(3) = vq3; SB_VS(4) = vq4; SB_VS(5) = vq5;
        __syncthreads();
        { const int un = (u + (int)gridDim.x < 2048) ? u + (int)gridDim.x : u; SB_LOAD(un); }
        const int q0 = t0 + wave * 32;
        const bf16_t* Q = p.qa + (size_t)bh * 4096 * 64;
        bf16x8 qf[2][2];
#pragma unroll
        for (int qt = 0; qt < 2; ++qt)
#pragma unroll
            for (int kk = 0; kk < 2; ++kk) qf[qt][kk] = *(const bf16x8*)(Q + (size_t)(q0 + qt * 16 + fr) * 64 + kk * 32 + fq * 8);
        f32x4 o[4][2];
#pragma unroll
        for (int dt = 0; dt < 4; ++dt) { o[dt][0] = (f32x4){0.f, 0.f, 0.f, 0.f}; o[dt][1] = (f32x4){0.f, 0.f, 0.f, 0.f}; }
        float carry[2] = {0.f, 0.f};
        const int lo = kbase > 0 ? kbase : 0;
        bool done = false;
        for (int k0 = q0; k0 >= lo; k0 -= 32) {
            const int kl = k0 - kbase;
            bf16x8 kf[2][2]; bf16x4 vlo[4], vhi[4];
#pragma unroll
            for (int u2 = 0; u2 < 2; ++u2)
#pragma unroll
                for (int kk = 0; kk < 2; ++kk) kf[u2][kk] = *(const bf16x8*)(Ks + (kl + 16 * u2 + fr) * 72 + kk * 32 + fq * 8);
#pragma unroll
            for (int dt = 0; dt < 4; ++dt) {
                vlo[dt] = *(const bf16x4*)(Vs + (dt * 16 + fr) * 392 + kl + fq * 4);
                vhi[dt] = *(const bf16x4*)(Vs + (dt * 16 + fr) * 392 + kl + 16 + fq * 4);
            }
            sb_tile2(kf, vlo, vhi, qf, o, carry, k0, q0, fr, fq, k0 == q0);
            if (__all(carry[0] < SB_EXIT && carry[1] < SB_EXIT)) { done = true; break; }
        }
        if (!done && lo > 0) {
            const bf16_t* Kp = p.ka + (size_t)bh * 4096 * 64;
            const bf16_t* Vt = p.vta + (size_t)bh * 64 * 4096;
            for (int k0 = lo - 32; k0 >= 0; k0 -= 32) {
                bf16x8 kf[2][2]; bf16x4 vlo[4], vhi[4];
#pragma unroll
                for (int u2 = 0; u2 < 2; ++u2)
#pragma unroll
                    for (int kk = 0; kk < 2; ++kk) kf[u2][kk] = *(const bf16x8*)(Kp + (size_t)(k0 + 16 * u2 + fr) * 64 + kk * 32 + fq * 8);
#pragma unroll
                for (int dt = 0; dt < 4; ++dt) {
                    vlo[dt] = *(const bf16x4*)(Vt + (size_t)(dt * 16 + fr) * 4096 + k0 + fq * 4);
                    vhi[dt] = *(const bf16x4*)(Vt + (size_t)(dt * 16 + fr) * 4096 + k0 + 16 + fq * 4);
                }
                sb_tile2(kf, vlo, vhi, qf, o, carry, k0, q0, fr, fq, false);
                if (__all(carry[0] < SB_EXIT && carry[1] < SB_EXIT)) break;
            }
        }
        const int hcol = (bh & 7) * 64;
#pragma unroll
        for (int qt = 0; qt < 2; ++qt) {
            const size_t tok = (size_t)(bh >> 3) * 4096 + q0 + qt * 16 + fr;
#pragma unroll
            for (int dt = 0; dt < 4; ++dt) {
                const int dh = dt * 16 + fq * 4;
                const uint2 gu = *(const uint2*)(p.gates + tok * 1024 + hcol + dh);
                const float g0 = bf2f((bf16_t)(gu.x & 0xffff)), g1 = bf2f((bf16_t)(gu.x >> 16)), g2 = bf2f((bf16_t)(gu.y & 0xffff)), g3 = bf2f((bf16_t)(gu.y >> 16));
                const float y0 = o[dt][qt][0] * g0 * sigmoidf_(g0), y1 = o[dt][qt][1] * g1 * sigmoidf_(g1), y2 = o[dt][qt][2] * g2 * sigmoidf_(g2), y3 = o[dt][qt][3] * g3 * sigmoidf_(g3);
                *(uint2*)(p.ypre + tok * 1024 + hcol + dh) = make_uint2(pack2(y0, y1), pack2(y2, y3));
            }
        }
    }
#undef SB_LOAD
#undef SB_KG
#undef SB_VG
#undef SB_KS
#undef SB_VS
}

constexpr float SM_C = 0.125f * 1.4426950408889634f;
constexpr int LCAP = 4096;

DEVI void moba_select_phase(const Params& p, char* smem) {
    float* km = (float*)smem;
    const int tid = threadIdx.x, wave = tid >> 6, lane = tid & 63;
    for (int w = blockIdx.x; w < 256; w += gridDim.x) {
        const int bh = w >> 1, hf = w & 1;
        __syncthreads();
        for (int i = tid; i < 1024; i += 512) km[i] = p.kmean[(size_t)bh * 1024 + i];
        __syncthreads();
        bf16x8 qv[8];
        { const bf16_t* qrow = p.qb + ((size_t)bh * 4096 + wave * 256 + hf * 128 + (lane & 31)) * 64;
#pragma unroll
          for (int c = 0; c < 8; ++c) qv[c] = *(const bf16x8*)(qrow + c * 8); }
#pragma unroll 1
        for (int ws8 = 0; ws8 < 8; ++ws8) {
            const int qb = (ws8 < 4) ? wave : 15 - wave;
            const int q = qb * 256 + (hf * 4 + (ws8 & 3)) * 32 + (lane & 31);
            bf16x8 qn[8];
            { const int wn = ws8 < 7 ? ws8 + 1 : ws8; const int qbn = (wn < 4) ? wave : 15 - wave;
              const bf16_t* qrow = p.qb + ((size_t)bh * 4096 + qbn * 256 + (hf * 4 + (wn & 3)) * 32 + (lane & 31)) * 64;
#pragma unroll
              for (int c = 0; c < 8; ++c) qn[c] = *(const bf16x8*)(qrow + c * 8); }
            float b0 = -INFINITY, b1 = -INFINITY, b2 = -INFINITY; int i0 = -1, i1 = -1, i2 = -1;
            for (int n = 0; n < qb; ++n) {
                float s = 0.f;
#pragma unroll
                for (int c = 0; c < 8; ++c) {
                    const f32x4 k0 = *(const f32x4*)(km + n * 64 + c * 8), k1 = *(const f32x4*)(km + n * 64 + c * 8 + 4);
                    s += bfs2f(qv[c][0]) * k0[0]; s += bfs2f(qv[c][1]) * k0[1]; s += bfs2f(qv[c][2]) * k0[2]; s += bfs2f(qv[c][3]) * k0[3];
                    s += bfs2f(qv[c][4]) * k1[0]; s += bfs2f(qv[c][5]) * k1[1]; s += bfs2f(qv[c][6]) * k1[2]; s += bfs2f(qv[c][7]) * k1[3];
                }
                if (s > b0) { b2 = b1; i2 = i1; b1 = b0; i1 = i0; b0 = s; i0 = n; }
                else if (s > b1) { b2 = b1; i2 = i1; b1 = s; i1 = n; }
                else if (s > b2) { b2 = s; i2 = n; }
            }
            for (int n = 0; n < qb; ++n) {
                const bool pred = (lane < 32) && (i0 == n || i1 == n || i2 == n);
                const unsigned long long mask = __ballot(pred);
                if (mask == 0ull) continue;
                const int leader = __ffsll((long long)mask) - 1;
                int base = 0;
                if (lane == leader) base = atomicAdd(p.mcnt + bh * 16 + n, __popcll(mask));
                base = __shfl(base, leader);
                if (pred) {
                    const int pos = base + __popcll(mask & ((1ull << lane) - 1ull));
                    const int j = (i0 == n) ? 0 : (i1 == n) ? 1 : 2;
                    __hip_atomic_store(p.mlist + (size_t)(bh * 16 + n) * LCAP + pos, (unsigned short)(q | (j << 12)), __ATOMIC_RELAXED, __HIP_MEMORY_SCOPE_AGENT);
                }
            }
#pragma unroll
            for (int c = 0; c < 8; ++c) qv[c] = qn[c];
        }
    }
}

template <bool MASK>
DEVI void moba_subtile(const bf16_t* Kt  , const bf16_t* Vt  , const int vstr,
                       const bf16x8 (&qf)[2][2], f32x4 (&o)[4][2], float (&mrun)[2], float (&lrun)[2], const int kl0, const int ql0, const int fr, const int fq) {
    f32x4 st[4][2];
#pragma unroll
    for (int kt = 0; kt < 4; ++kt) {
        st[kt][0] = (f32x4){0.f, 0.f, 0.f, 0.f}; st[kt][1] = (f32x4){0.f, 0.f, 0.f, 0.f};
#pragma unroll
        for (int kk = 0; kk < 2; ++kk) {
            const bf16x8 kf = *(const bf16x8*)(Kt + (kt * 16 + fr) * 72 + kk * 32 + fq * 8);
            st[kt][0] = __builtin_amdgcn_mfma_f32_16x16x32_bf16(kf, qf[0][kk], st[kt][0], 0, 0, 0);
            st[kt][1] = __builtin_amdgcn_mfma_f32_16x16x32_bf16(kf, qf[1][kk], st[kt][1], 0, 0, 0);
        }
    }
    bf16x8 pf[2][2];
    float sv[2][4][4], tmax[2], mnew[2], alpha[2], psum[2];
#pragma unroll
    for (int qt = 0; qt < 2; ++qt) {
        const int ql = ql0 + qt * 16 + fr;
        tmax[qt] = -1e30f;
#pragma unroll
        for (int kt = 0; kt < 4; ++kt)
#pragma unroll
            for (int j = 0; j < 4; ++j) {
                float v = st[kt][qt][j];
                if (MASK) { const int kl = kl0 + kt * 16 + fq * 4 + j; v = (kl <= ql) ? v : -1e30f; }
                sv[qt][kt][j] = v; tmax[qt] = fmaxf(tmax[qt], v);
            }
    }
#pragma unroll
    for (int qt = 0; qt < 2; ++qt) tmax[qt] = fmaxf(tmax[qt], sx16(tmax[qt], fq));
#pragma unroll
    for (int qt = 0; qt < 2; ++qt) tmax[qt] = fmaxf(tmax[qt], sx32(tmax[qt], fq));
#pragma unroll
    for (int qt = 0; qt < 2; ++qt) { mnew[qt] = fmaxf(mrun[qt], tmax[qt]); alpha[qt] = __builtin_amdgcn_exp2f(mrun[qt] - mnew[qt]); mrun[qt] = mnew[qt]; psum[qt] = 0.f; }
#pragma unroll
    for (int kt = 0; kt < 4; ++kt)
#pragma unroll
        for (int j = 0; j < 4; ++j)
#pragma unroll
            for (int qt = 0; qt < 2; ++qt) {
                float pv = __builtin_amdgcn_exp2f(sv[qt][kt][j] - mnew[qt]);
                if (MASK) pv = (sv[qt][kt][j] > -1e29f) ? pv : 0.f;
                sv[qt][kt][j] = pv; psum[qt] += pv;
            }
#pragma unroll
    for (int qt = 0; qt < 2; ++qt) psum[qt] += sx16(psum[qt], fq);
#pragma unroll
    for (int qt = 0; qt < 2; ++qt) psum[qt] += sx32(psum[qt], fq);
#pragma unroll
    for (int qt = 0; qt < 2; ++qt) {
        lrun[qt] = lrun[qt] * alpha[qt] + psum[qt];
#pragma unroll
        for (int dt = 0; dt < 4; ++dt) o[dt][qt] *= alpha[qt];
#pragma unroll
        for (int kk2 = 0; kk2 < 2; ++kk2) {
            const uint4 pu = make_uint4(pack2(sv[qt][2 * kk2][0], sv[qt][2 * kk2][1]), pack2(sv[qt][2 * kk2][2], sv[qt][2 * kk2][3]),
                                        pack2(sv[qt][2 * kk2 + 1][0], sv[qt][2 * kk2 + 1][1]), pack2(sv[qt][2 * kk2 + 1][2], sv[qt][2 * kk2 + 1][3]));
            pf[kk2][qt] = *(const bf16x8*)&pu;
        }
    }
#pragma unroll
    for (int dt = 0; dt < 4; ++dt)
#pragma unroll
        for (int kk2 = 0; kk2 < 2; ++kk2) {
            const uint2 lo = *(const uint2*)(Vt + (dt * 16 + fr) * vstr + kk2 * 32 + fq * 4);
            const uint2 hi = *(const uint2*)(Vt + (dt * 16 + fr) * vstr + kk2 * 32 + 16 + fq * 4);
            const uint4 vu = make_uint4(lo.x, lo.y, hi.x, hi.y);
            const bf16x8 vf = *(const bf16x8*)&vu;
            o[dt][0] = __builtin_amdgcn_mfma_f32_16x16x32_bf16(vf, pf[kk2][0], o[dt][0], 0, 0, 0);
            o[dt][1] = __builtin_amdgcn_mfma_f32_16x16x32_bf16(vf, pf[kk2][1], o[dt][1], 0, 0, 0);
        }
}

DEVI void moba_past_item(const Params& p, const int bh, const int n, char* smem) {
    bf16_t* Ks = (bf16_t*)smem;
    bf16_t* Vs = (bf16_t*)(smem + 36864);
    const int tid = threadIdx.x, wave = tid >> 6, lane = tid & 63, fr = lane & 15, fq = lane >> 4;
    const bf16_t* Qg = p.qb + (size_t)bh * 4096 * 64;
    const bf16_t* Kg = p.kb + ((size_t)bh * 4096 + (size_t)n * 256) * 64;
    const bf16_t* Vtg = p.vtb + (size_t)bh * 64 * 4096 + n * 256;
    __syncthreads();
#pragma unroll
    for (int q = 0; q < 4; ++q) {
        const int i = tid + q * 512;
        *(uint4*)(Ks + (i >> 3) * 72 + (i & 7) * 8) = *(const uint4*)(Kg + (size_t)(i >> 3) * 64 + (i & 7) * 8);
        *(uint4*)(Vs + (i >> 5) * 264 + (i & 31) * 8) = *(const uint4*)(Vtg + (size_t)(i >> 5) * 4096 + (i & 31) * 8);
    }
    __syncthreads();
    const int cnt = p.mcnt[bh * 16 + n];
    const unsigned short* lst = p.mlist + (size_t)(bh * 16 + n) * LCAP;
    const int ngroups = (cnt + 31) >> 5;
    int qidx[2], slot[2]; bool valid[2];
    bf16x8 qf[2][2];
#define D2_FETCH(g_) do { _Pragma("unroll") for (int qt = 0; qt < 2; ++qt) { const int idx = (g_) * 32 + qt * 16 + fr; valid[qt] = idx < cnt; \
        const unsigned e = lst[valid[qt] ? idx : 0]; qidx[qt] = e & 4095; slot[qt] = e >> 12; \
        _Pragma("unroll") for (int kk = 0; kk < 2; ++kk) qf[qt][kk] = *(const bf16x8*)(Qg + (size_t)qidx[qt] * 64 + kk * 32 + fq * 8); } } while (0)
    if (wave < ngroups) D2_FETCH(wave);
    for (int g = wave; g < ngroups; g += 8) {
        int cq[2], cs[2]; bool cv[2]; bf16x8 cf[2][2];
#pragma unroll
        for (int qt = 0; qt < 2; ++qt) { cq[qt] = qidx[qt]; cs[qt] = slot[qt]; cv[qt] = valid[qt]; cf[qt][0] = qf[qt][0]; cf[qt][1] = qf[qt][1]; }
        { const int gn = (g + 8 < ngroups) ? g + 8 : g; D2_FETCH(gn); }
        f32x4 o[4][2];
#pragma unroll
        for (int dt = 0; dt < 4; ++dt) { o[dt][0] = (f32x4){0.f, 0.f, 0.f, 0.f}; o[dt][1] = (f32x4){0.f, 0.f, 0.f, 0.f}; }
        float mrun[2] = {-1e30f, -1e30f}, lrun[2] = {0.f, 0.f};
#pragma unroll 1
        for (int jt = 0; jt < 4; ++jt)
            moba_subtile<false>(Ks + jt * 64 * 72, Vs + jt * 64, 264, cf, o, mrun, lrun, 0, 0, fr, fq);
#pragma unroll
        for (int qt = 0; qt < 2; ++qt) {
            if (cv[qt]) {
                const size_t pair = ((size_t)bh * 4096 + cq[qt]) * 3 + cs[qt];
                const float linv = __builtin_amdgcn_rcpf(lrun[qt]);
#pragma unroll
                for (int dt = 0; dt < 4; ++dt) {
                    const f32x4 v = o[dt][qt];
                    *(uint2*)(p.part_o + pair * 64 + dt * 16 + fq * 4) = make_uint2(pack2(v[0] * linv, v[1] * linv), pack2(v[2] * linv, v[3] * linv));
                }
                if (fq == 0) __hip_atomic_store((unsigned long long*)(p.part_ml + pair * 2), ((unsigned long long)__float_as_uint(lrun[qt]) << 32) | (unsigned long long)__float_as_uint(mrun[qt]), __ATOMIC_RELAXED, __HIP_MEMORY_SCOPE_AGENT);
            }
        }
    }
#undef D2_FETCH
}

DEVI void moba_past_phase(const Params& p, char* smem) {
    for (int w = blockIdx.x; w < 256; w += gridDim.x) {
        const int bh = w >> 1, set = w & 1;
#pragma unroll 1
        for (int n = 0; n < 15; ++n) {
            const int inA = (n == 0) | (n == 3) | (n == 4) | (n == 7) | (n == 8) | (n == 11) | (n == 12);
            if (inA == set) continue;
            moba_past_item(p, bh, n, smem);
        }
    }
}

DEVI void moba_own_item(const Params& p, const int bh, const int qb, char* smem) {
    bf16_t* Ks = (bf16_t*)smem;
    bf16_t* Vs = (bf16_t*)(smem + 36864);
    const int tid = threadIdx.x, wave = tid >> 6, lane = tid & 63, fr = lane & 15, fq = lane >> 4;
    const bf16_t* Qg = p.qb + ((size_t)bh * 4096 + (size_t)qb * 256) * 64;
    const bf16_t* Kg = p.kb + ((size_t)bh * 4096 + (size_t)qb * 256) * 64;
    const bf16_t* Vtg = p.vtb + (size_t)bh * 64 * 4096 + qb * 256;
#define OWN_K(q_) (*(const uint4*)(Kg + (size_t)((tid + (q_) * 512) >> 3) * 64 + ((tid + (q_) * 512) & 7) * 8))
#define OWN_V(q_) (*(const uint4*)(Vtg + (size_t)((tid + (q_) * 512) >> 5) * 4096 + ((tid + (q_) * 512) & 31) * 8))
    const uint4 kq0 = OWN_K(0), kq1 = OWN_K(1), kq2 = OWN_K(2), kq3 = OWN_K(3);
    const uint4 vq0 = OWN_V(0), vq1 = OWN_V(1), vq2 = OWN_V(2), vq3 = OWN_V(3);
#undef OWN_K
#undef OWN_V
    bf16x8 qf[2][2];
#pragma unroll
    for (int qt = 0; qt < 2; ++qt)
#pragma unroll
        for (int kk = 0; kk < 2; ++kk) qf[qt][kk] = *(const bf16x8*)(Qg + (size_t)(wave * 32 + qt * 16 + fr) * 64 + kk * 32 + fq * 8);
    f32x4 o[4][2];
#pragma unroll
    for (int dt = 0; dt < 4; ++dt) { o[dt][0] = (f32x4){0.f, 0.f, 0.f, 0.f}; o[dt][1] = (f32x4){0.f, 0.f, 0.f, 0.f}; }
    float mrun[2] = {-1e30f, -1e30f}, lrun[2] = {0.f, 0.f};
    const int hcol = 512 + (bh & 7) * 64;
    const int nsel = qb < 3 ? qb : 3;
    float2 pml[2][3]; uint2 po[2][3][4];
#pragma unroll
    for (int qt = 0; qt < 2; ++qt) {
        const int qs = qb * 256 + wave * 32 + qt * 16 + fr;
#pragma unroll
        for (int j = 0; j < 3; ++j) {
            const size_t pair = ((size_t)bh * 4096 + qs) * 3 + j;
            pml[qt][j] = make_float2(-1e30f, 0.f);
#pragma unroll
            for (int dt = 0; dt < 4; ++dt) po[qt][j][dt] = make_uint2(0u, 0u);
            if (j < nsel) {
                pml[qt][j] = *(const float2*)(p.part_ml + pair * 2);
#pragma unroll
                for (int dt = 0; dt < 4; ++dt) po[qt][j][dt] = *(const uint2*)(p.part_o + pair * 64 + dt * 16 + fq * 4);
            }
        }
    }
    __syncthreads();
#define OWN_KS(q_) (*(uint4*)(Ks + ((tid + (q_) * 512) >> 3) * 72 + ((tid + (q_) * 512) & 7) * 8))
#define OWN_VS(q_) (*(uint4*)(Vs + ((tid + (q_) * 512) >> 5) * 264 + ((tid + (q_) * 512) & 31) * 8))
    OWN_KS(0) = kq0; OWN_KS(1) = kq1; OWN_KS(2) = kq2; OWN_KS(3) = kq3;
    OWN_VS(0) = vq0; OWN_VS(1) = vq1; OWN_VS(2) = vq2; OWN_VS(3) = vq3;
#undef OWN_KS
#undef OWN_VS
    __syncthreads();
#pragma unroll 1
    for (int jt = 0; jt < 4; ++jt) {
        if (jt * 64 + 63 <= wave * 32)        moba_subtile<false>(Ks + jt * 64 * 72, Vs + jt * 64, 264, qf, o, mrun, lrun, 0, 0, fr, fq);
        else if (jt * 64 <= wave * 32 + 31)   moba_subtile<true>(Ks + jt * 64 * 72, Vs + jt * 64, 264, qf, o, mrun, lrun, jt * 64, wave * 32, fr, fq);
    }
#pragma unroll
    for (int qt = 0; qt < 2; ++qt) {
        float m = mrun[qt], l = lrun[qt];
        f32x4 acc[4];
#pragma unroll
        for (int dt = 0; dt < 4; ++dt) acc[dt] = o[dt][qt];
#pragma unroll
        for (int j = 0; j < 3; ++j) {
            const float2 ml = pml[qt][j];
            const float M = fmaxf(m, ml.x);
            const float wo = __builtin_amdgcn_exp2f(m - M), wj = ml.y * __builtin_amdgcn_exp2f(ml.x - M);
#pragma unroll
            for (int dt = 0; dt < 4; ++dt) {
                const uint2 ou = po[qt][j][dt];
                acc[dt][0] = acc[dt][0] * wo + wj * bf2f((bf16_t)(ou.x & 0xffff)); acc[dt][1] = acc[dt][1] * wo + wj * bf2f((bf16_t)(ou.x >> 16));
                acc[dt][2] = acc[dt][2] * wo + wj * bf2f((bf16_t)(ou.y & 0xffff)); acc[dt][3] = acc[dt][3] * wo + wj * bf2f((bf16_t)(ou.y >> 16));
            }
            l = l * wo + wj; m = M;
        }
        const float linv = __builtin_amdgcn_rcpf(l);
        const size_t tok = (size_t)(bh >> 3) * 4096 + qb * 256 + wave * 32 + qt * 16 + fr;
#pragma unroll
        for (int dt = 0; dt < 4; ++dt) {
            const int dh = dt * 16 + fq * 4;
            const uint2 gu = *(const uint2*)(p.gates + tok * 1024 + hcol + dh);
            const float g0 = bf2f((bf16_t)(gu.x & 0xffff)), g1 = bf2f((bf16_t)(gu.x >> 16)), g2 = bf2f((bf16_t)(gu.y & 0xffff)), g3 = bf2f((bf16_t)(gu.y >> 16));
            const float y0 = acc[dt][0] * linv * g0 * sigmoidf_(g0), y1 = acc[dt][1] * linv * g1 * sigmoidf_(g1);
            const float y2 = acc[dt][2] * linv * g2 * sigmoidf_(g2), y3 = acc[dt][3] * linv * g3 * sigmoidf_(g3);
            *(uint2*)(p.ypre + tok * 1024 + hcol + dh) = make_uint2(pack2(y0, y1), pack2(y2, y3));
        }
    }
}

DEVI void moba_own_phase(const Params& p, char* smem) {
    for (int it = blockIdx.x; it < 2048; it += gridDim.x) moba_own_item(p, it >> 4, it & 15, smem);
}

DEVI void lru_item(const Params& p, const int item, char* smem) {
    const int b = item >> 4, n = (item >> 1) & 7, half = item & 1;
    const int tid = threadIdx.x, wave = tid >> 6, lane = tid & 63, fr = lane & 15, fq = lane >> 4;
    bf16_t* xs = (bf16_t*)smem;
    bf16_t* wa = (bf16_t*)(smem + 35840);
    bf16_t* wx = (bf16_t*)(smem + 35840 + 17408);
    float* cw = (float*)(smem + 70656);
    float* agg = cw + 640;
    float* xcw = (float*)(smem + 81408) + wave * (16 * 68);
    bf16_t* gs = (bf16_t*)(smem + 81408 + 8 * 16 * 68 * 4);
    __syncthreads();
    for (int i = tid; i < 64 * 16; i += 512) {
        const int r = i >> 4, c = i & 15;
        *(uint4*)(wa + r * 136 + c * 8) = *(const uint4*)(p.wa_t + ((size_t)(n * 128 + half * 64 + r)) * 128 + c * 8);
        *(uint4*)(wx + r * 136 + c * 8) = *(const uint4*)(p.wx_t + ((size_t)(n * 128 + half * 64 + r)) * 128 + c * 8);
    }
    cw[tid] = p.lru_conv_w[(tid >> 7) * 1024 + n * 128 + (tid & 127)];
    if (tid < 128) cw[512 + tid] = p.lru_conv_b[n * 128 + tid];
    float ba[4], bx[4], lsl[4], hstart[4];
#pragma unroll
    for (int ct = 0; ct < 4; ++ct) {
        const int C = n * 128 + half * 64 + ct * 16 + fr;
        ba[ct] = p.lru_b_a[C]; bx[ct] = p.lru_b_x[C];
        const float lam = p.lru_lambda[C];
        lsl[ct] = -8.0f * (fmaxf(-lam, 0.f) + log1pf(expf(-fabsf(lam))));
        hstart[ct] = 0.f;
    }
    const bf16_t* xbase = p.xb + ((size_t)b * 4096) * 1024 + n * 128;
    const bf16_t* gbase = p.gl + ((size_t)b * 4096) * 1024 + n * 128 + half * 64;
    uint4 xr[5], gr0, gr1;
#define LRU_LOAD(t0_) do { \
        _Pragma("unroll") for (int q = 0; q < 5; ++q) { const int i = tid + q * 512; const int r = i >> 4, c = i & 15; const int t = (t0_) - 3 + r; \
            xr[q] = make_uint4(0, 0, 0, 0); if (i < 131 * 16 && t >= 0) xr[q] = *(const uint4*)(xbase + (size_t)t * 1024 + c * 8); } \
        gr0 = *(const uint4*)(gbase + (size_t)((t0_) + (tid >> 3)) * 1024 + (tid & 7) * 8); \
        gr1 = *(const uint4*)(gbase + (size_t)((t0_) + 64 + (tid >> 3)) * 1024 + (tid & 7) * 8); } while (0)
#define LRU_STORE() do { \
        _Pragma("unroll") for (int q = 0; q < 5; ++q) { const int i = tid + q * 512; const int r = i >> 4, c = i & 15; if (i < 131 * 16) *(uint4*)(xs + r * 136 + c * 8) = xr[q]; } \
        *(uint4*)(gs + (tid >> 3) * 72 + (tid & 7) * 8) = gr0; *(uint4*)(gs + (64 + (tid >> 3)) * 72 + (tid & 7) * 8) = gr1; } while (0)
    LRU_LOAD(0);
    LRU_STORE();
    __syncthreads();
    int par = 0;
    for (int ch = 0; ch < 32; ++ch) {
        const int t0 = ch * 128;
        { const int tn = (ch + 1 < 32) ? t0 + 128 : t0; LRU_LOAD(tn); }
        f32x4 ar[4], ax[4];
#pragma unroll
        for (int ct = 0; ct < 4; ++ct) { ar[ct] = (f32x4){0.f, 0.f, 0.f, 0.f}; ax[ct] = (f32x4){0.f, 0.f, 0.f, 0.f}; }
#pragma unroll
        for (int kk = 0; kk < 4; ++kk) {
            const int c0 = kk * 32 + fq * 8;
            float xcv[8];
            { const f32x4 b0 = *(const f32x4*)(cw + 512 + c0), b1 = *(const f32x4*)(cw + 512 + c0 + 4);
              xcv[0] = b0[0]; xcv[1] = b0[1]; xcv[2] = b0[2]; xcv[3] = b0[3]; xcv[4] = b1[0]; xcv[5] = b1[1]; xcv[6] = b1[2]; xcv[7] = b1[3]; }
#pragma unroll
            for (int tap = 0; tap < 4; ++tap) {
                const bf16x8 xv = *(const bf16x8*)(xs + (wave * 16 + fr + tap) * 136 + c0);
                const f32x4 w0 = *(const f32x4*)(cw + tap * 128 + c0), w1 = *(const f32x4*)(cw + tap * 128 + c0 + 4);
#pragma unroll
                for (int e = 0; e < 4; ++e) { xcv[e] += w0[e] * bfs2f(xv[e]); xcv[4 + e] += w1[e] * bfs2f(xv[4 + e]); }
            }
            if ((kk >> 1) == half) {
                float* d = xcw + fr * 68 + (kk & 1) * 32 + fq * 8;
                *(f32x4*)d = (f32x4){xcv[0], xcv[1], xcv[2], xcv[3]}; *(f32x4*)(d + 4) = (f32x4){xcv[4], xcv[5], xcv[6], xcv[7]};
            }
            const uint4 au = make_uint4(pack2(xcv[0], xcv[1]), pack2(xcv[2], xcv[3]), pack2(xcv[4], xcv[5]), pack2(xcv[6], xcv[7]));
            const bf16x8 af = *(const bf16x8*)&au;
#pragma unroll
            for (int ct = 0; ct < 4; ++ct) {
                const bf16x8 fa = *(const bf16x8*)(wa + (ct * 16 + fr) * 136 + c0);
                const bf16x8 fx = *(const bf16x8*)(wx + (ct * 16 + fr) * 136 + c0);
                ar[ct] = __builtin_amdgcn_mfma_f32_16x16x32_bf16(af, fa, ar[ct], 0, 0, 0);
                ax[ct] = __builtin_amdgcn_mfma_f32_16x16x32_bf16(af, fx, ax[ct], 0, 0, 0);
            }
        }
        float pa[4][4], pb[4][4];
#pragma unroll
        for (int ct = 0; ct < 4; ++ct) {
            float A[4], B[4];
#pragma unroll
            for (int j = 0; j < 4; ++j) {
                const float xc = xcw[(fq * 4 + j) * 68 + ct * 16 + fr];
                const float r = sigmoidf_(ar[ct][j] + ba[ct]);
                const float ig = sigmoidf_(ax[ct][j] + bx[ct]);
                const float av = __expf(lsl[ct] * r);
                const float mult = __builtin_amdgcn_sqrtf(fmaxf(1.0f - av * av, 0.f));
                A[j] = av; B[j] = mult * ig * xc;
            }
#pragma unroll
            for (int j = 1; j < 4; ++j) { B[j] = A[j] * B[j - 1] + B[j]; A[j] = A[j] * A[j - 1]; }
            float EA = 1.f, EB = 0.f, TA = 1.f, TB = 0.f;
#pragma unroll
            for (int g = 0; g < 4; ++g) {
                const float Ag = __shfl(A[3], fr + 16 * g), Bg = __shfl(B[3], fr + 16 * g);
                if (g < fq) { EB = Ag * EB + Bg; EA = Ag * EA; }
                TB = Ag * TB + Bg; TA = Ag * TA;
            }
#pragma unroll
            for (int j = 0; j < 4; ++j) { pa[ct][j] = A[j] * EA; pb[ct][j] = A[j] * EB + B[j]; }
            if (fq == 0) { float* ag = agg + ((par * 8 + wave) * 64 + ct * 16 + fr) * 2; ag[0] = TA; ag[1] = TB; }
        }
        __syncthreads();
#pragma unroll
        for (int ct = 0; ct < 4; ++ct) {
            float h = hstart[ct], hin = 0.f;
#pragma unroll
            for (int w = 0; w < 8; ++w) {
                const float2 ab = *(const float2*)(agg + ((par * 8 + w) * 64 + ct * 16 + fr) * 2);
                if (w == wave) hin = h;
                h = ab.x * h + ab.y;
            }
            hstart[ct] = h;
            const int C = n * 128 + half * 64 + ct * 16 + fr;
#pragma unroll
            for (int j = 0; j < 4; ++j) {
                const int tl = wave * 16 + fq * 4 + j;
                const size_t tok = (size_t)b * 4096 + t0 + tl;
                const float hs = pa[ct][j] * hin + pb[ct][j];
                const float g = bf2f(gs[tl * 72 + ct * 16 + fr]);
                p.ypre[tok * 1024 + C] = f2bf(hs * g * sigmoidf_(g));
            }
        }
        __syncthreads();
        LRU_STORE();
        __syncthreads();
        par ^= 1;
    }
#undef LRU_LOAD
#undef LRU_STORE
}

DEVI void lru_phase(const Params& p, char* smem) {
    for (int it = blockIdx.x; it < 256; it += gridDim.x) lru_item(p, it, smem);
}

#define GRID_SYNC_CG() do { asm volatile("s_waitcnt vmcnt(0) lgkmcnt(0)" ::: "memory"); grid.sync(); \
    if (threadIdx.x < 64) { __builtin_amdgcn_fence(__ATOMIC_ACQUIRE, "agent"); asm volatile("s_waitcnt vmcnt(0) lgkmcnt(0)" ::: "memory"); } __syncthreads(); } while (0)
DEVI void grid_barrier(unsigned* bar, const unsigned k, const unsigned xcc, const unsigned nx, const unsigned nxcd) {
    asm volatile("s_waitcnt vmcnt(0) lgkmcnt(0)" ::: "memory");
    __syncthreads();
    if (threadIdx.x == 0) {
        const unsigned old = __hip_atomic_fetch_add(bar + 64 * (17 + xcc), 1u, __ATOMIC_RELAXED, __HIP_MEMORY_SCOPE_AGENT);
        if (old + 1 == k * nx) {
            __builtin_amdgcn_fence(__ATOMIC_RELEASE, "agent");
            asm volatile("s_waitcnt vmcnt(0) lgkmcnt(0)" ::: "memory");
            __hip_atomic_fetch_add(bar, 1u, __ATOMIC_RELAXED, __HIP_MEMORY_SCOPE_AGENT);
        }
        while (__hip_atomic_load(bar, __ATOMIC_RELAXED, __HIP_MEMORY_SCOPE_AGENT) < k * nxcd) __builtin_amdgcn_s_sleep(1);
        __builtin_amdgcn_fence(__ATOMIC_ACQUIRE, "agent");
        asm volatile("s_waitcnt vmcnt(0) lgkmcnt(0)" ::: "memory");
    }
    __syncthreads();
}
#define GRID_SYNC() do { ++bar_k; grid_barrier(p.bar, bar_k, xcc, nx, nxcd); } while (0)
__global__ void __launch_bounds__(512, 2) mega_fwd(Params p) {
    extern __shared__ __attribute__((aligned(16))) char smem[];
    cg::grid_group grid = cg::this_grid();
    unsigned bar_k = 0;
    const unsigned xcc = (unsigned)__builtin_amdgcn_s_getreg((3 << 11) | 20) & 0xFu;
    if (threadIdx.x == 0) {
        __hip_atomic_fetch_add(p.bar + 64 * (1 + xcc), 1u, __ATOMIC_RELAXED, __HIP_MEMORY_SCOPE_AGENT);
        __hip_atomic_fetch_add(p.bar + 64 * 40, 1u, __ATOMIC_RELEASE, __HIP_MEMORY_SCOPE_AGENT);
        while (__hip_atomic_load(p.bar + 64 * 40, __ATOMIC_RELAXED, __HIP_MEMORY_SCOPE_AGENT) < gridDim.x) __builtin_amdgcn_s_sleep(1);
    }
    __syncthreads();
    if (p.bar == nullptr) GRID_SYNC_CG();
    unsigned nx = 0, nxcd = 0;
    for (unsigned j = 0; j < 16; ++j) { const unsigned c = __hip_atomic_load(p.bar + 64 * (1 + j), __ATOMIC_RELAXED, __HIP_MEMORY_SCOPE_AGENT); nxcd += (c != 0u); if (j == xcc) nx = c; }
    phase_a(p, smem);
    GRID_SYNC();
    prenorm_phase(p.x, p.norm_g, p.mod, p.h);
    GRID_SYNC();
    gemm_phase(p.h, p.wt_in0, NTOK, 4096, 1024, smem, Epi1{Epi1P{p.positions, p.kmean, p.gates, p.qa}});
    GRID_SYNC();
    moba_select_phase(p, smem);
    sb_phase(p, smem);
    GRID_SYNC();
    moba_past_phase(p, smem);
    GRID_SYNC();
    moba_own_phase(p, smem);
    GRID_SYNC();
    gemm_phase(p.ypre, p.wt_out0, NTOK, 1024, 1024, smem, EpiResP<false>{p.x, p.kb  , p.mod + 2048});
    GRID_SYNC();
    prenorm_bf_phase(p.kb, p.norm_g + 1024, p.mod + 16 * 3072, p.h);
    GRID_SYNC();
    gemm_phase(p.h, p.wt_in1, NTOK, 2048, 1024, smem, Epi3P{p.xb, p.gl});
    GRID_SYNC();
    lru_phase(p, smem);
    GRID_SYNC();
    gemm_phase(p.ypre, p.wt_out1, NTOK, 1024, 1024, smem, EpiResP<true>{p.kb, p.gates  , p.mod + 16 * 3072 + 2048});
    GRID_SYNC();
    final_norm_bf_phase(p.gates, p.out, p.final_g);
}

extern "C" void kernel_launch(void* const* d_in, const int* in_sizes, int n_in, void* d_out, int out_size, void* d_ws, size_t ws_size, hipStream_t stream) {
    constexpr size_t kDynLds = 147456;
    static int grid_blocks = 0;
    if (!grid_blocks) {
        hipFuncSetAttribute((const void*)mega_fwd, hipFuncAttributeMaxDynamicSharedMemorySize, (int)kDynLds);
        int dev = 0, cus = 0, per_cu = 0;
        hipGetDevice(&dev);
        hipDeviceGetAttribute(&cus, hipDeviceAttributeMultiprocessorCount, dev);
        hipOccupancyMaxActiveBlocksPerMultiprocessor(&per_cu, mega_fwd, 512, kDynLds);
        if (per_cu < 1) per_cu = 1;
        grid_blocks = cus * 1;
    }
    Params p{};
    p.x = (const float*)d_in[0]; p.c = (const float*)d_in[1]; p.positions = (const int*)d_in[2];
    p.norm_g = (const float*)d_in[3]; p.w_mod = (const float*)d_in[4]; p.b_mod = (const float*)d_in[5];
    p.attn_w_in = (const float*)d_in[6]; p.attn_w_out = (const float*)d_in[7]; p.lru_w_in = (const float*)d_in[8];
    p.lru_conv_w = (const float*)d_in[9]; p.lru_conv_b = (const float*)d_in[10]; p.lru_w_a = (const float*)d_in[11];
    p.lru_b_a = (const float*)d_in[12]; p.lru_w_x = (const float*)d_in[13]; p.lru_b_x = (const float*)d_in[14];
    p.lru_lambda = (const float*)d_in[15]; p.lru_w_out = (const float*)d_in[16]; p.final_g = (const float*)d_in[17];
    p.out = (float*)d_out;
    char* w = (char*)d_ws; size_t off = 0;
    auto take = [&](size_t bytes) { char* r = w + off; off += (bytes + 255) & ~(size_t)255; return r; };
    p.wt_in0 = (bf16_t*)take((size_t)4096 * 1024 * 2);
    p.wt_out0 = (bf16_t*)take((size_t)1024 * 1024 * 2);
    p.wt_in1 = (bf16_t*)take((size_t)2048 * 1024 * 2);
    p.wt_out1 = (bf16_t*)take((size_t)1024 * 1024 * 2);
    p.wa_t = (bf16_t*)take((size_t)8 * 128 * 128 * 2);
    p.wx_t = (bf16_t*)take((size_t)8 * 128 * 128 * 2);
    p.mod = (float*)take((size_t)2 * 16 * 3072 * 4);
    p.kmean = (float*)take((size_t)16 * 8 * 16 * 64 * 4);
    p.h = (bf16_t*)take((size_t)NTOK * 1024 * 2);
    const size_t hd = (size_t)16 * 8 * 4096 * 64 * 2;
    p.qa = (bf16_t*)take(hd); p.ka = (bf16_t*)take(hd); p.vta = (bf16_t*)take(hd);
    p.qb = (bf16_t*)take(hd); p.kb = (bf16_t*)take(hd); p.vtb = (bf16_t*)take(hd);
    p.gates = (bf16_t*)take((size_t)NTOK * 1024 * 2);
    p.ypre = (bf16_t*)take((size_t)NTOK * 1024 * 2);
    p.bar = (unsigned*)take(16384);
    p.mcnt = (int*)take((size_t)128 * 16 * 4);
    p.mlist = (unsigned short*)take((size_t)128 * 16 * LCAP * 2);
    p.part_ml = (float*)take((size_t)128 * 4096 * 3 * 2 * 4);
    p.part_o = (bf16_t*)take((size_t)128 * 4096 * 3 * 64 * 2);
    p.xb = p.qa;
    p.gl = p.vta;
    hipMemsetAsync(p.bar, 0, 16384, stream);
    void* args[] = {&p};
    hipError_t e = hipLaunchCooperativeKernel((const void*)mega_fwd, dim3(grid_blocks), dim3(512), args, kDynLds, stream);
    if (e != hipSuccess) fprintf(stderr, "cooperative launch failed: %s (grid %d)\n", hipGetErrorString(e), grid_blocks);
}
```

```cpp
#include <hip/hip_runtime.h>
#include <hip/hip_cooperative_groups.h>
#include <stdint.h>
#include <cstdio>
namespace cg = cooperative_groups;

#define DEVI __device__ __forceinline__
typedef unsigned short bf16_t;
typedef short bf16x8 __attribute__((ext_vector_type(8)));
typedef short bf16x4 __attribute__((ext_vector_type(4)));
typedef float f32x4 __attribute__((ext_vector_type(4)));

constexpr int NB = 16, SEQ = 4096, DM = 1024, NTOK = NB * SEQ;

struct Params {
    const float *x, *c; const int* positions;
    const float *norm_g, *w_mod, *b_mod, *attn_w_in, *attn_w_out, *lru_w_in, *lru_conv_w, *lru_conv_b,
        *lru_w_a, *lru_b_a, *lru_w_x, *lru_b_x, *lru_lambda, *lru_w_out, *final_g;
    float* out;
    bf16_t *wt_in0, *wt_out0, *wt_in1, *wt_out1, *wa_t, *wx_t;
    float *mod, *kmean, *part_ml; unsigned* bar; int* mcnt; unsigned short* mlist; bf16_t* part_o;
    bf16_t *h, *qa, *ka, *vta, *qb, *kb, *vtb, *gates, *ypre, *xb, *gl;
};

DEVI bf16_t f2bf(float f) { unsigned u = __float_as_uint(f); u += 0x7fffu + ((u >> 16) & 1u); return (bf16_t)(u >> 16); }
DEVI float bf2f(bf16_t h) { return __uint_as_float(((unsigned)h) << 16); }
DEVI float bfs2f(short h) { return __uint_as_float(((unsigned)(unsigned short)h) << 16); }
typedef __bf16 bf16x2_t __attribute__((ext_vector_type(2)));
typedef float f32x2_t __attribute__((ext_vector_type(2)));
DEVI unsigned pack2(float a, float b) { const f32x2_t v = {a, b}; const bf16x2_t h = __builtin_convertvector(v, bf16x2_t); return __builtin_bit_cast(unsigned, h); }
DEVI float wave_sum(float v) {
#pragma unroll
    for (int o = 32; o > 0; o >>= 1) v += __shfl_xor(v, o);
    return v;
}
DEVI float sx16(float x, int fq) { const auto r = __builtin_amdgcn_permlane16_swap(__float_as_uint(x), __float_as_uint(x), false, false); return __uint_as_float((fq & 1) ? r[0] : r[1]); }
DEVI float sx32(float x, int fq) { const auto r = __builtin_amdgcn_permlane32_swap(__float_as_uint(x), __float_as_uint(x), false, false); return __uint_as_float((fq & 2) ? r[0] : r[1]); }
DEVI float sigmoidf_(float x) { return __builtin_amdgcn_rcpf(1.0f + __expf(-x)); }

DEVI void transpose_tile(const float* __restrict__ W, bf16_t* Wt, int K, int N, int tile, float* lds) {
    const int tn = N >> 6; const int tk = tile / tn, tnn = tile - tk * tn; const int k0 = tk * 64, n0 = tnn * 64;
    const int tid = threadIdx.x;
#pragma unroll
    for (int i = 0; i < 2; ++i) {
        const int r = (tid >> 4) + i * 32, c4 = tid & 15;
        const float4 v = *(const float4*)(W + (size_t)(k0 + r) * N + n0 + c4 * 4);
        float* d = lds + r * 65 + c4 * 4; d[0] = v.x; d[1] = v.y; d[2] = v.z; d[3] = v.w;
    }
    __syncthreads();
    const int n = tid >> 3, kc = tid & 7;
    unsigned pk[4];
#pragma unroll
    for (int j = 0; j < 4; ++j) pk[j] = pack2(lds[(kc * 8 + 2 * j) * 65 + n], lds[(kc * 8 + 2 * j + 1) * 65 + n]);
    *(uint4*)(Wt + (size_t)(n0 + n) * K + k0 + kc * 8) = make_uint4(pk[0], pk[1], pk[2], pk[3]);
    __syncthreads();
}

DEVI void mod_unit(const Params& p, int unit, float* lds) {
    float* cl = lds;
    float* red = lds + 16384;
    const int tid = threadIdx.x;
    for (int i = tid; i < 4096; i += 512) ((float4*)cl)[i] = ((const float4*)p.c)[i];
    __syncthreads();
    const int l = unit / 96, n0 = (unit % 96) * 32; const int ks = tid >> 5, col = tid & 31;
    float acc[16];
#pragma unroll
    for (int b = 0; b < 16; ++b) acc[b] = 0.f;
    const float* w = p.w_mod + (size_t)l * 1024 * 3072 + n0 + col;
#pragma unroll 8
    for (int k = ks * 64; k < ks * 64 + 64; ++k) {
        const float wv = w[(size_t)k * 3072];
#pragma unroll
        for (int b = 0; b < 16; ++b) acc[b] += cl[b * 1024 + k] * wv;
    }
#pragma unroll
    for (int b = 0; b < 16; ++b) red[(ks * 16 + b) * 32 + col] = acc[b];
    __syncthreads();
    {
        const int b = tid >> 5; float s = 0.f;
#pragma unroll
        for (int k2 = 0; k2 < 16; ++k2) s += red[(k2 * 16 + b) * 32 + col];
        p.mod[(l * 16 + b) * 3072 + n0 + col] = s + p.b_mod[l * 3072 + n0 + col];
    }
    __syncthreads();
}

DEVI void phase_a(const Params& p, char* smem) {
    float* lds = (float*)smem;
    constexpr int U_MOD = 192, T_IN0 = 16 * 64, T_OUT0 = 16 * 16, T_IN1 = 16 * 32, T_OUT1 = 16 * 16, T_G = 8 * 4;
    constexpr int TOTAL = U_MOD + T_IN0 + T_OUT0 + T_IN1 + T_OUT1 + 2 * T_G;
    for (int u = blockIdx.x; u < TOTAL; u += gridDim.x) {
        int v = u;
        if (v < U_MOD) { mod_unit(p, v, lds); continue; } v -= U_MOD;
        if (v < T_IN0) { transpose_tile(p.attn_w_in, p.wt_in0, 1024, 4096, v, lds); continue; } v -= T_IN0;
        if (v < T_OUT0) { transpose_tile(p.attn_w_out, p.wt_out0, 1024, 1024, v, lds); continue; } v -= T_OUT0;
        if (v < T_IN1) { transpose_tile(p.lru_w_in, p.wt_in1, 1024, 2048, v, lds); continue; } v -= T_IN1;
        if (v < T_OUT1) { transpose_tile(p.lru_w_out, p.wt_out1, 1024, 1024, v, lds); continue; } v -= T_OUT1;
        if (v < T_G) { const int blk = v >> 2; transpose_tile(p.lru_w_a + blk * 16384, p.wa_t + blk * 16384, 128, 128, v & 3, lds); continue; } v -= T_G;
        { const int blk = v >> 2; transpose_tile(p.lru_w_x + blk * 16384, p.wx_t + blk * 16384, 128, 128, v & 3, lds); }
    }
    for (int i = blockIdx.x * 512 + threadIdx.x; i < 16 * 8 * 16 * 64; i += gridDim.x * 512) __hip_atomic_store(p.kmean + i, 0.f, __ATOMIC_RELAXED, __HIP_MEMORY_SCOPE_AGENT);
    for (int i = blockIdx.x * 512 + threadIdx.x; i < 128 * 16; i += gridDim.x * 512) __hip_atomic_store(p.mcnt + i, 0, __ATOMIC_RELAXED, __HIP_MEMORY_SCOPE_AGENT);
}

DEVI void prenorm_phase(const float* xin, const float* __restrict__ g, const float* modl, bf16_t* hout) {
    const int wave = threadIdx.x >> 6, lane = threadIdx.x & 63;
    const int stride = gridDim.x * 8;
    int row = blockIdx.x * 8 + wave;
    float4 nx[4];
#pragma unroll
    for (int i = 0; i < 4; ++i) nx[i] = ((const float4*)(xin + (size_t)(row < NTOK ? row : 0) * DM))[lane + 64 * i];
    for (; row < NTOK; row += stride) {
        float4 v[4]; float ss = 0.f;
#pragma unroll
        for (int i = 0; i < 4; ++i) { v[i] = nx[i]; ss += v[i].x * v[i].x + v[i].y * v[i].y + v[i].z * v[i].z + v[i].w * v[i].w; }
        { const int rn = (row + stride < NTOK) ? row + stride : row;
#pragma unroll
          for (int i = 0; i < 4; ++i) nx[i] = ((const float4*)(xin + (size_t)rn * DM))[lane + 64 * i]; }
        ss = wave_sum(ss);
        const float rinv = rsqrtf(ss * (1.0f / 1024.0f) + 1e-6f);
        const float* md = modl + (row >> 12) * 3072;
#pragma unroll
        for (int i = 0; i < 4; ++i) {
            const int k = (lane + 64 * i) * 4;
            const float4 gg = *(const float4*)(g + k), sh = *(const float4*)(md + k), sc = *(const float4*)(md + 1024 + k);
            const float o0 = v[i].x * rinv * gg.x * (1.f + sc.x) + sh.x, o1 = v[i].y * rinv * gg.y * (1.f + sc.y) + sh.y;
            const float o2 = v[i].z * rinv * gg.z * (1.f + sc.z) + sh.z, o3 = v[i].w * rinv * gg.w * (1.f + sc.w) + sh.w;
            *(uint2*)(hout + (size_t)row * DM + k) = make_uint2(pack2(o0, o1), pack2(o2, o3));
        }
    }
}

DEVI void bf8_to_f(const uint4 u, float (&f)[8]) {
    f[0] = __uint_as_float(u.x << 16); f[1] = __uint_as_float(u.x & 0xffff0000u); f[2] = __uint_as_float(u.y << 16); f[3] = __uint_as_float(u.y & 0xffff0000u);
    f[4] = __uint_as_float(u.z << 16); f[5] = __uint_as_float(u.z & 0xffff0000u); f[6] = __uint_as_float(u.w << 16); f[7] = __uint_as_float(u.w & 0xffff0000u);
}
DEVI void prenorm_bf_phase(const bf16_t* xin, const float* __restrict__ g, const float* modl, bf16_t* hout) {
    const int wave = threadIdx.x >> 6, lane = threadIdx.x & 63;
    const int stride = gridDim.x * 8;
    int row = blockIdx.x * 8 + wave;
    uint4 nx0 = ((const uint4*)(xin + (size_t)(row < NTOK ? row : 0) * DM))[lane], nx1 = ((const uint4*)(xin + (size_t)(row < NTOK ? row : 0) * DM))[lane + 64];
    for (; row < NTOK; row += stride) {
        float v[2][8]; float ss = 0.f;
        bf8_to_f(nx0, v[0]); bf8_to_f(nx1, v[1]);
        { const int rn = (row + stride < NTOK) ? row + stride : row;
          nx0 = ((const uint4*)(xin + (size_t)rn * DM))[lane]; nx1 = ((const uint4*)(xin + (size_t)rn * DM))[lane + 64]; }
#pragma unroll
        for (int i = 0; i < 2; ++i)
#pragma unroll
            for (int e = 0; e < 8; ++e) ss += v[i][e] * v[i][e];
        ss = wave_sum(ss);
        const float rinv = rsqrtf(ss * (1.0f / 1024.0f) + 1e-6f);
        const float* md = modl + (row >> 12) * 3072;
#pragma unroll
        for (int i = 0; i < 2; ++i) {
            const int k = (lane + 64 * i) * 8;
            float o[8];
#pragma unroll
            for (int h2 = 0; h2 < 2; ++h2) {
                const float4 gg = *(const float4*)(g + k + 4 * h2), sh = *(const float4*)(md + k + 4 * h2), sc = *(const float4*)(md + 1024 + k + 4 * h2);
                o[4 * h2 + 0] = v[i][4 * h2 + 0] * rinv * gg.x * (1.f + sc.x) + sh.x; o[4 * h2 + 1] = v[i][4 * h2 + 1] * rinv * gg.y * (1.f + sc.y) + sh.y;
                o[4 * h2 + 2] = v[i][4 * h2 + 2] * rinv * gg.z * (1.f + sc.z) + sh.z; o[4 * h2 + 3] = v[i][4 * h2 + 3] * rinv * gg.w * (1.f + sc.w) + sh.w;
            }
            *(uint4*)(hout + (size_t)row * DM + k) = make_uint4(pack2(o[0], o[1]), pack2(o[2], o[3]), pack2(o[4], o[5]), pack2(o[6], o[7]));
        }
    }
}
DEVI void final_norm_bf_phase(const bf16_t* xin, float* out, const float* __restrict__ g) {
    const int wave = threadIdx.x >> 6, lane = threadIdx.x & 63;
    const int stride = gridDim.x * 8;
    int row = blockIdx.x * 8 + wave;
    uint4 nx0 = ((const uint4*)(xin + (size_t)(row < NTOK ? row : 0) * DM))[lane], nx1 = ((const uint4*)(xin + (size_t)(row < NTOK ? row : 0) * DM))[lane + 64];
    for (; row < NTOK; row += stride) {
        float v[2][8]; float ss = 0.f;
        bf8_to_f(nx0, v[0]); bf8_to_f(nx1, v[1]);
        { const int rn = (row + stride < NTOK) ? row + stride : row;
          nx0 = ((const uint4*)(xin + (size_t)rn * DM))[lane]; nx1 = ((const uint4*)(xin + (size_t)rn * DM))[lane + 64]; }
#pragma unroll
        for (int i = 0; i < 2; ++i)
#pragma unroll
            for (int e = 0; e < 8; ++e) ss += v[i][e] * v[i][e];
        ss = wave_sum(ss);
        const float rinv = rsqrtf(ss * (1.0f / 1024.0f) + 1e-6f);
#pragma unroll
        for (int i = 0; i < 2; ++i) {
            const int k = (lane + 64 * i) * 8;
#pragma unroll
            for (int h2 = 0; h2 < 2; ++h2) {
                const float4 gg = *(const float4*)(g + k + 4 * h2);
                float4 o; o.x = v[i][4 * h2 + 0] * rinv * gg.x; o.y = v[i][4 * h2 + 1] * rinv * gg.y; o.z = v[i][4 * h2 + 2] * rinv * gg.z; o.w = v[i][4 * h2 + 3] * rinv * gg.w;
                *(float4*)(out + (size_t)row * DM + k + 4 * h2) = o;
            }
        }
    }
}

DEVI void final_norm_phase(float* xio, const float* __restrict__ g) {
    const int wave = threadIdx.x >> 6, lane = threadIdx.x & 63;
    for (int row = blockIdx.x * 8 + wave; row < NTOK; row += gridDim.x * 8) {
        float4* xr = (float4*)(xio + (size_t)row * DM);
        float4 v[4]; float ss = 0.f;
#pragma unroll
        for (int i = 0; i < 4; ++i) { v[i] = xr[lane + 64 * i]; ss += v[i].x * v[i].x + v[i].y * v[i].y + v[i].z * v[i].z + v[i].w * v[i].w; }
        ss = wave_sum(ss);
        const float rinv = rsqrtf(ss * (1.0f / 1024.0f) + 1e-6f);
#pragma unroll
        for (int i = 0; i < 4; ++i) {
            const float4 gg = *(const float4*)(g + (lane + 64 * i) * 4);
            float4 o; o.x = v[i].x * rinv * gg.x; o.y = v[i].y * rinv * gg.y; o.z = v[i].z * rinv * gg.z; o.w = v[i].w * rinv * gg.w;
            xr[lane + 64 * i] = o;
        }
    }
}

#define LAS __attribute__((address_space(3)))
constexpr int BM = 256, BK = 64, HALF = 128, HTB = HALF * BK * 2, NXCD = 8, WGM = 8;
DEVI int lds_byte(int r, int c) { const int st = (r >> 4) * 2 + (c >> 5), rr = r & 15, cc = c & 31, ob = rr * 64 + cc * 2; return st * 1024 + (ob ^ (((ob >> 9) & 1) << 5)); }
DEVI void stage_rc(int b, int& R, int& C) { const int st = b / 1024, sb = b % 1024, swz = sb ^ (((sb >> 9) & 1) << 5); R = (st >> 1) * 16 + swz / 64; C = (st & 1) * 32 + (swz % 64) / 2; }
DEVI int perm32(int rho) { const int n = rho >> 4, i = rho & 15; return 8 * (i >> 2) + 4 * n + (i & 3); }
struct Unit { int pm, pn; };
struct StaticOrder {
    int nM, nN, nwg, G, c;
    DEVI void init(int M, int N, int G_, int c_) { nM = M / BM; nN = N / BM; nwg = nM * nN; G = G_; c = c_; }
    DEVI bool next(int i, Unit& u) const {
        const long L = (long)i * G + c; if (L >= nwg) return false;
        int wgid = (int)L; { const int q = nwg / NXCD, r = nwg % NXCD, xcd = wgid % NXCD, off = wgid / NXCD; wgid = (xcd < r ? xcd * (q + 1) : r * (q + 1) + (xcd - r) * q) + off; }
        const int nig = WGM * nN, gid = wgid / nig, fm = gid * WGM, gsz = (nM - fm) < WGM ? (nM - fm) : WGM;
        u.pm = fm + ((wgid % nig) % gsz); u.pn = (wgid % nig) / gsz; return true;
    }
};

template <class Epi>
DEVI void gemm_phase(const bf16_t* gA, const bf16_t* gBt, const int M, const int N, const int K, char* smem, const Epi& E) {
    LAS unsigned char* lds = (LAS unsigned char*)smem;
    StaticOrder S; S.init(M, N, gridDim.x, blockIdx.x);
    int tid = threadIdx.x; asm volatile("" : "+v"(tid));
    const int wid = __builtin_amdgcn_readfirstlane(tid >> 6), lane = tid & 63, wr = wid >> 2, wc = wid & 3, fr = lane & 15, fq = lane >> 4;
    const int nt = K / BK;
    unsigned voffA[2], voffB[2];
#pragma unroll
    for (int i = 0; i < 2; ++i) { int R, C; stage_rc(tid * 16 + i * 8192, R, C); voffA[i] = (unsigned)(R * K + C) * 2u;
        const int Rb = Epi::PERM ? ((R & ~31) + perm32(R & 31)) : R; voffB[i] = (unsigned)(Rb * K + C) * 2u; }
    const size_t kstep = (size_t)(BK * 2);
    const size_t hstep = (size_t)HALF * K * 2;
    const size_t tstep = 2 * hstep;
    const unsigned ldsw = (unsigned)wid * 1024u;
    const int aoff = lds_byte(wr * 64 + fr, fq * 8), boff = lds_byte(wc * 32 + fr, fq * 8);
#define PG8_SA(b, h) (((b) * 2 + (h)) * HTB)
#define PG8_SB(b, h) ((4 + (b) * 2 + (h)) * HTB)
#define PG8_STAGE(bufoff, gbase, voff) do { _Pragma("unroll") for (int _i = 0; _i < 2; ++_i) \
        __builtin_amdgcn_global_load_lds((const __attribute__((address_space(1))) unsigned*)((const char*)(gbase) + (voff)[_i]), (LAS unsigned*)(lds + (bufoff) + ldsw + _i * 8192), 16, 0, 0); } while (0)
#define PG8_LDA(dst, b, h) do { _Pragma("unroll") for (int m = 0; m < 4; ++m) _Pragma("unroll") for (int k = 0; k < 2; ++k) dst[m][k] = *(const LAS bf16x8*)(lds + PG8_SA(b, h) + aoff + m * 2048 + k * 1024); } while (0)
#define PG8_LDB(dst, b, h) do { _Pragma("unroll") for (int n = 0; n < 2; ++n) _Pragma("unroll") for (int k = 0; k < 2; ++k) dst[n][k] = *(const LAS bf16x8*)(lds + PG8_SB(b, h) + boff + n * 2048 + k * 1024); } while (0)
#define PG8_MMA(ai, bj, At, Bt) do { __builtin_amdgcn_s_setprio(1); _Pragma("unroll") for (int m = 0; m < 4; ++m) _Pragma("unroll") for (int n = 0; n < 2; ++n) _Pragma("unroll") for (int k = 0; k < 2; ++k) \
        acc[ai][bj][m][n] = __builtin_amdgcn_mfma_f32_16x16x32_bf16(Bt[n][k], At[m][k], acc[ai][bj][m][n], 0, 0, 0); __builtin_amdgcn_s_setprio(0); } while (0)
#define PG8_WAIT_V(n) asm volatile("s_waitcnt vmcnt(" #n ")" ::: "memory")
#define PG8_WAIT_L(n) asm volatile("s_waitcnt lgkmcnt(" #n ")" ::: "memory")
#define PG8_BAR __builtin_amdgcn_s_barrier()
#define PG8_SCHED __builtin_amdgcn_sched_barrier(0)
    Unit cur, nxt; int ui = 0;
    if (!S.next(0, cur)) return;
    f32x4 acc[2][2][4][2];
#pragma unroll
    for (int a = 0; a < 2; ++a)
#pragma unroll
        for (int b = 0; b < 2; ++b)
#pragma unroll
            for (int m = 0; m < 4; ++m)
#pragma unroll
                for (int n = 0; n < 2; ++n) acc[a][b][m][n] = (f32x4){0.f, 0.f, 0.f, 0.f};
    bf16x8 At[4][2], B0[2][2], B1[2][2];
    const char* cA = (const char*)gA + (size_t)cur.pm * tstep; const char* cB = (const char*)gBt + (size_t)cur.pn * tstep;
    PG8_STAGE(PG8_SB(0, 0), cB, voffB); PG8_STAGE(PG8_SB(0, 1), cB + hstep, voffB); PG8_STAGE(PG8_SA(0, 0), cA, voffA); PG8_STAGE(PG8_SA(0, 1), cA + hstep, voffA);
    if (wr == 1) PG8_BAR;
    PG8_WAIT_V(2); PG8_BAR;
    PG8_STAGE(PG8_SB(1, 0), cB + kstep, voffB); PG8_STAGE(PG8_SA(1, 0), cA + kstep, voffA); PG8_STAGE(PG8_SB(1, 1), cB + hstep + kstep, voffB);
    PG8_WAIT_V(6); PG8_BAR;
    for (;;) {
        const bool has_next = S.next(ui + 1, nxt);
        const char* nA = has_next ? (const char*)gA + (size_t)nxt.pm * tstep : cA; const char* nB = has_next ? (const char*)gBt + (size_t)nxt.pn * tstep : cB;
        for (int t = 0; t < nt; t += 2) {
            const bool last = (t == nt - 2);
            const char* a1 = cA + (size_t)(t + 1) * kstep;
            const char* a2 = last ? nA : cA + (size_t)(t + 2) * kstep; const char* b2 = last ? nB : cB + (size_t)(t + 2) * kstep;
            const char* a3 = a2 + kstep; const char* b3 = b2 + kstep;
            PG8_LDB(B0, 0, 0); PG8_LDB(B1, 0, 1); PG8_SCHED; PG8_LDA(At, 0, 0); PG8_STAGE(PG8_SA(1, 1), a1 + hstep, voffA);
            PG8_WAIT_V(8); PG8_WAIT_L(0); PG8_BAR; PG8_MMA(0, 0, At, B0); PG8_MMA(0, 1, At, B1); PG8_BAR; PG8_SCHED;
            PG8_LDA(At, 0, 1); PG8_STAGE(PG8_SB(0, 0), b2, voffB); PG8_STAGE(PG8_SB(0, 1), b2 + hstep, voffB); PG8_STAGE(PG8_SA(0, 0), a2, voffA);
            PG8_WAIT_V(8); PG8_WAIT_L(0); PG8_BAR; PG8_MMA(1, 0, At, B0); PG8_MMA(1, 1, At, B1); PG8_BAR; PG8_SCHED;
            PG8_LDB(B0, 1, 0); PG8_LDB(B1, 1, 1); PG8_SCHED; PG8_LDA(At, 1, 0); PG8_STAGE(PG8_SA(0, 1), a2 + hstep, voffA);
            PG8_WAIT_V(8); PG8_WAIT_L(0); PG8_BAR; PG8_MMA(0, 0, At, B0); PG8_MMA(0, 1, At, B1); PG8_BAR; PG8_SCHED;
            PG8_LDA(At, 1, 1); PG8_STAGE(PG8_SB(1, 0), b3, voffB); PG8_STAGE(PG8_SB(1, 1), b3 + hstep, voffB); PG8_STAGE(PG8_SA(1, 0), a3, voffA);
            PG8_WAIT_V(8); PG8_WAIT_L(0); PG8_BAR; PG8_MMA(1, 0, At, B0); PG8_MMA(1, 1, At, B1); PG8_BAR; PG8_SCHED;
        }
        if (wr == 0) PG8_BAR;
        E(acc, cur.pm * BM, cur.pn * BM, wr, wc, fr, fq);
        PG8_WAIT_V(0);
        if (!has_next) break;
#pragma unroll
        for (int a = 0; a < 2; ++a)
#pragma unroll
            for (int b = 0; b < 2; ++b)
#pragma unroll
                for (int m = 0; m < 4; ++m)
#pragma unroll
                    for (int n = 0; n < 2; ++n) acc[a][b][m][n] = (f32x4){0.f, 0.f, 0.f, 0.f};
        cur = nxt; cA = nA; cB = nB; ++ui;
        if (wr == 1) PG8_BAR;
    }
    PG8_WAIT_V(0);
    PG8_BAR;
#undef PG8_SA
#undef PG8_SB
#undef PG8_STAGE
#undef PG8_LDA
#undef PG8_LDB
#undef PG8_MMA
}

constexpr size_t HD = (size_t)16 * 8 * 4096 * 64;
struct Epi1P { const int* positions; float* kmean; bf16_t* gates; bf16_t* qkv; };
struct Epi1 {
    static constexpr bool PERM = true;
    Epi1P p;
    DEVI void operator()(f32x4 (&acc)[2][2][4][2], int brow, int bcol, int wr, int wc, int fr, int fq) const {
        const int grp = bcol >> 9, cbase = bcol & 511;
        const int b = brow >> 12, s0 = brow & 4095;
        if ((grp == 3 || grp == 4) && ((wc & 1) == 0)) {
            const float invt[8] = {1.0f, 0.19392274474868576f, 0.03760603093086393f, 0.007292664737217109f,
                                   0.001414213562373095f, 0.0002742481756762073f, 5.318295896944988e-05f, 1.031338537721246e-05f};
#pragma unroll
            for (int ai = 0; ai < 2; ++ai)
#pragma unroll
                for (int m = 0; m < 4; ++m) {
                    const int s = s0 + ai * 128 + wr * 64 + m * 16 + fr;
                    const float pos = (float)p.positions[b * 4096 + s];
#pragma unroll
                    for (int n = 0; n < 2; ++n)
#pragma unroll
                        for (int j = 0; j < 4; ++j) {
                            const float ang = pos * invt[n * 4 + j];
                            const float rvf = __builtin_amdgcn_fractf(ang * 0.15915494309189535f);
                            const float sn = __builtin_amdgcn_sinf(rvf), cs = __builtin_amdgcn_cosf(rvf);
#pragma unroll
                            for (int bj = 0; bj < 2; ++bj) {
                                const float v = acc[ai][bj][m][n][j];
                                const float pr = sx16(v, fq);
                                const float rot = (fq == 0) ? (v * cs - pr * sn) : (v * cs + pr * sn);
                                acc[ai][bj][m][n][j] = (fq < 2) ? rot : v;
                            }
                        }
                }
        }
        if (grp == 4) {
            const int nblk = s0 >> 8;
#pragma unroll
            for (int bj = 0; bj < 2; ++bj)
#pragma unroll
                for (int n = 0; n < 2; ++n)
#pragma unroll
                    for (int j = 0; j < 4; ++j) {
                        float cs = 0.f;
#pragma unroll
                        for (int ai = 0; ai < 2; ++ai)
#pragma unroll
                            for (int m = 0; m < 4; ++m) cs += acc[ai][bj][m][n][j];
                        cs += __shfl_xor(cs, 1); cs += __shfl_xor(cs, 2); cs += __shfl_xor(cs, 4); cs += __shfl_xor(cs, 8);
                        if (fr == 0) {
                            const int colg = cbase + bj * 128 + wc * 32 + fq * 8 + n * 4 + j;
                            atomicAdd(p.kmean + ((size_t)((b * 8 + (colg >> 6)) * 16 + nblk)) * 64 + (colg & 63), cs);
                        }
                    }
        }
        if (grp >= 6) {
#pragma unroll
            for (int ai = 0; ai < 2; ++ai)
#pragma unroll
                for (int m = 0; m < 4; ++m) {
                    const size_t tok = (size_t)brow + ai * 128 + wr * 64 + m * 16 + fr;
#pragma unroll
                    for (int bj = 0; bj < 2; ++bj) {
                        const int gc = (grp - 6) * 512 + cbase + bj * 128 + wc * 32 + fq * 8;
                        const f32x4 v0 = acc[ai][bj][m][0], v1 = acc[ai][bj][m][1];
                        *(uint4*)(p.gates + tok * 1024 + gc) = make_uint4(pack2(v0[0], v0[1]), pack2(v0[2], v0[3]), pack2(v1[0], v1[1]), pack2(v1[2], v1[3]));
                    }
                }
        } else if (grp == 2 || grp == 5) {
            bf16_t* dst = p.qkv + (size_t)grp * HD;
#pragma unroll
            for (int ai = 0; ai < 2; ++ai)
#pragma unroll
                for (int m = 0; m < 4; ++m) {
                    const int s = s0 + ai * 128 + wr * 64 + m * 16 + fr;
#pragma unroll
                    for (int bj = 0; bj < 2; ++bj)
#pragma unroll
                        for (int n = 0; n < 2; ++n) {
                            const int colg = cbase + bj * 128 + wc * 32 + fq * 8 + n * 4;
                            const f32x4 v = acc[ai][bj][m][n];
                            bf16_t* d0 = dst + ((size_t)((b * 8 + (colg >> 6)) * 64 + (colg & 63))) * 4096 + s;
#pragma unroll
                            for (int j = 0; j < 4; ++j) d0[(size_t)j * 4096] = f2bf(v[j]);
                        }
                }
        } else {
            bf16_t* dst = p.qkv + (size_t)grp * HD;
            const float qsc = (grp == 0) ? 0.125f : (grp == 3) ? (0.125f * 1.4426950408889634f) : 1.0f;
#pragma unroll
            for (int ai = 0; ai < 2; ++ai)
#pragma unroll
                for (int m = 0; m < 4; ++m) {
                    const int s = s0 + ai * 128 + wr * 64 + m * 16 + fr;
#pragma unroll
                    for (int bj = 0; bj < 2; ++bj) {
                        const int colg = cbase + bj * 128 + wc * 32 + fq * 8;
                        const f32x4 v0 = acc[ai][bj][m][0], v1 = acc[ai][bj][m][1];
                        *(uint4*)(dst + ((size_t)((b * 8 + (colg >> 6)) * 4096 + s)) * 64 + (colg & 63)) =
                            make_uint4(pack2(v0[0] * qsc, v0[1] * qsc), pack2(v0[2] * qsc, v0[3] * qsc), pack2(v1[0] * qsc, v1[1] * qsc), pack2(v1[2] * qsc, v1[3] * qsc));
                    }
                }
        }
    }
};

struct EpiRes {
    static constexpr bool PERM = false;
    const float* base; float* out; const float* gate;
    DEVI void operator()(f32x4 (&acc)[2][2][4][2], int brow, int bcol, int wr, int wc, int fr, int fq) const {
        const float* gt = gate + (brow >> 12) * 3072;
#pragma unroll
        for (int ai = 0; ai < 2; ++ai)
#pragma unroll
            for (int m = 0; m < 4; ++m) {
                const size_t row = (size_t)brow + ai * 128 + wr * 64 + m * 16 + fr;
#pragma unroll
                for (int bj = 0; bj < 2; ++bj)
#pragma unroll
                    for (int n = 0; n < 2; ++n) {
                        const int col = bcol + bj * 128 + wc * 32 + n * 16 + fq * 4;
                        const float4 bs = *(const float4*)(base + row * DM + col);
                        const float4 g = *(const float4*)(gt + col);
                        const f32x4 v = acc[ai][bj][m][n];
                        float4 o; o.x = bs.x + g.x * v[0]; o.y = bs.y + g.y * v[1]; o.z = bs.z + g.z * v[2]; o.w = bs.w + g.w * v[3];
                        *(float4*)(out + row * DM + col) = o;
                    }
            }
    }
};

template <bool BASE_BF16> struct EpiResP {
    static constexpr bool PERM = true;
    const void* base; bf16_t* outb; const float* gate;
    DEVI void operator()(f32x4 (&acc)[2][2][4][2], int brow, int bcol, int wr, int wc, int fr, int fq) const {
        const float* gt = gate + (brow >> 12) * 3072;
#pragma unroll
        for (int ai = 0; ai < 2; ++ai)
#pragma unroll
            for (int m = 0; m < 4; ++m) {
                const size_t row = (size_t)brow + ai * 128 + wr * 64 + m * 16 + fr;
#pragma unroll
                for (int bj = 0; bj < 2; ++bj) {
                    const int col = bcol + bj * 128 + wc * 32 + fq * 8;
                    float b[8];
                    if (BASE_BF16) bf8_to_f(*(const uint4*)((const bf16_t*)base + row * DM + col), b);
                    else { const float4 b0 = *(const float4*)((const float*)base + row * DM + col), b1 = *(const float4*)((const float*)base + row * DM + col + 4);
                           b[0] = b0.x; b[1] = b0.y; b[2] = b0.z; b[3] = b0.w; b[4] = b1.x; b[5] = b1.y; b[6] = b1.z; b[7] = b1.w; }
                    const float4 g0 = *(const float4*)(gt + col), g1 = *(const float4*)(gt + col + 4);
                    const f32x4 v0 = acc[ai][bj][m][0], v1 = acc[ai][bj][m][1];
                    *(uint4*)(outb + row * DM + col) = make_uint4(pack2(b[0] + g0.x * v0[0], b[1] + g0.y * v0[1]), pack2(b[2] + g0.z * v0[2], b[3] + g0.w * v0[3]),
                                                                   pack2(b[4] + g1.x * v1[0], b[5] + g1.y * v1[1]), pack2(b[6] + g1.z * v1[2], b[7] + g1.w * v1[3]));
                }
            }
    }
};
struct Epi3P {
    static constexpr bool PERM = true;
    bf16_t *xb, *gl;
    DEVI void operator()(f32x4 (&acc)[2][2][4][2], int brow, int bcol, int wr, int wc, int fr, int fq) const {
        bf16_t* dst = (bcol < 1024) ? xb : gl; const int cb = bcol & 1023;
#pragma unroll
        for (int ai = 0; ai < 2; ++ai)
#pragma unroll
            for (int m = 0; m < 4; ++m) {
                const size_t row = (size_t)brow + ai * 128 + wr * 64 + m * 16 + fr;
#pragma unroll
                for (int bj = 0; bj < 2; ++bj) {
                    const int col = cb + bj * 128 + wc * 32 + fq * 8;
                    const f32x4 v0 = acc[ai][bj][m][0], v1 = acc[ai][bj][m][1];
                    *(uint4*)(dst + row * DM + col) = make_uint4(pack2(v0[0], v0[1]), pack2(v0[2], v0[3]), pack2(v1[0], v1[1]), pack2(v1[2], v1[3]));
                }
            }
    }
};

template <bool BASE_BF16> struct EpiResB {   static constexpr bool PERM = false;
    const void* base; bf16_t* outb; const float* gate;
    DEVI void operator()(f32x4 (&acc)[2][2][4][2], int brow, int bcol, int wr, int wc, int fr, int fq) const {
        const float* gt = gate + (brow >> 12) * 3072;
#pragma unroll
        for (int ai = 0; ai < 2; ++ai)
#pragma unroll
            for (int m = 0; m < 4; ++m) {
                const size_t row = (size_t)brow + ai * 128 + wr * 64 + m * 16 + fr;
#pragma unroll
                for (int bj = 0; bj < 2; ++bj)
#pragma unroll
                    for (int n = 0; n < 2; ++n) {
                        const int col = bcol + bj * 128 + wc * 32 + n * 16 + fq * 4;
                        float b0, b1, b2, b3;
                        if (BASE_BF16) { const uint2 u = *(const uint2*)((const bf16_t*)base + row * DM + col);
                            b0 = __uint_as_float(u.x << 16); b1 = __uint_as_float(u.x & 0xffff0000u); b2 = __uint_as_float(u.y << 16); b3 = __uint_as_float(u.y & 0xffff0000u); }
                        else { const float4 bs = *(const float4*)((const float*)base + row * DM + col); b0 = bs.x; b1 = bs.y; b2 = bs.z; b3 = bs.w; }
                        const float4 g = *(const float4*)(gt + col);
                        const f32x4 v = acc[ai][bj][m][n];
                        *(uint2*)(outb + row * DM + col) = make_uint2(pack2(b0 + g.x * v[0], b1 + g.y * v[1]), pack2(b2 + g.z * v[2], b3 + g.w * v[3]));
                    }
            }
    }
};

struct Epi3 {   static constexpr bool PERM = false;
    bf16_t *xb, *gl;
    DEVI void operator()(f32x4 (&acc)[2][2][4][2], int brow, int bcol, int wr, int wc, int fr, int fq) const {
        bf16_t* dst = (bcol < 1024) ? xb : gl; const int cb = bcol & 1023;
#pragma unroll
        for (int ai = 0; ai < 2; ++ai)
#pragma unroll
            for (int m = 0; m < 4; ++m) {
                const size_t row = (size_t)brow + ai * 128 + wr * 64 + m * 16 + fr;
#pragma unroll
                for (int bj = 0; bj < 2; ++bj)
#pragma unroll
                    for (int n = 0; n < 2; ++n) {
                        const int col = cb + bj * 128 + wc * 32 + n * 16 + fq * 4;
                        const f32x4 v = acc[ai][bj][m][n];
                        *(uint2*)(dst + row * DM + col) = make_uint2(pack2(v[0], v[1]), pack2(v[2], v[3]));
                    }
            }
    }
};

constexpr float SB_EXIT = -40.0f;
DEVI void sb_tile(const bf16x8 (&kf)[2][2], const bf16x4 (&vlo)[4], const bf16x4 (&vhi)[4], const bf16x8 (&qf)[2], f32x4 (&o)[4], float& carry, const int k0, const int t, const int fq) {
    f32x4 st[2];
#pragma unroll
    for (int u2 = 0; u2 < 2; ++u2) {
        st[u2] = (f32x4){0.f, 0.f, 0.f, 0.f};
#pragma unroll
        for (int kk = 0; kk < 2; ++kk) st[u2] = __builtin_amdgcn_mfma_f32_16x16x32_bf16(kf[u2][kk], qf[kk], st[u2], 0, 0, 0);
    }
    float w[2][4];
#pragma unroll
    for (int u2 = 1; u2 >= 0; --u2) {
        float z[4], c[4]; bool valid[4];
#pragma unroll
        for (int j = 0; j < 4; ++j) {
            const int key = k0 + 16 * u2 + fq * 4 + j;
            z[j] = st[u2][j]; valid[j] = key < t;
            const float sp = fmaxf(z[j], 0.f) + 0.6931471805599453f * __builtin_amdgcn_logf(1.0f + __builtin_amdgcn_exp2f(-1.4426950408889634f * fabsf(z[j])));
            c[j] = valid[j] ? -sp : 0.f;
        }
        c[2] += c[3]; c[1] += c[2]; c[0] += c[1];
        const float T = c[0];
        const float a = T + sx16(T, fq);
        const float b2 = sx32(a, fq);
        const float above = ((fq & 1) ? 0.f : 1.f) * (a - T) + ((fq & 2) ? 0.f : 1.f) * b2;
        const float base = carry + above;
#pragma unroll
        for (int j = 0; j < 4; ++j) w[u2][j] = valid[j] ? __builtin_amdgcn_exp2f(1.4426950408889634f * (z[j] + base + c[j])) : 0.f;
        carry += a + b2;
    }
    bf16x8 pf;
    { const uint4 pu = make_uint4(pack2(w[0][0], w[0][1]), pack2(w[0][2], w[0][3]), pack2(w[1][0], w[1][1]), pack2(w[1][2], w[1][3])); pf = *(const bf16x8*)&pu; }
#pragma unroll
    for (int dt = 0; dt < 4; ++dt) {
        bf16x8 vf;
        vf[0] = vlo[dt][0]; vf[1] = vlo[dt][1]; vf[2] = vlo[dt][2]; vf[3] = vlo[dt][3];
        vf[4] = vhi[dt][0]; vf[5] = vhi[dt][1]; vf[6] = vhi[dt][2]; vf[7] = vhi[dt][3];
        o[dt] = __builtin_amdgcn_mfma_f32_16x16x32_bf16(vf, pf, o[dt], 0, 0, 0);
    }
}

DEVI void sb_tile2(const bf16x8 (&kf)[2][2], const bf16x4 (&vlo)[4], const bf16x4 (&vhi)[4], const bf16x8 (&qf)[2][2], f32x4 (&o)[4][2], float (&carry)[2], const int k0, const int tq0, const int fr, const int fq, const bool masked) {
    f32x4 st[2][2];
#pragma unroll
    for (int u2 = 0; u2 < 2; ++u2)
#pragma unroll
        for (int qt = 0; qt < 2; ++qt) st[u2][qt] = __builtin_amdgcn_mfma_f32_16x16x32_bf16(kf[u2][0], qf[qt][0], (f32x4){0.f, 0.f, 0.f, 0.f}, 0, 0, 0);
#pragma unroll
    for (int u2 = 0; u2 < 2; ++u2)
#pragma unroll
        for (int qt = 0; qt < 2; ++qt) st[u2][qt] = __builtin_amdgcn_mfma_f32_16x16x32_bf16(kf[u2][1], qf[qt][1], st[u2][qt], 0, 0, 0);
    float c[2][2][4]; bool valid[2][2][4];
#pragma unroll
    for (int u2 = 0; u2 < 2; ++u2)
#pragma unroll
        for (int qt = 0; qt < 2; ++qt)
#pragma unroll
            for (int j = 0; j < 4; ++j) {
                const float z = st[u2][qt][j];
                const float sp = fmaxf(z, 0.f) + 0.6931471805599453f * __builtin_amdgcn_logf(1.0f + __builtin_amdgcn_exp2f(-1.4426950408889634f * fabsf(z)));
                valid[u2][qt][j] = masked ? ((k0 + 16 * u2 + fq * 4 + j) < (tq0 + qt * 16 + fr)) : true;
                c[u2][qt][j] = valid[u2][qt][j] ? -sp : 0.f;
            }
#pragma unroll
    for (int u2 = 0; u2 < 2; ++u2)
#pragma unroll
        for (int qt = 0; qt < 2; ++qt) { c[u2][qt][2] += c[u2][qt][3]; c[u2][qt][1] += c[u2][qt][2]; c[u2][qt][0] += c[u2][qt][1]; }
    float a[2][2], b2[2][2];
#pragma unroll
    for (int u2 = 0; u2 < 2; ++u2)
#pragma unroll
        for (int qt = 0; qt < 2; ++qt) a[u2][qt] = c[u2][qt][0] + sx16(c[u2][qt][0], fq);
#pragma unroll
    for (int u2 = 0; u2 < 2; ++u2)
#pragma unroll
        for (int qt = 0; qt < 2; ++qt) b2[u2][qt] = sx32(a[u2][qt], fq);
    const float m1 = (fq & 1) ? 0.f : 1.f, m2 = (fq & 2) ? 0.f : 1.f;
    float w[2][2][4];
#pragma unroll
    for (int qt = 0; qt < 2; ++qt) {
        const float tot1 = a[1][qt] + b2[1][qt], tot0 = a[0][qt] + b2[0][qt];
        const float base1 = carry[qt] + m1 * (a[1][qt] - c[1][qt][0]) + m2 * b2[1][qt];
        const float base0 = carry[qt] + tot1 + m1 * (a[0][qt] - c[0][qt][0]) + m2 * b2[0][qt];
#pragma unroll
        for (int j = 0; j < 4; ++j) {
            const float e1 = __builtin_amdgcn_exp2f(1.4426950408889634f * (st[1][qt][j] + base1 + c[1][qt][j]));
            const float e0 = __builtin_amdgcn_exp2f(1.4426950408889634f * (st[0][qt][j] + base0 + c[0][qt][j]));
            w[1][qt][j] = valid[1][qt][j] ? e1 : 0.f; w[0][qt][j] = valid[0][qt][j] ? e0 : 0.f;
        }
        carry[qt] += tot1 + tot0;
    }
    bf16x8 pf[2];
#pragma unroll
    for (int qt = 0; qt < 2; ++qt) {
        const uint4 pu = make_uint4(pack2(w[0][qt][0], w[0][qt][1]), pack2(w[0][qt][2], w[0][qt][3]), pack2(w[1][qt][0], w[1][qt][1]), pack2(w[1][qt][2], w[1][qt][3]));
        pf[qt] = *(const bf16x8*)&pu;
    }
#pragma unroll
    for (int dt = 0; dt < 4; ++dt) {
        bf16x8 vf;
        vf[0] = vlo[dt][0]; vf[1] = vlo[dt][1]; vf[2] = vlo[dt][2]; vf[3] = vlo[dt][3];
        vf[4] = vhi[dt][0]; vf[5] = vhi[dt][1]; vf[6] = vhi[dt][2]; vf[7] = vhi[dt][3];
        o[dt][0] = __builtin_amdgcn_mfma_f32_16x16x32_bf16(vf, pf[0], o[dt][0], 0, 0, 0);
        o[dt][1] = __builtin_amdgcn_mfma_f32_16x16x32_bf16(vf, pf[1], o[dt][1], 0, 0, 0);
    }
}

DEVI void sb_phase(const Params& p, char* smem) {
    bf16_t* Ks = (bf16_t*)smem;
    bf16_t* Vs = (bf16_t*)(smem + 55296);
    const int tid = threadIdx.x, wave = tid >> 6, lane = tid & 63, fr = lane & 15, fq = lane >> 4;
    uint4 kq0, kq1, kq2, kq3, kq4, kq5, vq0, vq1, vq2, vq3, vq4, vq5;
#define SB_KG(q_) ((kb_ + ((tid + (q_) * 512) >> 3)) >= 0 ? *(const uint4*)(Kp_ + (size_t)(kb_ + ((tid + (q_) * 512) >> 3)) * 64 + ((tid + (q_) * 512) & 7) * 8) : make_uint4(0, 0, 0, 0))
#define SB_VG(q_) ((kb_ + ((tid + (q_) * 512) % 48) * 8) >= 0 ? *(const uint4*)(Vt_ + (size_t)((tid + (q_) * 512) / 48) * 4096 + kb_ + ((tid + (q_) * 512) % 48) * 8) : make_uint4(0, 0, 0, 0))
#define SB_LOAD(u_) do { const int bh_ = (u_) >> 4, kb_ = ((u_) & 15) * 256 - 128; \
        const bf16_t* Kp_ = p.ka + (size_t)bh_ * 4096 * 64; const bf16_t* Vt_ = p.vta + (size_t)bh_ * 64 * 4096; \
        kq0 = SB_KG(0); kq1 = SB_KG(1); kq2 = SB_KG(2); kq3 = SB_KG(3); kq4 = SB_KG(4); kq5 = SB_KG(5); \
        vq0 = SB_VG(0); vq1 = SB_VG(1); vq2 = SB_VG(2); vq3 = SB_VG(3); vq4 = SB_VG(4); vq5 = SB_VG(5); } while (0)
#define SB_KS(q_) (*(uint4*)(Ks + ((tid + (q_) * 512) >> 3) * 72 + ((tid + (q_) * 512) & 7) * 8))
#define SB_VS(q_) (*(uint4*)(Vs + ((tid + (q_) * 512) / 48) * 392 + ((tid + (q_) * 512) % 48) * 8))
    int u = blockIdx.x;
    { const int u0 = u < 2048 ? u : 0; SB_LOAD(u0); }
    for (; u < 2048; u += gridDim.x) {
        const int bh = u >> 4, t0 = (u & 15) * 256, kbase = t0 - 128;
        __syncthreads();
        SB_KS(0) = kq0; SB_KS(1) = kq1; SB_KS(2) = kq2; SB_KS(3) = kq3; SB_KS(4) = kq4; SB_KS(5) = kq5;
        SB_VS(0) = vq0; SB_VS(1) = vq1; SB_VS(2) = vq2; SB_VS(3) = vq3; SB_VS(4) = vq4; SB_VS(5) = vq5;
        __syncthreads();
        { const int un = (u + (int)gridDim.x < 2048) ? u + (int)gridDim.x : u; SB_LOAD(un); }
        const int q0 = t0 + wave * 32;
        const bf16_t* Q = p.qa + (size_t)bh * 4096 * 64;
        bf16x8 qf[2][2];
#pragma unroll
        for (int qt = 0; qt < 2; ++qt)
#pragma unroll
            for (int kk = 0; kk < 2; ++kk) qf[qt][kk] = *(const bf16x8*)(Q + (size_t)(q0 + qt * 16 + fr) * 64 + kk * 32 + fq * 8);
        f32x4 o[4][2];
#pragma unroll
        for (int dt = 0; dt < 4; ++dt) { o[dt][0] = (f32x4){0.f, 0.f, 0.f, 0.f}; o[dt][1] = (f32x4){0.f, 0.f, 0.f, 0.f}; }
        float carry[2] = {0.f, 0.f};
        const int lo = kbase > 0 ? kbase : 0;
        bool done = false;
        for (int k0 = q0; k0 >= lo; k0 -= 32) {
            const int kl = k0 - kbase;
            bf16x8 kf[2][2]; bf16x4 vlo[4], vhi[4];
#pragma unroll
            for (int u2 = 0; u2 < 2; ++u2)
#pragma unroll
                for (int kk = 0; kk < 2; ++kk) kf[u2][kk] = *(const bf16x8*)(Ks + (kl + 16 * u2 + fr) * 72 + kk * 32 + fq * 8);
#pragma unroll
            for (int dt = 0; dt < 4; ++dt) {
                vlo[dt] = *(const bf16x4*)(Vs + (dt * 16 + fr) * 392 + kl + fq * 4);
                vhi[dt] = *(const bf16x4*)(Vs + (dt * 16 + fr) * 392 + kl + 16 + fq * 4);
            }
            sb_tile2(kf, vlo, vhi, qf, o, carry, k0, q0, fr, fq, k0 == q0);
            if (__all(carry[0] < SB_EXIT && carry[1] < SB_EXIT)) { done = true; break; }
        }
        if (!done && lo > 0) {
            const bf16_t* Kp = p.ka + (size_t)bh * 4096 * 64;
            const bf16_t* Vt = p.vta + (size_t)bh * 64 * 4096;
            for (int k0 = lo - 32; k0 >= 0; k0 -= 32) {
                bf16x8 kf[2][2]; bf16x4 vlo[4], vhi[4];
#pragma unroll
                for (int u2 = 0; u2 < 2; ++u2)
#pragma unroll
                    for (int kk = 0; kk < 2; ++kk) kf[u2][kk] = *(const bf16x8*)(Kp + (size_t)(k0 + 16 * u2 + fr) * 64 + kk * 32 + fq * 8);
#pragma unroll
                for (int dt = 0; dt < 4; ++dt) {
                    vlo[dt] = *(const bf16x4*)(Vt + (size_t)(dt * 16 + fr) * 4096 + k0 + fq * 4);
                    vhi[dt] = *(const bf16x4*)(Vt + (size_t)(dt * 16 + fr) * 4096 + k0 + 16 + fq * 4);
                }
                sb_tile2(kf, vlo, vhi, qf, o, carry, k0, q0, fr, fq, false);
                if (__all(carry[0] < SB_EXIT && carry[1] < SB_EXIT)) break;
            }
        }
        const int hcol = (bh & 7) * 64;
#pragma unroll
        for (int qt = 0; qt < 2; ++qt) {
            const size_t tok = (size_t)(bh >> 3) * 4096 + q0 + qt * 16 + fr;
#pragma unroll
            for (int dt = 0; dt < 4; ++dt) {
                const int dh = dt * 16 + fq * 4;
                const uint2 gu = *(const uint2*)(p.gates + tok * 1024 + hcol + dh);
                const float g0 = bf2f((bf16_t)(gu.x & 0xffff)), g1 = bf2f((bf16_t)(gu.x >> 16)), g2 = bf2f((bf16_t)(gu.y & 0xffff)), g3 = bf2f((bf16_t)(gu.y >> 16));
                const float y0 = o[dt][qt][0] * g0 * sigmoidf_(g0), y1 = o[dt][qt][1] * g1 * sigmoidf_(g1), y2 = o[dt][qt][2] * g2 * sigmoidf_(g2), y3 = o[dt][qt][3] * g3 * sigmoidf_(g3);
                *(uint2*)(p.ypre + tok * 1024 + hcol + dh) = make_uint2(pack2(y0, y1), pack2(y2, y3));
            }
        }
    }
#undef SB_LOAD
#undef SB_KG
#undef SB_VG
#undef SB_KS
#undef SB_VS
}

constexpr float SM_C = 0.125f * 1.4426950408889634f;
constexpr int LCAP = 4096;

DEVI void moba_select_phase(const Params& p, char* smem) {
    float* km = (float*)smem;
    const int tid = threadIdx.x, wave = tid >> 6, lane = tid & 63;
    for (int w = blockIdx.x; w < 256; w += gridDim.x) {
        const int bh = w >> 1, hf = w & 1;
        __syncthreads();
        for (int i = tid; i < 1024; i += 512) km[i] = p.kmean[(size_t)bh * 1024 + i];
        __syncthreads();
        bf16x8 qv[8];
        { const bf16_t* qrow = p.qb + ((size_t)bh * 4096 + wave * 256 + hf * 128 + (lane & 31)) * 64;
#pragma unroll
          for (int c = 0; c < 8; ++c) qv[c] = *(const bf16x8*)(qrow + c * 8); }
#pragma unroll 1
        for (int ws8 = 0; ws8 < 8; ++ws8) {
            const int qb = (ws8 < 4) ? wave : 15 - wave;
            const int q = qb * 256 + (hf * 4 + (ws8 & 3)) * 32 + (lane & 31);
            bf16x8 qn[8];
            { const int wn = ws8 < 7 ? ws8 + 1 : ws8; const int qbn = (wn < 4) ? wave : 15 - wave;
              const bf16_t* qrow = p.qb + ((size_t)bh * 4096 + qbn * 256 + (hf * 4 + (wn & 3)) * 32 + (lane & 31)) * 64;
#pragma unroll
              for (int c = 0; c < 8; ++c) qn[c] = *(const bf16x8*)(qrow + c * 8); }
            float b0 = -INFINITY, b1 = -INFINITY, b2 = -INFINITY; int i0 = -1, i1 = -1, i2 = -1;
            for (int n = 0; n < qb; ++n) {
                float s = 0.f;
#pragma unroll
                for (int c = 0; c < 8; ++c) {
                    const f32x4 k0 = *(const f32x4*)(km + n * 64 + c * 8), k1 = *(const f32x4*)(km + n * 64 + c * 8 + 4);
                    s += bfs2f(qv[c][0]) * k0[0]; s += bfs2f(qv[c][1]) * k0[1]; s += bfs2f(qv[c][2]) * k0[2]; s += bfs2f(qv[c][3]) * k0[3];
                    s += bfs2f(qv[c][4]) * k1[0]; s += bfs2f(qv[c][5]) * k1[1]; s += bfs2f(qv[c][6]) * k1[2]; s += bfs2f(qv[c][7]) * k1[3];
                }
                if (s > b0) { b2 = b1; i2 = i1; b1 = b0; i1 = i0; b0 = s; i0 = n; }
                else if (s > b1) { b2 = b1; i2 = i1; b1 = s; i1 = n; }
                else if (s > b2) { b2 = s; i2 = n; }
            }
            for (int n = 0; n < qb; ++n) {
                const bool pred = (lane < 32) && (i0 == n || i1 == n || i2 == n);
                const unsigned long long mask = __ballot(pred);
                if (mask == 0ull) continue;
                const int leader = __ffsll((long long)mask) - 1;
                int base = 0;
                if (lane == leader) base = atomicAdd(p.mcnt + bh * 16 + n, __popcll(mask));
                base = __shfl(base, leader);
                if (pred) {
                    const int pos = base + __popcll(mask & ((1ull << lane) - 1ull));
                    const int j = (i0 == n) ? 0 : (i1 == n) ? 1 : 2;
                    __hip_atomic_store(p.mlist + (size_t)(bh * 16 + n) * LCAP + pos, (unsigned short)(q | (j << 12)), __ATOMIC_RELAXED, __HIP_MEMORY_SCOPE_AGENT);
                }
            }
#pragma unroll
            for (int c = 0; c < 8; ++c) qv[c] = qn[c];
        }
    }
}

template <bool MASK>
DEVI void moba_subtile(const bf16_t* Kt  , const bf16_t* Vt  , const int vstr,
                       const bf16x8 (&qf)[2][2], f32x4 (&o)[4][2], float (&mrun)[2], float (&lrun)[2], const int kl0, const int ql0, const int fr, const int fq) {
    f32x4 st[4][2];
#pragma unroll
    for (int kt = 0; kt < 4; ++kt) {
        st[kt][0] = (f32x4){0.f, 0.f, 0.f, 0.f}; st[kt][1] = (f32x4){0.f, 0.f, 0.f, 0.f};
#pragma unroll
        for (int kk = 0; kk < 2; ++kk) {
            const bf16x8 kf = *(const bf16x8*)(Kt + (kt * 16 + fr) * 72 + kk * 32 + fq * 8);
            st[kt][0] = __builtin_amdgcn_mfma_f32_16x16x32_bf16(kf, qf[0][kk], st[kt][0], 0, 0, 0);
            st[kt][1] = __builtin_amdgcn_mfma_f32_16x16x32_bf16(kf, qf[1][kk], st[kt][1], 0, 0, 0);
        }
    }
    bf16x8 pf[2][2];
    float sv[2][4][4], tmax[2], mnew[2], alpha[2], psum[2];
#pragma unroll
    for (int qt = 0; qt < 2; ++qt) {
        const int ql = ql0 + qt * 16 + fr;
        tmax[qt] = -1e30f;
#pragma unroll
        for (int kt = 0; kt < 4; ++kt)
#pragma unroll
            for (int j = 0; j < 4; ++j) {
                float v = st[kt][qt][j];
                if (MASK) { const int kl = kl0 + kt * 16 + fq * 4 + j; v = (kl <= ql) ? v : -1e30f; }
                sv[qt][kt][j] = v; tmax[qt] = fmaxf(tmax[qt], v);
            }
    }
#pragma unroll
    for (int qt = 0; qt < 2; ++qt) tmax[qt] = fmaxf(tmax[qt], sx16(tmax[qt], fq));
#pragma unroll
    for (int qt = 0; qt < 2; ++qt) tmax[qt] = fmaxf(tmax[qt], sx32(tmax[qt], fq));
#pragma unroll
    for (int qt = 0; qt < 2; ++qt) { mnew[qt] = fmaxf(mrun[qt], tmax[qt]); alpha[qt] = __builtin_amdgcn_exp2f(mrun[qt] - mnew[qt]); mrun[qt] = mnew[qt]; psum[qt] = 0.f; }
#pragma unroll
    for (int kt = 0; kt < 4; ++kt)
#pragma unroll
        for (int j = 0; j < 4; ++j)
#pragma unroll
            for (int qt = 0; qt < 2; ++qt) {
                float pv = __builtin_amdgcn_exp2f(sv[qt][kt][j] - mnew[qt]);
                if (MASK) pv = (sv[qt][kt][j] > -1e29f) ? pv : 0.f;
                sv[qt][kt][j] = pv; psum[qt] += pv;
            }
#pragma unroll
    for (int qt = 0; qt < 2; ++qt) psum[qt] += sx16(psum[qt], fq);
#pragma unroll
    for (int qt = 0; qt < 2; ++qt) psum[qt] += sx32(psum[qt], fq);
#pragma unroll
    for (int qt = 0; qt < 2; ++qt) {
        lrun[qt] = lrun[qt] * alpha[qt] + psum[qt];
#pragma unroll
        for (int dt = 0; dt < 4; ++dt) o[dt][qt] *= alpha[qt];
#pragma unroll
        for (int kk2 = 0; kk2 < 2; ++kk2) {
            const uint4 pu = make_uint4(pack2(sv[qt][2 * kk2][0], sv[qt][2 * kk2][1]), pack2(sv[qt][2 * kk2][2], sv[qt][2 * kk2][3]),
                                        pack2(sv[qt][2 * kk2 + 1][0], sv[qt][2 * kk2 + 1][1]), pack2(sv[qt][2 * kk2 + 1][2], sv[qt][2 * kk2 + 1][3]));
            pf[kk2][qt] = *(const bf16x8*)&pu;
        }
    }
#pragma unroll
    for (int dt = 0; dt < 4; ++dt)
#pragma unroll
        for (int kk2 = 0; kk2 < 2; ++kk2) {
            const uint2 lo = *(const uint2*)(Vt + (dt * 16 + fr) * vstr + kk2 * 32 + fq * 4);
            const uint2 hi = *(const uint2*)(Vt + (dt * 16 + fr) * vstr + kk2 * 32 + 16 + fq * 4);
            const uint4 vu = make_uint4(lo.x, lo.y, hi.x, hi.y);
            const bf16x8 vf = *(const bf16x8*)&vu;
            o[dt][0] = __builtin_amdgcn_mfma_f32_16x16x32_bf16(vf, pf[kk2][0], o[dt][0], 0, 0, 0);
            o[dt][1] = __builtin_amdgcn_mfma_f32_16x16x32_bf16(vf, pf[kk2][1], o[dt][1], 0, 0, 0);
        }
}

DEVI void moba_past_item(const Params& p, const int bh, const int n, char* smem) {
    bf16_t* Ks = (bf16_t*)smem;
    bf16_t* Vs = (bf16_t*)(smem + 36864);
    const int tid = threadIdx.x, wave = tid >> 6, lane = tid & 63, fr = lane & 15, fq = lane >> 4;
    const bf16_t* Qg = p.qb + (size_t)bh * 4096 * 64;
    const bf16_t* Kg = p.kb + ((size_t)bh * 4096 + (size_t)n * 256) * 64;
    const bf16_t* Vtg = p.vtb + (size_t)bh * 64 * 4096 + n * 256;
    __syncthreads();
#pragma unroll
    for (int q = 0; q < 4; ++q) {
        const int i = tid + q * 512;
        *(uint4*)(Ks + (i >> 3) * 72 + (i & 7) * 8) = *(const uint4*)(Kg + (size_t)(i >> 3) * 64 + (i & 7) * 8);
        *(uint4*)(Vs + (i >> 5) * 264 + (i & 31) * 8) = *(const uint4*)(Vtg + (size_t)(i >> 5) * 4096 + (i & 31) * 8);
    }
    __syncthreads();
    const int cnt = p.mcnt[bh * 16 + n];
    const unsigned short* lst = p.mlist + (size_t)(bh * 16 + n) * LCAP;
    const int ngroups = (cnt + 31) >> 5;
    int qidx[2], slot[2]; bool valid[2];
    bf16x8 qf[2][2];
#define D2_FETCH(g_) do { _Pragma("unroll") for (int qt = 0; qt < 2; ++qt) { const int idx = (g_) * 32 + qt * 16 + fr; valid[qt] = idx < cnt; \
        const unsigned e = lst[valid[qt] ? idx : 0]; qidx[qt] = e & 4095; slot[qt] = e >> 12; \
        _Pragma("unroll") for (int kk = 0; kk < 2; ++kk) qf[qt][kk] = *(const bf16x8*)(Qg + (size_t)qidx[qt] * 64 + kk * 32 + fq * 8); } } while (0)
    if (wave < ngroups) D2_FETCH(wave);
    for (int g = wave; g < ngroups; g += 8) {
        int cq[2], cs[2]; bool cv[2]; bf16x8 cf[2][2];
#pragma unroll
        for (int qt = 0; qt < 2; ++qt) { cq[qt] = qidx[qt]; cs[qt] = slot[qt]; cv[qt] = valid[qt]; cf[qt][0] = qf[qt][0]; cf[qt][1] = qf[qt][1]; }
        { const int gn = (g + 8 < ngroups) ? g + 8 : g; D2_FETCH(gn); }
        f32x4 o[4][2];
#pragma unroll
        for (int dt = 0; dt < 4; ++dt) { o[dt][0] = (f32x4){0.f, 0.f, 0.f, 0.f}; o[dt][1] = (f32x4){0.f, 0.f, 0.f, 0.f}; }
        float mrun[2] = {-1e30f, -1e30f}, lrun[2] = {0.f, 0.f};
#pragma unroll 1
        for (int jt = 0; jt < 4; ++jt)
            moba_subtile<false>(Ks + jt * 64 * 72, Vs + jt * 64, 264, cf, o, mrun, lrun, 0, 0, fr, fq);
#pragma unroll
        for (int qt = 0; qt < 2; ++qt) {
            if (cv[qt]) {
                const size_t pair = ((size_t)bh * 4096 + cq[qt]) * 3 + cs[qt];
                const float linv = __builtin_amdgcn_rcpf(lrun[qt]);
#pragma unroll
                for (int dt = 0; dt < 4; ++dt) {
                    const f32x4 v = o[dt][qt];
                    *(uint2*)(p.part_o + pair * 64 + dt * 16 + fq * 4) = make_uint2(pack2(v[0] * linv, v[1] * linv), pack2(v[2] * linv, v[3] * linv));
                }
                if (fq == 0) __hip_atomic_store((unsigned long long*)(p.part_ml + pair * 2), ((unsigned long long)__float_as_uint(lrun[qt]) << 32) | (unsigned long long)__float_as_uint(mrun[qt]), __ATOMIC_RELAXED, __HIP_MEMORY_SCOPE_AGENT);
            }
        }
    }
#undef D2_FETCH
}

DEVI void moba_past_phase(const Params& p, char* smem) {
    for (int w = blockIdx.x; w < 256; w += gridDim.x) {
        const int bh = w >> 1, set = w & 1;
#pragma unroll 1
        for (int n = 0; n < 15; ++n) {
            const int inA = (n == 0) | (n == 3) | (n == 4) | (n == 7) | (n == 8) | (n == 11) | (n == 12);
            if (inA == set) continue;
            moba_past_item(p, bh, n, smem);
        }
    }
}

DEVI void moba_own_item(const Params& p, const int bh, const int qb, char* smem) {
    bf16_t* Ks = (bf16_t*)smem;
    bf16_t* Vs = (bf16_t*)(smem + 36864);
    const int tid = threadIdx.x, wave = tid >> 6, lane = tid & 63, fr = lane & 15, fq = lane >> 4;
    const bf16_t* Qg = p.qb + ((size_t)bh * 4096 + (size_t)qb * 256) * 64;
    const bf16_t* Kg = p.kb + ((size_t)bh * 4096 + (size_t)qb * 256) * 64;
    const bf16_t* Vtg = p.vtb + (size_t)bh * 64 * 4096 + qb * 256;
#define OWN_K(q_) (*(const uint4*)(Kg + (size_t)((tid + (q_) * 512) >> 3) * 64 + ((tid + (q_) * 512) & 7) * 8))
#define OWN_V(q_) (*(const uint4*)(Vtg + (size_t)((tid + (q_) * 512) >> 5) * 4096 + ((tid + (q_) * 512) & 31) * 8))
    const uint4 kq0 = OWN_K(0), kq1 = OWN_K(1), kq2 = OWN_K(2), kq3 = OWN_K(3);
    const uint4 vq0 = OWN_V(0), vq1 = OWN_V(1), vq2 = OWN_V(2), vq3 = OWN_V(3);
#undef OWN_K
#undef OWN_V
    bf16x8 qf[2][2];
#pragma unroll
    for (int qt = 0; qt < 2; ++qt)
#pragma unroll
        for (int kk = 0; kk < 2; ++kk) qf[qt][kk] = *(const bf16x8*)(Qg + (size_t)(wave * 32 + qt * 16 + fr) * 64 + kk * 32 + fq * 8);
    f32x4 o[4][2];
#pragma unroll
    for (int dt = 0; dt < 4; ++dt) { o[dt][0] = (f32x4){0.f, 0.f, 0.f, 0.f}; o[dt][1] = (f32x4){0.f, 0.f, 0.f, 0.f}; }
    float mrun[2] = {-1e30f, -1e30f}, lrun[2] = {0.f, 0.f};
    const int hcol = 512 + (bh & 7) * 64;
    const int nsel = qb < 3 ? qb : 3;
    float2 pml[2][3]; uint2 po[2][3][4];
#pragma unroll
    for (int qt = 0; qt < 2; ++qt) {
        const int qs = qb * 256 + wave * 32 + qt * 16 + fr;
#pragma unroll
        for (int j = 0; j < 3; ++j) {
            const size_t pair = ((size_t)bh * 4096 + qs) * 3 + j;
            pml[qt][j] = make_float2(-1e30f, 0.f);
#pragma unroll
            for (int dt = 0; dt < 4; ++dt) po[qt][j][dt] = make_uint2(0u, 0u);
            if (j < nsel) {
                pml[qt][j] = *(const float2*)(p.part_ml + pair * 2);
#pragma unroll
                for (int dt = 0; dt < 4; ++dt) po[qt][j][dt] = *(const uint2*)(p.part_o + pair * 64 + dt * 16 + fq * 4);
            }
        }
    }
    __syncthreads();
#define OWN_KS(q_) (*(uint4*)(Ks + ((tid + (q_) * 512) >> 3) * 72 + ((tid + (q_) * 512) & 7) * 8))
#define OWN_VS(q_) (*(uint4*)(Vs + ((tid + (q_) * 512) >> 5) * 264 + ((tid + (q_) * 512) & 31) * 8))
    OWN_KS(0) = kq0; OWN_KS(1) = kq1; OWN_KS(2) = kq2; OWN_KS(3) = kq3;
    OWN_VS(0) = vq0; OWN_VS(1) = vq1; OWN_VS(2) = vq2; OWN_VS(3) = vq3;
#undef OWN_KS
#undef OWN_VS
    __syncthreads();
#pragma unroll 1
    for (int jt = 0; jt < 4; ++jt) {
        if (jt * 64 + 63 <= wave * 32)        moba_subtile<false>(Ks + jt * 64 * 72, Vs + jt * 64, 264, qf, o, mrun, lrun, 0, 0, fr, fq);
        else if (jt * 64 <= wave * 32 + 31)   moba_subtile<true>(Ks + jt * 64 * 72, Vs + jt * 64, 264, qf, o, mrun, lrun, jt * 64, wave * 32, fr, fq);
    }
#pragma unroll
    for (int qt = 0; qt < 2; ++qt) {
        float m = mrun[qt], l = lrun[qt];
        f32x4 acc[4];
#pragma unroll
        for (int dt = 0; dt < 4; ++dt) acc[dt] = o[dt][qt];
#pragma unroll
        for (int j = 0; j < 3; ++j) {
            const float2 ml = pml[qt][j];
            const float M = fmaxf(m, ml.x);
            const float wo = __builtin_amdgcn_exp2f(m - M), wj = ml.y * __builtin_amdgcn_exp2f(ml.x - M);
#pragma unroll
            for (int dt = 0; dt < 4; ++dt) {
                const uint2 ou = po[qt][j][dt];
                acc[dt][0] = acc[dt][0] * wo + wj * bf2f((bf16_t)(ou.x & 0xffff)); acc[dt][1] = acc[dt][1] * wo + wj * bf2f((bf16_t)(ou.x >> 16));
                acc[dt][2] = acc[dt][2] * wo + wj * bf2f((bf16_t)(ou.y & 0xffff)); acc[dt][3] = acc[dt][3] * wo + wj * bf2f((bf16_t)(ou.y >> 16));
            }
            l = l * wo + wj; m = M;
        }
        const float linv = __builtin_amdgcn_rcpf(l);
        const size_t tok = (size_t)(bh >> 3) * 4096 + qb * 256 + wave * 32 + qt * 16 + fr;
#pragma unroll
        for (int dt = 0; dt < 4; ++dt) {
            const int dh = dt * 16 + fq * 4;
            const uint2 gu = *(const uint2*)(p.gates + tok * 1024 + hcol + dh);
            const float g0 = bf2f((bf16_t)(gu.x & 0xffff)), g1 = bf2f((bf16_t)(gu.x >> 16)), g2 = bf2f((bf16_t)(gu.y & 0xffff)), g3 = bf2f((bf16_t)(gu.y >> 16));
            const float y0 = acc[dt][0] * linv * g0 * sigmoidf_(g0), y1 = acc[dt][1] * linv * g1 * sigmoidf_(g1);
            const float y2 = acc[dt][2] * linv * g2 * sigmoidf_(g2), y3 = acc[dt][3] * linv * g3 * sigmoidf_(g3);
            *(uint2*)(p.ypre + tok * 1024 + hcol + dh) = make_uint2(pack2(y0, y1), pack2(y2, y3));
        }
    }
}

DEVI void moba_own_phase(const Params& p, char* smem) {
    for (int it = blockIdx.x; it < 2048; it += gridDim.x) moba_own_item(p, it >> 4, it & 15, smem);
}

DEVI void lru_item(const Params& p, const int item, char* smem) {
    const int b = item >> 4, n = (item >> 1) & 7, half = item & 1;
    const int tid = threadIdx.x, wave = tid >> 6, lane = tid & 63, fr = lane & 15, fq = lane >> 4;
    bf16_t* xs = (bf16_t*)smem;
    bf16_t* wa = (bf16_t*)(smem + 35840);
    bf16_t* wx = (bf16_t*)(smem + 35840 + 17408);
    float* cw = (float*)(smem + 70656);
    float* agg = cw + 640;
    float* xcw = (float*)(smem + 81408) + wave * (16 * 68);
    bf16_t* gs = (bf16_t*)(smem + 81408 + 8 * 16 * 68 * 4);
    __syncthreads();
    for (int i = tid; i < 64 * 16; i += 512) {
        const int r = i >> 4, c = i & 15;
        *(uint4*)(wa + r * 136 + c * 8) = *(const uint4*)(p.wa_t + ((size_t)(n * 128 + half * 64 + r)) * 128 + c * 8);
        *(uint4*)(wx + r * 136 + c * 8) = *(const uint4*)(p.wx_t + ((size_t)(n * 128 + half * 64 + r)) * 128 + c * 8);
    }
    cw[tid] = p.lru_conv_w[(tid >> 7) * 1024 + n * 128 + (tid & 127)];
    if (tid < 128) cw[512 + tid] = p.lru_conv_b[n * 128 + tid];
    float ba[4], bx[4], lsl[4], hstart[4];
#pragma unroll
    for (int ct = 0; ct < 4; ++ct) {
        const int C = n * 128 + half * 64 + ct * 16 + fr;
        ba[ct] = p.lru_b_a[C]; bx[ct] = p.lru_b_x[C];
        const float lam = p.lru_lambda[C];
        lsl[ct] = -8.0f * (fmaxf(-lam, 0.f) + log1pf(expf(-fabsf(lam))));
        hstart[ct] = 0.f;
    }
    const bf16_t* xbase = p.xb + ((size_t)b * 4096) * 1024 + n * 128;
    const bf16_t* gbase = p.gl + ((size_t)b * 4096) * 1024 + n * 128 + half * 64;
    uint4 xr[5], gr0, gr1;
#define LRU_LOAD(t0_) do { \
        _Pragma("unroll") for (int q = 0; q < 5; ++q) { const int i = tid + q * 512; const int r = i >> 4, c = i & 15; const int t = (t0_) - 3 + r; \
            xr[q] = make_uint4(0, 0, 0, 0); if (i < 131 * 16 && t >= 0) xr[q] = *(const uint4*)(xbase + (size_t)t * 1024 + c * 8); } \
        gr0 = *(const uint4*)(gbase + (size_t)((t0_) + (tid >> 3)) * 1024 + (tid & 7) * 8); \
        gr1 = *(const uint4*)(gbase + (size_t)((t0_) + 64 + (tid >> 3)) * 1024 + (tid & 7) * 8); } while (0)
#define LRU_STORE() do { \
        _Pragma("unroll") for (int q = 0; q < 5; ++q) { const int i = tid + q * 512; const int r = i >> 4, c = i & 15; if (i < 131 * 16) *(uint4*)(xs + r * 136 + c * 8) = xr[q]; } \
        *(uint4*)(gs + (tid >> 3) * 72 + (tid & 7) * 8) = gr0; *(uint4*)(gs + (64 + (tid >> 3)) * 72 + (tid & 7) * 8) = gr1; } while (0)
    LRU_LOAD(0);
    LRU_STORE();
    __syncthreads();
    int par = 0;
    for (int ch = 0; ch < 32; ++ch) {
        const int t0 = ch * 128;
        { const int tn = (ch + 1 < 32) ? t0 + 128 : t0; LRU_LOAD(tn); }
        f32x4 ar[4], ax[4];
#pragma unroll
        for (int ct = 0; ct < 4; ++ct) { ar[ct] = (f32x4){0.f, 0.f, 0.f, 0.f}; ax[ct] = (f32x4){0.f, 0.f, 0.f, 0.f}; }
#pragma unroll
        for (int kk = 0; kk < 4; ++kk) {
            const int c0 = kk * 32 + fq * 8;
            float xcv[8];
            { const f32x4 b0 = *(const f32x4*)(cw + 512 + c0), b1 = *(const f32x4*)(cw + 512 + c0 + 4);
              xcv[0] = b0[0]; xcv[1] = b0[1]; xcv[2] = b0[2]; xcv[3] = b0[3]; xcv[4] = b1[0]; xcv[5] = b1[1]; xcv[6] = b1[2]; xcv[7] = b1[3]; }
#pragma unroll
            for (int tap = 0; tap < 4; ++tap) {
                const bf16x8 xv = *(const bf16x8*)(xs + (wave * 16 + fr + tap) * 136 + c0);
                const f32x4 w0 = *(const f32x4*)(cw + tap * 128 + c0), w1 = *(const f32x4*)(cw + tap * 128 + c0 + 4);
#pragma unroll
                for (int e = 0; e < 4; ++e) { xcv[e] += w0[e] * bfs2f(xv[e]); xcv[4 + e] += w1[e] * bfs2f(xv[4 + e]); }
            }
            if ((kk >> 1) == half) {
                float* d = xcw + fr * 68 + (kk & 1) * 32 + fq * 8;
                *(f32x4*)d = (f32x4){xcv[0], xcv[1], xcv[2], xcv[3]}; *(f32x4*)(d + 4) = (f32x4){xcv[4], xcv[5], xcv[6], xcv[7]};
            }
            const uint4 au = make_uint4(pack2(xcv[0], xcv[1]), pack2(xcv[2], xcv[3]), pack2(xcv[4], xcv[5]), pack2(xcv[6], xcv[7]));
            const bf16x8 af = *(const bf16x8*)&au;
#pragma unroll
            for (int ct = 0; ct < 4; ++ct) {
                const bf16x8 fa = *(const bf16x8*)(wa + (ct * 16 + fr) * 136 + c0);
                const bf16x8 fx = *(const bf16x8*)(wx + (ct * 16 + fr) * 136 + c0);
                ar[ct] = __builtin_amdgcn_mfma_f32_16x16x32_bf16(af, fa, ar[ct], 0, 0, 0);
                ax[ct] = __builtin_amdgcn_mfma_f32_16x16x32_bf16(af, fx, ax[ct], 0, 0, 0);
            }
        }
        float pa[4][4], pb[4][4];
#pragma unroll
        for (int ct = 0; ct < 4; ++ct) {
            float A[4], B[4];
#pragma unroll
            for (int j = 0; j < 4; ++j) {
                const float xc = xcw[(fq * 4 + j) * 68 + ct * 16 + fr];
                const float r = sigmoidf_(ar[ct][j] + ba[ct]);
                const float ig = sigmoidf_(ax[ct][j] + bx[ct]);
                const float av = __expf(lsl[ct] * r);
                const float mult = __builtin_amdgcn_sqrtf(fmaxf(1.0f - av * av, 0.f));
                A[j] = av; B[j] = mult * ig * xc;
            }
#pragma unroll
            for (int j = 1; j < 4; ++j) { B[j] = A[j] * B[j - 1] + B[j]; A[j] = A[j] * A[j - 1]; }
            float EA = 1.f, EB = 0.f, TA = 1.f, TB = 0.f;
#pragma unroll
            for (int g = 0; g < 4; ++g) {
                const float Ag = __shfl(A[3], fr + 16 * g), Bg = __shfl(B[3], fr + 16 * g);
                if (g < fq) { EB = Ag * EB + Bg; EA = Ag * EA; }
                TB = Ag * TB + Bg; TA = Ag * TA;
            }
#pragma unroll
            for (int j = 0; j < 4; ++j) { pa[ct][j] = A[j] * EA; pb[ct][j] = A[j] * EB + B[j]; }
            if (fq == 0) { float* ag = agg + ((par * 8 + wave) * 64 + ct * 16 + fr) * 2; ag[0] = TA; ag[1] = TB; }
        }
        __syncthreads();
#pragma unroll
        for (int ct = 0; ct < 4; ++ct) {
            float h = hstart[ct], hin = 0.f;
#pragma unroll
            for (int w = 0; w < 8; ++w) {
                const float2 ab = *(const float2*)(agg + ((par * 8 + w) * 64 + ct * 16 + fr) * 2);
                if (w == wave) hin = h;
                h = ab.x * h + ab.y;
            }
            hstart[ct] = h;
            const int C = n * 128 + half * 64 + ct * 16 + fr;
#pragma unroll
            for (int j = 0; j < 4; ++j) {
                const int tl = wave * 16 + fq * 4 + j;
                const size_t tok = (size_t)b * 4096 + t0 + tl;
                const float hs = pa[ct][j] * hin + pb[ct][j];
                const float g = bf2f(gs[tl * 72 + ct * 16 + fr]);
                p.ypre[tok * 1024 + C] = f2bf(hs * g * sigmoidf_(g));
            }
        }
        __syncthreads();
        LRU_STORE();
        __syncthreads();
        par ^= 1;
    }
#undef LRU_LOAD
#undef LRU_STORE
}

DEVI void lru_phase(const Params& p, char* smem) {
    for (int it = blockIdx.x; it < 256; it += gridDim.x) { const int pr = (it & 7) + 8 * (it >> 4), hf = (it >> 3) & 1; lru_item(p, pr * 2 + hf, smem); }
}

#define GRID_SYNC_CG() do { asm volatile("s_waitcnt vmcnt(0) lgkmcnt(0)" ::: "memory"); grid.sync(); \
    if (threadIdx.x < 64) { __builtin_amdgcn_fence(__ATOMIC_ACQUIRE, "agent"); asm volatile("s_waitcnt vmcnt(0) lgkmcnt(0)" ::: "memory"); } __syncthreads(); } while (0)
DEVI void grid_barrier(unsigned* bar, const unsigned k, const unsigned xcc, const unsigned nx, const unsigned nxcd) {
    asm volatile("s_waitcnt vmcnt(0) lgkmcnt(0)" ::: "memory");
    __syncthreads();
    if (threadIdx.x == 0) {
        const unsigned old = __hip_atomic_fetch_add(bar + 64 * (17 + xcc), 1u, __ATOMIC_RELAXED, __HIP_MEMORY_SCOPE_AGENT);
        if (old + 1 == k * nx) {
            __builtin_amdgcn_fence(__ATOMIC_RELEASE, "agent");
            asm volatile("s_waitcnt vmcnt(0) lgkmcnt(0)" ::: "memory");
            __hip_atomic_fetch_add(bar, 1u, __ATOMIC_RELAXED, __HIP_MEMORY_SCOPE_AGENT);
        }
        while (__hip_atomic_load(bar, __ATOMIC_RELAXED, __HIP_MEMORY_SCOPE_AGENT) < k * nxcd) __builtin_amdgcn_s_sleep(1);
        __builtin_amdgcn_fence(__ATOMIC_ACQUIRE, "agent");
        asm volatile("s_waitcnt vmcnt(0) lgkmcnt(0)" ::: "memory");
    }
    __syncthreads();
}
#define GRID_SYNC() do { ++bar_k; grid_barrier(p.bar, bar_k, xcc, nx, nxcd); } while (0)
__global__ void __launch_bounds__(512, 2) mega_fwd(Params p) {
    extern __shared__ __attribute__((aligned(16))) char smem[];
    cg::grid_group grid = cg::this_grid();
    unsigned bar_k = 0;
    const unsigned xcc = (unsigned)__builtin_amdgcn_s_getreg((3 << 11) | 20) & 0xFu;
    if (threadIdx.x == 0) {
        __hip_atomic_fetch_add(p.bar + 64 * (1 + xcc), 1u, __ATOMIC_RELAXED, __HIP_MEMORY_SCOPE_AGENT);
        __hip_atomic_fetch_add(p.bar + 64 * 40, 1u, __ATOMIC_RELEASE, __HIP_MEMORY_SCOPE_AGENT);
        while (__hip_atomic_load(p.bar + 64 * 40, __ATOMIC_RELAXED, __HIP_MEMORY_SCOPE_AGENT) < gridDim.x) __builtin_amdgcn_s_sleep(1);
    }
    __syncthreads();
    if (p.bar == nullptr) GRID_SYNC_CG();
    unsigned nx = 0, nxcd = 0;
    for (unsigned j = 0; j < 16; ++j) { const unsigned c = __hip_atomic_load(p.bar + 64 * (1 + j), __ATOMIC_RELAXED, __HIP_MEMORY_SCOPE_AGENT); nxcd += (c != 0u); if (j == xcc) nx = c; }
    phase_a(p, smem);
    GRID_SYNC();
    prenorm_phase(p.x, p.norm_g, p.mod, p.h);
    GRID_SYNC();
    gemm_phase(p.h, p.wt_in0, NTOK, 4096, 1024, smem, Epi1{Epi1P{p.positions, p.kmean, p.gates, p.qa}});
    GRID_SYNC();
    moba_select_phase(p, smem);
    sb_phase(p, smem);
    GRID_SYNC();
    moba_past_phase(p, smem);
    GRID_SYNC();
    moba_own_phase(p, smem);
    GRID_SYNC();
    gemm_phase(p.ypre, p.wt_out0, NTOK, 1024, 1024, smem, EpiResP<false>{p.x, p.kb  , p.mod + 2048});
    GRID_SYNC();
    prenorm_bf_phase(p.kb, p.norm_g + 1024, p.mod + 16 * 3072, p.h);
    GRID_SYNC();
    gemm_phase(p.h, p.wt_in1, NTOK, 2048, 1024, smem, Epi3P{p.xb, p.gl});
    GRID_SYNC();
    lru_phase(p, smem);
    GRID_SYNC();
    gemm_phase(p.ypre, p.wt_out1, NTOK, 1024, 1024, smem, EpiResP<true>{p.kb, p.gates  , p.mod + 16 * 3072 + 2048});
    GRID_SYNC();
    final_norm_bf_phase(p.gates, p.out, p.final_g);
}

extern "C" void kernel_launch(void* const* d_in, const int* in_sizes, int n_in, void* d_out, int out_size, void* d_ws, size_t ws_size, hipStream_t stream) {
    constexpr size_t kDynLds = 147456;
    static int grid_blocks = 0;
    if (!grid_blocks) {
        hipFuncSetAttribute((const void*)mega_fwd, hipFuncAttributeMaxDynamicSharedMemorySize, (int)kDynLds);
        int dev = 0, cus = 0, per_cu = 0;
        hipGetDevice(&dev);
        hipDeviceGetAttribute(&cus, hipDeviceAttributeMultiprocessorCount, dev);
        hipOccupancyMaxActiveBlocksPerMultiprocessor(&per_cu, mega_fwd, 512, kDynLds);
        if (per_cu < 1) per_cu = 1;
        grid_blocks = cus * 1;
    }
    Params p{};
    p.x = (const float*)d_in[0]; p.c = (const float*)d_in[1]; p.positions = (const int*)d_in[2];
    p.norm_g = (const float*)d_in[3]; p.w_mod = (const float*)d_in[4]; p.b_mod = (const float*)d_in[5];
    p.attn_w_in = (const float*)d_in[6]; p.attn_w_out = (const float*)d_in[7]; p.lru_w_in = (const float*)d_in[8];
    p.lru_conv_w = (const float*)d_in[9]; p.lru_conv_b = (const float*)d_in[10]; p.lru_w_a = (const float*)d_in[11];
    p.lru_b_a = (const float*)d_in[12]; p.lru_w_x = (const float*)d_in[13]; p.lru_b_x = (const float*)d_in[14];
    p.lru_lambda = (const float*)d_in[15]; p.lru_w_out = (const float*)d_in[16]; p.final_g = (const float*)d_in[17];
    p.out = (float*)d_out;
    char* w = (char*)d_ws; size_t off = 0;
    auto take = [&](size_t bytes) { char* r = w + off; off += (bytes + 255) & ~(size_t)255; return r; };
    p.wt_in0 = (bf16_t*)take((size_t)4096 * 1024 * 2);
    p.wt_out0 = (bf16_t*)take((size_t)1024 * 1024 * 2);
    p.wt_in1 = (bf16_t*)take((size_t)2048 * 1024 * 2);
    p.wt_out1 = (bf16_t*)take((size_t)1024 * 1024 * 2);
    p.wa_t = (bf16_t*)take((size_t)8 * 128 * 128 * 2);
    p.wx_t = (bf16_t*)take((size_t)8 * 128 * 128 * 2);
    p.mod = (float*)take((size_t)2 * 16 * 3072 * 4);
    p.kmean = (float*)take((size_t)16 * 8 * 16 * 64 * 4);
    p.h = (bf16_t*)take((size_t)NTOK * 1024 * 2);
    const size_t hd = (size_t)16 * 8 * 4096 * 64 * 2;
    p.qa = (bf16_t*)take(hd); p.ka = (bf16_t*)take(hd); p.vta = (bf16_t*)take(hd);
    p.qb = (bf16_t*)take(hd); p.kb = (bf16_t*)take(hd); p.vtb = (bf16_t*)take(hd);
    p.gates = (bf16_t*)take((size_t)NTOK * 1024 * 2);
    p.ypre = (bf16_t*)take((size_t)NTOK * 1024 * 2);
    p.bar = (unsigned*)take(16384);
    p.mcnt = (int*)take((size_t)128 * 16 * 4);
    p.mlist = (unsigned short*)take((size_t)128 * 16 * LCAP * 2);
    p.part_ml = (float*)take((size_t)128 * 4096 * 3 * 2 * 4);
    p.part_o = (bf16_t*)take((size_t)128 * 4096 * 3 * 64 * 2);
    p.xb = p.qa;
    p.gl = p.vta;
    hipMemsetAsync(p.bar, 0, 16384, stream);
    void* args[] = {&p};
    hipError_t e = hipLaunchCooperativeKernel((const void*)mega_fwd, dim3(grid_blocks), dim3(512), args, kDynLds, stream);
    if (e != hipSuccess) fprintf(stderr, "cooperative launch failed: %s (grid %d)\n", hipGetErrorString(e), grid_blocks);
}
```

```cpp
#include <hip/hip_runtime.h>
#include <hip/hip_cooperative_groups.h>
#include <stdint.h>
#include <cstdio>
namespace cg = cooperative_groups;

#define DEVI __device__ __forceinline__
typedef unsigned short bf16_t;
typedef short bf16x8 __attribute__((ext_vector_type(8)));
typedef short bf16x4 __attribute__((ext_vector_type(4)));
typedef float f32x4 __attribute__((ext_vector_type(4)));

constexpr int NB = 16, SEQ = 4096, DM = 1024, NTOK = NB * SEQ;

struct Params {
    const float *x, *c; const int* positions;
    const float *norm_g, *w_mod, *b_mod, *attn_w_in, *attn_w_out, *lru_w_in, *lru_conv_w, *lru_conv_b,
        *lru_w_a, *lru_b_a, *lru_w_x, *lru_b_x, *lru_lambda, *lru_w_out, *final_g;
    float* out;
    bf16_t *wt_in0, *wt_out0, *wt_in1, *wt_out1, *wa_t, *wx_t;
    float *mod, *kmean, *part_ml; unsigned* bar; int* mcnt; unsigned short* mlist; bf16_t* part_o;
    bf16_t *h, *qa, *ka, *vta, *qb, *kb, *vtb, *gates, *ypre, *xb, *gl;
};

DEVI bf16_t f2bf(float f) { unsigned u = __float_as_uint(f); u += 0x7fffu + ((u >> 16) & 1u); return (bf16_t)(u >> 16); }
DEVI float bf2f(bf16_t h) { return __uint_as_float(((unsigned)h) << 16); }
DEVI float bfs2f(short h) { return __uint_as_float(((unsigned)(unsigned short)h) << 16); }
typedef __bf16 bf16x2_t __attribute__((ext_vector_type(2)));
typedef float f32x2_t __attribute__((ext_vector_type(2)));
DEVI unsigned pack2(float a, float b) { const f32x2_t v = {a, b}; const bf16x2_t h = __builtin_convertvector(v, bf16x2_t); return __builtin_bit_cast(unsigned, h); }
DEVI float wave_sum(float v) {
#pragma unroll
    for (int o = 32; o > 0; o >>= 1) v += __shfl_xor(v, o);
    return v;
}
DEVI float sx16(float x, int fq) { const auto r = __builtin_amdgcn_permlane16_swap(__float_as_uint(x), __float_as_uint(x), false, false); return __uint_as_float((fq & 1) ? r[0] : r[1]); }
DEVI float sx32(float x, int fq) { const auto r = __builtin_amdgcn_permlane32_swap(__float_as_uint(x), __float_as_uint(x), false, false); return __uint_as_float((fq & 2) ? r[0] : r[1]); }
DEVI float sigmoidf_(float x) { return __builtin_amdgcn_rcpf(1.0f + __expf(-x)); }

DEVI void transpose_tile(const float* __restrict__ W, bf16_t* Wt, int K, int N, int tile, float* lds) {
    const int tn = N >> 6; const int tk = tile / tn, tnn = tile - tk * tn; const int k0 = tk * 64, n0 = tnn * 64;
    const int tid = threadIdx.x;
#pragma unroll
    for (int i = 0; i < 2; ++i) {
        const int r = (tid >> 4) + i * 32, c4 = tid & 15;
        const float4 v = *(const float4*)(W + (size_t)(k0 + r) * N + n0 + c4 * 4);
        float* d = lds + r * 65 + c4 * 4; d[0] = v.x; d[1] = v.y; d[2] = v.z; d[3] = v.w;
    }
    __syncthreads();
    const int n = tid >> 3, kc = tid & 7;
    unsigned pk[4];
#pragma unroll
    for (int j = 0; j < 4; ++j) pk[j] = pack2(lds[(kc * 8 + 2 * j) * 65 + n], lds[(kc * 8 + 2 * j + 1) * 65 + n]);
    *(uint4*)(Wt + (size_t)(n0 + n) * K + k0 + kc * 8) = make_uint4(pk[0], pk[1], pk[2], pk[3]);
    __syncthreads();
}

DEVI void mod_unit(const Params& p, int unit, float* lds) {
    float* cl = lds;
    float* red = lds + 16384;
    const int tid = threadIdx.x;
    for (int i = tid; i < 4096; i += 512) ((float4*)cl)[i] = ((const float4*)p.c)[i];
    __syncthreads();
    const int l = unit / 96, n0 = (unit % 96) * 32; const int ks = tid >> 5, col = tid & 31;
    float acc[16];
#pragma unroll
    for (int b = 0; b < 16; ++b) acc[b] = 0.f;
    const float* w = p.w_mod + (size_t)l * 1024 * 3072 + n0 + col;
#pragma unroll 8
    for (int k = ks * 64; k < ks * 64 + 64; ++k) {
        const float wv = w[(size_t)k * 3072];
#pragma unroll
        for (int b = 0; b < 16; ++b) acc[b] += cl[b * 1024 + k] * wv;
    }
#pragma unroll
    for (int b = 0; b < 16; ++b) red[(ks * 16 + b) * 32 + col] = acc[b];
    __syncthreads();
    {
        const int b = tid >> 5; float s = 0.f;
#pragma unroll
        for (int k2 = 0; k2 < 16; ++k2) s += red[(k2 * 16 + b) * 32 + col];
        p.mod[(l * 16 + b) * 3072 + n0 + col] = s + p.b_mod[l * 3072 + n0 + col];
    }
    __syncthreads();
}

DEVI void phase_a(const Params& p, char* smem) {
    float* lds = (float*)smem;
    constexpr int U_MOD = 192, T_IN0 = 16 * 64, T_OUT0 = 16 * 16, T_IN1 = 16 * 32, T_OUT1 = 16 * 16, T_G = 8 * 4;
    constexpr int TOTAL = U_MOD + T_IN0 + T_OUT0 + T_IN1 + T_OUT1 + 2 * T_G;
    for (int u = blockIdx.x; u < TOTAL; u += gridDim.x) {
        int v = u;
        if (v < U_MOD) { mod_unit(p, v, lds); continue; } v -= U_MOD;
        if (v < T_IN0) { transpose_tile(p.attn_w_in, p.wt_in0, 1024, 4096, v, lds); continue; } v -= T_IN0;
        if (v < T_OUT0) { transpose_tile(p.attn_w_out, p.wt_out0, 1024, 1024, v, lds); continue; } v -= T_OUT0;
        if (v < T_IN1) { transpose_tile(p.lru_w_in, p.wt_in1, 1024, 2048, v, lds); continue; } v -= T_IN1;
        if (v < T_OUT1) { transpose_tile(p.lru_w_out, p.wt_out1, 1024, 1024, v, lds); continue; } v -= T_OUT1;
        if (v < T_G) { const int blk = v >> 2; transpose_tile(p.lru_w_a + blk * 16384, p.wa_t + blk * 16384, 128, 128, v & 3, lds); continue; } v -= T_G;
        { const int blk = v >> 2; transpose_tile(p.lru_w_x + blk * 16384, p.wx_t + blk * 16384, 128, 128, v & 3, lds); }
    }
    for (int i = blockIdx.x * 512 + threadIdx.x; i < 16 * 8 * 16 * 64; i += gridDim.x * 512) __hip_atomic_store(p.kmean + i, 0.f, __ATOMIC_RELAXED, __HIP_MEMORY_SCOPE_AGENT);
    for (int i = blockIdx.x * 512 + threadIdx.x; i < 128 * 16; i += gridDim.x * 512) __hip_atomic_store(p.mcnt + i, 0, __ATOMIC_RELAXED, __HIP_MEMORY_SCOPE_AGENT);
}

DEVI void prenorm_phase(const float* xin, const float* __restrict__ g, const float* modl, bf16_t* hout) {
    const int wave = threadIdx.x >> 6, lane = threadIdx.x & 63;
    const int stride = gridDim.x * 8;
    int row = blockIdx.x * 8 + wave;
    float4 nx[4];
#pragma unroll
    for (int i = 0; i < 4; ++i) nx[i] = ((const float4*)(xin + (size_t)(row < NTOK ? row : 0) * DM))[lane + 64 * i];
    for (; row < NTOK; row += stride) {
        float4 v[4]; float ss = 0.f;
#pragma unroll
        for (int i = 0; i < 4; ++i) { v[i] = nx[i]; ss += v[i].x * v[i].x + v[i].y * v[i].y + v[i].z * v[i].z + v[i].w * v[i].w; }
        { const int rn = (row + stride < NTOK) ? row + stride : row;
#pragma unroll
          for (int i = 0; i < 4; ++i) nx[i] = ((const float4*)(xin + (size_t)rn * DM))[lane + 64 * i]; }
        ss = wave_sum(ss);
        const float rinv = rsqrtf(ss * (1.0f / 1024.0f) + 1e-6f);
        const float* md = modl + (row >> 12) * 3072;
#pragma unroll
        for (int i = 0; i < 4; ++i) {
            const int k = (lane + 64 * i) * 4;
            const float4 gg = *(const float4*)(g + k), sh = *(const float4*)(md + k), sc = *(const float4*)(md + 1024 + k);
            const float o0 = v[i].x * rinv * gg.x * (1.f + sc.x) + sh.x, o1 = v[i].y * rinv * gg.y * (1.f + sc.y) + sh.y;
            const float o2 = v[i].z * rinv * gg.z * (1.f + sc.z) + sh.z, o3 = v[i].w * rinv * gg.w * (1.f + sc.w) + sh.w;
            *(uint2*)(hout + (size_t)row * DM + k) = make_uint2(pack2(o0, o1), pack2(o2, o3));
        }
    }
}

DEVI void bf8_to_f(const uint4 u, float (&f)[8]) {
    f[0] = __uint_as_float(u.x << 16); f[1] = __uint_as_float(u.x & 0xffff0000u); f[2] = __uint_as_float(u.y << 16); f[3] = __uint_as_float(u.y & 0xffff0000u);
    f[4] = __uint_as_float(u.z << 16); f[5] = __uint_as_float(u.z & 0xffff0000u); f[6] = __uint_as_float(u.w << 16); f[7] = __uint_as_float(u.w & 0xffff0000u);
}
DEVI void prenorm_bf_phase(const bf16_t* xin, const float* __restrict__ g, const float* modl, bf16_t* hout) {
    const int wave = threadIdx.x >> 6, lane = threadIdx.x & 63;
    const int stride = gridDim.x * 8;
    int row = blockIdx.x * 8 + wave;
    uint4 nx0 = ((const uint4*)(xin + (size_t)(row < NTOK ? row : 0) * DM))[lane], nx1 = ((const uint4*)(xin + (size_t)(row < NTOK ? row : 0) * DM))[lane + 64];
    for (; row < NTOK; row += stride) {
        float v[2][8]; float ss = 0.f;
        bf8_to_f(nx0, v[0]); bf8_to_f(nx1, v[1]);
        { const int rn = (row + stride < NTOK) ? row + stride : row;
          nx0 = ((const uint4*)(xin + (size_t)rn * DM))[lane]; nx1 = ((const uint4*)(xin + (size_t)rn * DM))[lane + 64]; }
#pragma unroll
        for (int i = 0; i < 2; ++i)
#pragma unroll
            for (int e = 0; e < 8; ++e) ss += v[i][e] * v[i][e];
        ss = wave_sum(ss);
        const float rinv = rsqrtf(ss * (1.0f / 1024.0f) + 1e-6f);
        const float* md = modl + (row >> 12) * 3072;
#pragma unroll
        for (int i = 0; i < 2; ++i) {
            const int k = (lane + 64 * i) * 8;
            float o[8];
#pragma unroll
            for (int h2 = 0; h2 < 2; ++h2) {
                const float4 gg = *(const float4*)(g + k + 4 * h2), sh = *(const float4*)(md + k + 4 * h2), sc = *(const float4*)(md + 1024 + k + 4 * h2);
                o[4 * h2 + 0] = v[i][4 * h2 + 0] * rinv * gg.x * (1.f + sc.x) + sh.x; o[4 * h2 + 1] = v[i][4 * h2 + 1] * rinv * gg.y * (1.f + sc.y) + sh.y;
                o[4 * h2 + 2] = v[i][4 * h2 + 2] * rinv * gg.z * (1.f + sc.z) + sh.z; o[4 * h2 + 3] = v[i][4 * h2 + 3] * rinv * gg.w * (1.f + sc.w) + sh.w;
            }
            *(uint4*)(hout + (size_t)row * DM + k) = make_uint4(pack2(o[0], o[1]), pack2(o[2], o[3]), pack2(o[4], o[5]), pack2(o[6], o[7]));
        }
    }
}
DEVI void final_norm_bf_phase(const bf16_t* xin, float* out, const float* __restrict__ g) {
    const int wave = threadIdx.x >> 6, lane = threadIdx.x & 63;
    const int stride = gridDim.x * 8;
    int row = blockIdx.x * 8 + wave;
    uint4 nx0 = ((const uint4*)(xin + (size_t)(row < NTOK ? row : 0) * DM))[lane], nx1 = ((const uint4*)(xin + (size_t)(row < NTOK ? row : 0) * DM))[lane + 64];
    for (; row < NTOK; row += stride) {
        float v[2][8]; float ss = 0.f;
        bf8_to_f(nx0, v[0]); bf8_to_f(nx1, v[1]);
        { const int rn = (row + stride < NTOK) ? row + stride : row;
          nx0 = ((const uint4*)(xin + (size_t)rn * DM))[lane]; nx1 = ((const uint4*)(xin + (size_t)rn * DM))[lane + 64]; }
#pragma unroll
        for (int i = 0; i < 2; ++i)
#pragma unroll
            for (int e = 0; e < 8; ++e) ss += v[i][e] * v[i][e];
        ss = wave_sum(ss);
        const float rinv = rsqrtf(ss * (1.0f / 1024.0f) + 1e-6f);
#pragma unroll
        for (int i = 0; i < 2; ++i) {
            const int k = (lane + 64 * i) * 8;
#pragma unroll
            for (int h2 = 0; h2 < 2; ++h2) {
                const float4 gg = *(const float4*)(g + k + 4 * h2);
                float4 o; o.x = v[i][4 * h2 + 0] * rinv * gg.x; o.y = v[i][4 * h2 + 1] * rinv * gg.y; o.z = v[i][4 * h2 + 2] * rinv * gg.z; o.w = v[i][4 * h2 + 3] * rinv * gg.w;
                *(float4*)(out + (size_t)row * DM + k + 4 * h2) = o;
            }
        }
    }
}

DEVI void final_norm_phase(float* xio, const float* __restrict__ g) {
    const int wave = threadIdx.x >> 6, lane = threadIdx.x & 63;
    for (int row = blockIdx.x * 8 + wave; row < NTOK; row += gridDim.x * 8) {
        float4* xr = (float4*)(xio + (size_t)row * DM);
        float4 v[4]; float ss = 0.f;
#pragma unroll
        for (int i = 0; i < 4; ++i) { v[i] = xr[lane + 64 * i]; ss += v[i].x * v[i].x + v[i].y * v[i].y + v[i].z * v[i].z + v[i].w * v[i].w; }
        ss = wave_sum(ss);
        const float rinv = rsqrtf(ss * (1.0f / 1024.0f) + 1e-6f);
#pragma unroll
        for (int i = 0; i < 4; ++i) {
            const float4 gg = *(const float4*)(g + (lane + 64 * i) * 4);
            float4 o; o.x = v[i].x * rinv * gg.x; o.y = v[i].y * rinv * gg.y; o.z = v[i].z * rinv * gg.z; o.w = v[i].w * rinv * gg.w;
            xr[lane + 64 * i] = o;
        }
    }
}

#define LAS __attribute__((address_space(3)))
constexpr int BM = 256, BK = 64, HALF = 128, HTB = HALF * BK * 2, NXCD = 8, WGM = 8;
DEVI int lds_byte(int r, int c) { const int st = (r >> 4) * 2 + (c >> 5), rr = r & 15, cc = c & 31, ob = rr * 64 + cc * 2; return st * 1024 + (ob ^ (((ob >> 9) & 1) << 5)); }
DEVI void stage_rc(int b, int& R, int& C) { const int st = b / 1024, sb = b % 1024, swz = sb ^ (((sb >> 9) & 1) << 5); R = (st >> 1) * 16 + swz / 64; C = (st & 1) * 32 + (swz % 64) / 2; }
DEVI int perm32(int rho) { const int n = rho >> 4, i = rho & 15; return 8 * (i >> 2) + 4 * n + (i & 3); }
struct Unit { int pm, pn; };
struct StaticOrder {
    int nM, nN, nwg, G, c;
    DEVI void init(int M, int N, int G_, int c_) { nM = M / BM; nN = N / BM; nwg = nM * nN; G = G_; c = c_; }
    DEVI bool next(int i, Unit& u) const {
        const long L = (long)i * G + c; if (L >= nwg) return false;
        int wgid = (int)L; { const int q = nwg / NXCD, r = nwg % NXCD, xcd = wgid % NXCD, off = wgid / NXCD; wgid = (xcd < r ? xcd * (q + 1) : r * (q + 1) + (xcd - r) * q) + off; }
        const int nig = WGM * nN, gid = wgid / nig, fm = gid * WGM, gsz = (nM - fm) < WGM ? (nM - fm) : WGM;
        u.pm = fm + ((wgid % nig) % gsz); u.pn = (wgid % nig) / gsz; return true;
    }
};

template <class Epi>
DEVI void gemm_phase(const bf16_t* gA, const bf16_t* gBt, const int M, const int N, const int K, char* smem, const Epi& E) {
    LAS unsigned char* lds = (LAS unsigned char*)smem;
    StaticOrder S; S.init(M, N, gridDim.x, blockIdx.x);
    int tid = threadIdx.x; asm volatile("" : "+v"(tid));
    const int wid = __builtin_amdgcn_readfirstlane(tid >> 6), lane = tid & 63, wr = wid >> 2, wc = wid & 3, fr = lane & 15, fq = lane >> 4;
    const int nt = K / BK;
    unsigned voffA[2], voffB[2];
#pragma unroll
    for (int i = 0; i < 2; ++i) { int R, C; stage_rc(tid * 16 + i * 8192, R, C); voffA[i] = (unsigned)(R * K + C) * 2u;
        const int Rb = Epi::PERM ? ((R & ~31) + perm32(R & 31)) : R; voffB[i] = (unsigned)(Rb * K + C) * 2u; }
    const size_t kstep = (size_t)(BK * 2);
    const size_t hstep = (size_t)HALF * K * 2;
    const size_t tstep = 2 * hstep;
    const unsigned ldsw = (unsigned)wid * 1024u;
    const int aoff = lds_byte(wr * 64 + fr, fq * 8), boff = lds_byte(wc * 32 + fr, fq * 8);
#define PG8_SA(b, h) (((b) * 2 + (h)) * HTB)
#define PG8_SB(b, h) ((4 + (b) * 2 + (h)) * HTB)
#define PG8_STAGE(bufoff, gbase, voff) do { _Pragma("unroll") for (int _i = 0; _i < 2; ++_i) \
        __builtin_amdgcn_global_load_lds((const __attribute__((address_space(1))) unsigned*)((const char*)(gbase) + (voff)[_i]), (LAS unsigned*)(lds + (bufoff) + ldsw + _i * 8192), 16, 0, 0); } while (0)
#define PG8_LDA(dst, b, h) do { _Pragma("unroll") for (int m = 0; m < 4; ++m) _Pragma("unroll") for (int k = 0; k < 2; ++k) dst[m][k] = *(const LAS bf16x8*)(lds + PG8_SA(b, h) + aoff + m * 2048 + k * 1024); } while (0)
#define PG8_LDB(dst, b, h) do { _Pragma("unroll") for (int n = 0; n < 2; ++n) _Pragma("unroll") for (int k = 0; k < 2; ++k) dst[n][k] = *(const LAS bf16x8*)(lds + PG8_SB(b, h) + boff + n * 2048 + k * 1024); } while (0)
#define PG8_MMA(ai, bj, At, Bt) do { __builtin_amdgcn_s_setprio(1); _Pragma("unroll") for (int m = 0; m < 4; ++m) _Pragma("unroll") for (int n = 0; n < 2; ++n) _Pragma("unroll") for (int k = 0; k < 2; ++k) \
        acc[ai][bj][m][n] = __builtin_amdgcn_mfma_f32_16x16x32_bf16(Bt[n][k], At[m][k], acc[ai][bj][m][n], 0, 0, 0); __builtin_amdgcn_s_setprio(0); } while (0)
#define PG8_WAIT_V(n) asm volatile("s_waitcnt vmcnt(" #n ")" ::: "memory")
#define PG8_WAIT_L(n) asm volatile("s_waitcnt lgkmcnt(" #n ")" ::: "memory")
#define PG8_BAR __builtin_amdgcn_s_barrier()
#define PG8_SCHED __builtin_amdgcn_sched_barrier(0)
    Unit cur, nxt; int ui = 0;
    if (!S.next(0, cur)) return;
    f32x4 acc[2][2][4][2];
#pragma unroll
    for (int a = 0; a < 2; ++a)
#pragma unroll
        for (int b = 0; b < 2; ++b)
#pragma unroll
            for (int m = 0; m < 4; ++m)
#pragma unroll
                for (int n = 0; n < 2; ++n) acc[a][b][m][n] = (f32x4){0.f, 0.f, 0.f, 0.f};
    bf16x8 At[4][2], B0[2][2], B1[2][2];
    const char* cA = (const char*)gA + (size_t)cur.pm * tstep; const char* cB = (const char*)gBt + (size_t)cur.pn * tstep;
    PG8_STAGE(PG8_SB(0, 0), cB, voffB); PG8_STAGE(PG8_SB(0, 1), cB + hstep, voffB); PG8_STAGE(PG8_SA(0, 0), cA, voffA); PG8_STAGE(PG8_SA(0, 1), cA + hstep, voffA);
    if (wr == 1) PG8_BAR;
    PG8_WAIT_V(2); PG8_BAR;
    PG8_STAGE(PG8_SB(1, 0), cB + kstep, voffB); PG8_STAGE(PG8_SA(1, 0), cA + kstep, voffA); PG8_STAGE(PG8_SB(1, 1), cB + hstep + kstep, voffB);
    PG8_WAIT_V(6); PG8_BAR;
    for (;;) {
        const bool has_next = S.next(ui + 1, nxt);
        const char* nA = has_next ? (const char*)gA + (size_t)nxt.pm * tstep : cA; const char* nB = has_next ? (const char*)gBt + (size_t)nxt.pn * tstep : cB;
        for (int t = 0; t < nt; t += 2) {
            const bool last = (t == nt - 2);
            const char* a1 = cA + (size_t)(t + 1) * kstep;
            const char* a2 = last ? nA : cA + (size_t)(t + 2) * kstep; const char* b2 = last ? nB : cB + (size_t)(t + 2) * kstep;
            const char* a3 = a2 + kstep; const char* b3 = b2 + kstep;
            PG8_LDB(B0, 0, 0); PG8_LDB(B1, 0, 1); PG8_SCHED; PG8_LDA(At, 0, 0); PG8_STAGE(PG8_SA(1, 1), a1 + hstep, voffA);
            PG8_WAIT_V(8); PG8_WAIT_L(0); PG8_BAR; PG8_MMA(0, 0, At, B0); PG8_MMA(0, 1, At, B1); PG8_BAR; PG8_SCHED;
            PG8_LDA(At, 0, 1); PG8_STAGE(PG8_SB(0, 0), b2, voffB); PG8_STAGE(PG8_SB(0, 1), b2 + hstep, voffB); PG8_STAGE(PG8_SA(0, 0), a2, voffA);
            PG8_WAIT_V(8); PG8_WAIT_L(0); PG8_BAR; PG8_MMA(1, 0, At, B0); PG8_MMA(1, 1, At, B1); PG8_BAR; PG8_SCHED;
            PG8_LDB(B0, 1, 0); PG8_LDB(B1, 1, 1); PG8_SCHED; PG8_LDA(At, 1, 0); PG8_STAGE(PG8_SA(0, 1), a2 + hstep, voffA);
            PG8_WAIT_V(8); PG8_WAIT_L(0); PG8_BAR; PG8_MMA(0, 0, At, B0); PG8_MMA(0, 1, At, B1); PG8_BAR; PG8_SCHED;
            PG8_LDA(At, 1, 1); PG8_STAGE(PG8_SB(1, 0), b3, voffB); PG8_STAGE(PG8_SB(1, 1), b3 + hstep, voffB); PG8_STAGE(PG8_SA(1, 0), a3, voffA);
            PG8_WAIT_V(8); PG8_WAIT_L(0); PG8_BAR; PG8_MMA(1, 0, At, B0); PG8_MMA(1, 1, At, B1); PG8_BAR; PG8_SCHED;
        }
        if (wr == 0) PG8_BAR;
        E(acc, cur.pm * BM, cur.pn * BM, wr, wc, fr, fq);
        PG8_WAIT_V(0);
        if (!has_next) break;
#pragma unroll
        for (int a = 0; a < 2; ++a)
#pragma unroll
            for (int b = 0; b < 2; ++b)
#pragma unroll
                for (int m = 0; m < 4; ++m)
#pragma unroll
                    for (int n = 0; n < 2; ++n) acc[a][b][m][n] = (f32x4){0.f, 0.f, 0.f, 0.f};
        cur = nxt; cA = nA; cB = nB; ++ui;
        if (wr == 1) PG8_BAR;
    }
    PG8_WAIT_V(0);
    PG8_BAR;
#undef PG8_SA
#undef PG8_SB
#undef PG8_STAGE
#undef PG8_LDA
#undef PG8_LDB
#undef PG8_MMA
}

constexpr size_t HD = (size_t)16 * 8 * 4096 * 64;
struct Epi1P { const int* positions; float* kmean; bf16_t* gates; bf16_t* qkv; };
struct Epi1 {
    static constexpr bool PERM = true;
    Epi1P p;
    DEVI void operator()(f32x4 (&acc)[2][2][4][2], int brow, int bcol, int wr, int wc, int fr, int fq) const {
        const int grp = bcol >> 9, cbase = bcol & 511;
        const int b = brow >> 12, s0 = brow & 4095;
        if ((grp == 3 || grp == 4) && ((wc & 1) == 0)) {
            const float invt[8] = {1.0f, 0.19392274474868576f, 0.03760603093086393f, 0.007292664737217109f,
                                   0.001414213562373095f, 0.0002742481756762073f, 5.318295896944988e-05f, 1.031338537721246e-05f};
#pragma unroll
            for (int ai = 0; ai < 2; ++ai)
#pragma unroll
                for (int m = 0; m < 4; ++m) {
                    const int s = s0 + ai * 128 + wr * 64 + m * 16 + fr;
                    const float pos = (float)p.positions[b * 4096 + s];
#pragma unroll
                    for (int n = 0; n < 2; ++n)
#pragma unroll
                        for (int j = 0; j < 4; ++j) {
                            const float ang = pos * invt[n * 4 + j];
                            const float rvf = __builtin_amdgcn_fractf(ang * 0.15915494309189535f);
                            const float sn = __builtin_amdgcn_sinf(rvf), cs = __builtin_amdgcn_cosf(rvf);
#pragma unroll
                            for (int bj = 0; bj < 2; ++bj) {
                                const float v = acc[ai][bj][m][n][j];
                                const float pr = sx16(v, fq);
                                const float rot = (fq == 0) ? (v * cs - pr * sn) : (v * cs + pr * sn);
                                acc[ai][bj][m][n][j] = (fq < 2) ? rot : v;
                            }
                        }
                }
        }
        if (grp == 4) {
            const int nblk = s0 >> 8;
#pragma unroll
            for (int bj = 0; bj < 2; ++bj)
#pragma unroll
                for (int n = 0; n < 2; ++n)
#pragma unroll
                    for (int j = 0; j < 4; ++j) {
                        float cs = 0.f;
#pragma unroll
                        for (int ai = 0; ai < 2; ++ai)
#pragma unroll
                            for (int m = 0; m < 4; ++m) cs += acc[ai][bj][m][n][j];
                        cs += __shfl_xor(cs, 1); cs += __shfl_xor(cs, 2); cs += __shfl_xor(cs, 4); cs += __shfl_xor(cs, 8);
                        if (fr == 0) {
                            const int colg = cbase + bj * 128 + wc * 32 + fq * 8 + n * 4 + j;
                            atomicAdd(p.kmean + ((size_t)((b * 8 + (colg >> 6)) * 16 + nblk)) * 64 + (colg & 63), cs);
                        }
                    }
        }
        if (grp >= 6) {
#pragma unroll
            for (int ai = 0; ai < 2; ++ai)
#pragma unroll
                for (int m = 0; m < 4; ++m) {
                    const size_t tok = (size_t)brow + ai * 128 + wr * 64 + m * 16 + fr;
#pragma unroll
                    for (int bj = 0; bj < 2; ++bj) {
                        const int gc = (grp - 6) * 512 + cbase + bj * 128 + wc * 32 + fq * 8;
                        const f32x4 v0 = acc[ai][bj][m][0], v1 = acc[ai][bj][m][1];
                        *(uint4*)(p.gates + tok * 1024 + gc) = make_uint4(pack2(v0[0], v0[1]), pack2(v0[2], v0[3]), pack2(v1[0], v1[1]), pack2(v1[2], v1[3]));
                    }
                }
        } else if (grp == 2 || grp == 5) {
            bf16_t* dst = p.qkv + (size_t)grp * HD;
#pragma unroll
            for (int ai = 0; ai < 2; ++ai)
#pragma unroll
                for (int m = 0; m < 4; ++m) {
                    const int s = s0 + ai * 128 + wr * 64 + m * 16 + fr;
#pragma unroll
                    for (int bj = 0; bj < 2; ++bj)
#pragma unroll
                        for (int n = 0; n < 2; ++n) {
                            const int colg = cbase + bj * 128 + wc * 32 + fq * 8 + n * 4;
                            const f32x4 v = acc[ai][bj][m][n];
                            bf16_t* d0 = dst + ((size_t)((b * 8 + (colg >> 6)) * 64 + (colg & 63))) * 4096 + s;
#pragma unroll
                            for (int j = 0; j < 4; ++j) d0[(size_t)j * 4096] = f2bf(v[j]);
                        }
                }
        } else {
            bf16_t* dst = p.qkv + (size_t)grp * HD;
            const float qsc = (grp == 0) ? 0.125f : (grp == 3) ? (0.125f * 1.4426950408889634f) : 1.0f;
#pragma unroll
            for (int ai = 0; ai < 2; ++ai)
#pragma unroll
                for (int m = 0; m < 4; ++m) {
                    const int s = s0 + ai * 128 + wr * 64 + m * 16 + fr;
#pragma unroll
                    for (int bj = 0; bj < 2; ++bj) {
                        const int colg = cbase + bj * 128 + wc * 32 + fq * 8;
                        const f32x4 v0 = acc[ai][bj][m][0], v1 = acc[ai][bj][m][1];
                        *(uint4*)(dst + ((size_t)((b * 8 + (colg >> 6)) * 4096 + s)) * 64 + (colg & 63)) =
                            make_uint4(pack2(v0[0] * qsc, v0[1] * qsc), pack2(v0[2] * qsc, v0[3] * qsc), pack2(v1[0] * qsc, v1[1] * qsc), pack2(v1[2] * qsc, v1[3] * qsc));
                    }
                }
        }
    }
};

struct EpiRes {
    static constexpr bool PERM = false;
    const float* base; float* out; const float* gate;
    DEVI void operator()(f32x4 (&acc)[2][2][4][2], int brow, int bcol, int wr, int wc, int fr, int fq) const {
        const float* gt = gate + (brow >> 12) * 3072;
#pragma unroll
        for (int ai = 0; ai < 2; ++ai)
#pragma unroll
            for (int m = 0; m < 4; ++m) {
                const size_t row = (size_t)brow + ai * 128 + wr * 64 + m * 16 + fr;
#pragma unroll
                for (int bj = 0; bj < 2; ++bj)
#pragma unroll
                    for (int n = 0; n < 2; ++n) {
                        const int col = bcol + bj * 128 + wc * 32 + n * 16 + fq * 4;
                        const float4 bs = *(const float4*)(base + row * DM + col);
                        const float4 g = *(const float4*)(gt + col);
                        const f32x4 v = acc[ai][bj][m][n];
                        float4 o; o.x = bs.x + g.x * v[0]; o.y = bs.y + g.y * v[1]; o.z = bs.z + g.z * v[2]; o.w = bs.w + g.w * v[3];
                        *(float4*)(out + row * DM + col) = o;
                    }
            }
    }
};

template <bool BASE_BF16> struct EpiResP {
    static constexpr bool PERM = true;
    const void* base; bf16_t* outb; const float* gate;
    DEVI void operator()(f32x4 (&acc)[2][2][4][2], int brow, int bcol, int wr, int wc, int fr, int fq) const {
        const float* gt = gate + (brow >> 12) * 3072;
        float4 gv[2][2];
#pragma unroll
        for (int bj = 0; bj < 2; ++bj) { const int c0 = bcol + bj * 128 + wc * 32 + fq * 8; gv[bj][0] = *(const float4*)(gt + c0); gv[bj][1] = *(const float4*)(gt + c0 + 4); }
#pragma unroll
        for (int ai = 0; ai < 2; ++ai)
#pragma unroll
            for (int m = 0; m < 4; ++m) {
                const size_t row = (size_t)brow + ai * 128 + wr * 64 + m * 16 + fr;
#pragma unroll
                for (int bj = 0; bj < 2; ++bj) {
                    const int col = bcol + bj * 128 + wc * 32 + fq * 8;
                    float b[8];
                    if (BASE_BF16) bf8_to_f(*(const uint4*)((const bf16_t*)base + row * DM + col), b);
                    else { const float4 b0 = *(const float4*)((const float*)base + row * DM + col), b1 = *(const float4*)((const float*)base + row * DM + col + 4);
                           b[0] = b0.x; b[1] = b0.y; b[2] = b0.z; b[3] = b0.w; b[4] = b1.x; b[5] = b1.y; b[6] = b1.z; b[7] = b1.w; }
                    const float4 g0 = gv[bj][0], g1 = gv[bj][1];
                    const f32x4 v0 = acc[ai][bj][m][0], v1 = acc[ai][bj][m][1];
                    *(uint4*)(outb + row * DM + col) = make_uint4(pack2(b[0] + g0.x * v0[0], b[1] + g0.y * v0[1]), pack2(b[2] + g0.z * v0[2], b[3] + g0.w * v0[3]),
                                                                   pack2(b[4] + g1.x * v1[0], b[5] + g1.y * v1[1]), pack2(b[6] + g1.z * v1[2], b[7] + g1.w * v1[3]));
                }
            }
    }
};
struct Epi3P {
    static constexpr bool PERM = true;
    bf16_t *xb, *gl;
    DEVI void operator()(f32x4 (&acc)[2][2][4][2], int brow, int bcol, int wr, int wc, int fr, int fq) const {
        bf16_t* dst = (bcol < 1024) ? xb : gl; const int cb = bcol & 1023;
#pragma unroll
        for (int ai = 0; ai < 2; ++ai)
#pragma unroll
            for (int m = 0; m < 4; ++m) {
                const size_t row = (size_t)brow + ai * 128 + wr * 64 + m * 16 + fr;
#pragma unroll
                for (int bj = 0; bj < 2; ++bj) {
                    const int col = cb + bj * 128 + wc * 32 + fq * 8;
                    const f32x4 v0 = acc[ai][bj][m][0], v1 = acc[ai][bj][m][1];
                    *(uint4*)(dst + row * DM + col) = make_uint4(pack2(v0[0], v0[1]), pack2(v0[2], v0[3]), pack2(v1[0], v1[1]), pack2(v1[2], v1[3]));
                }
            }
    }
};

template <bool BASE_BF16> struct EpiResB {   static constexpr bool PERM = false;
    const void* base; bf16_t* outb; const float* gate;
    DEVI void operator()(f32x4 (&acc)[2][2][4][2], int brow, int bcol, int wr, int wc, int fr, int fq) const {
        const float* gt = gate + (brow >> 12) * 3072;
#pragma unroll
        for (int ai = 0; ai < 2; ++ai)
#pragma unroll
            for (int m = 0; m < 4; ++m) {
                const size_t row = (size_t)brow + ai * 128 + wr * 64 + m * 16 + fr;
#pragma unroll
                for (int bj = 0; bj < 2; ++bj)
#pragma unroll
                    for (int n = 0; n < 2; ++n) {
                        const int col = bcol + bj * 128 + wc * 32 + n * 16 + fq * 4;
                        float b0, b1, b2, b3;
                        if (BASE_BF16) { const uint2 u = *(const uint2*)((const bf16_t*)base + row * DM + col);
                            b0 = __uint_as_float(u.x << 16); b1 = __uint_as_float(u.x & 0xffff0000u); b2 = __uint_as_float(u.y << 16); b3 = __uint_as_float(u.y & 0xffff0000u); }
                        else { const float4 bs = *(const float4*)((const float*)base + row * DM + col); b0 = bs.x; b1 = bs.y; b2 = bs.z; b3 = bs.w; }
                        const float4 g = *(const float4*)(gt + col);
                        const f32x4 v = acc[ai][bj][m][n];
                        *(uint2*)(outb + row * DM + col) = make_uint2(pack2(b0 + g.x * v[0], b1 + g.y * v[1]), pack2(b2 + g.z * v[2], b3 + g.w * v[3]));
                    }
            }
    }
};

struct Epi3 {   static constexpr bool PERM = false;
    bf16_t *xb, *gl;
    DEVI void operator()(f32x4 (&acc)[2][2][4][2], int brow, int bcol, int wr, int wc, int fr, int fq) const {
        bf16_t* dst = (bcol < 1024) ? xb : gl; const int cb = bcol & 1023;
#pragma unroll
        for (int ai = 0; ai < 2; ++ai)
#pragma unroll
            for (int m = 0; m < 4; ++m) {
                const size_t row = (size_t)brow + ai * 128 + wr * 64 + m * 16 + fr;
#pragma unroll
                for (int bj = 0; bj < 2; ++bj)
#pragma unroll
                    for (int n = 0; n < 2; ++n) {
                        const int col = cb + bj * 128 + wc * 32 + n * 16 + fq * 4;
                        const f32x4 v = acc[ai][bj][m][n];
                        *(uint2*)(dst + row * DM + col) = make_uint2(pack2(v[0], v[1]), pack2(v[2], v[3]));
                    }
            }
    }
};

constexpr float SB_EXIT = -40.0f;
DEVI void sb_tile(const bf16x8 (&kf)[2][2], const bf16x4 (&vlo)[4], const bf16x4 (&vhi)[4], const bf16x8 (&qf)[2], f32x4 (&o)[4], float& carry, const int k0, const int t, const int fq) {
    f32x4 st[2];
#pragma unroll
    for (int u2 = 0; u2 < 2; ++u2) {
        st[u2] = (f32x4){0.f, 0.f, 0.f, 0.f};
#pragma unroll
        for (int kk = 0; kk < 2; ++kk) st[u2] = __builtin_amdgcn_mfma_f32_16x16x32_bf16(kf[u2][kk], qf[kk], st[u2], 0, 0, 0);
    }
    float w[2][4];
#pragma unroll
    for (int u2 = 1; u2 >= 0; --u2) {
        float z[4], c[4]; bool valid[4];
#pragma unroll
        for (int j = 0; j < 4; ++j) {
            const int key = k0 + 16 * u2 + fq * 4 + j;
            z[j] = st[u2][j]; valid[j] = key < t;
            const float sp = fmaxf(z[j], 0.f) + 0.6931471805599453f * __builtin_amdgcn_logf(1.0f + __builtin_amdgcn_exp2f(-1.4426950408889634f * fabsf(z[j])));
            c[j] = valid[j] ? -sp : 0.f;
        }
        c[2] += c[3]; c[1] += c[2]; c[0] += c[1];
        const float T = c[0];
        const float a = T + sx16(T, fq);
        const float b2 = sx32(a, fq);
        const float above = ((fq & 1) ? 0.f : 1.f) * (a - T) + ((fq & 2) ? 0.f : 1.f) * b2;
        const float base = carry + above;
#pragma unroll
        for (int j = 0; j < 4; ++j) w[u2][j] = valid[j] ? __builtin_amdgcn_exp2f(1.4426950408889634f * (z[j] + base + c[j])) : 0.f;
        carry += a + b2;
    }
    bf16x8 pf;
    { const uint4 pu = make_uint4(pack2(w[0][0], w[0][1]), pack2(w[0][2], w[0][3]), pack2(w[1][0], w[1][1]), pack2(w[1][2], w[1][3])); pf = *(const bf16x8*)&pu; }
#pragma unroll
    for (int dt = 0; dt < 4; ++dt) {
        bf16x8 vf;
        vf[0] = vlo[dt][0]; vf[1] = vlo[dt][1]; vf[2] = vlo[dt][2]; vf[3] = vlo[dt][3];
        vf[4] = vhi[dt][0]; vf[5] = vhi[dt][1]; vf[6] = vhi[dt][2]; vf[7] = vhi[dt][3];
        o[dt] = __builtin_amdgcn_mfma_f32_16x16x32_bf16(vf, pf, o[dt], 0, 0, 0);
    }
}

DEVI void sb_tile2(const bf16x8 (&kf)[2][2], const bf16x4 (&vlo)[4], const bf16x4 (&vhi)[4], const bf16x8 (&qf)[2][2], f32x4 (&o)[4][2], float (&carry)[2], const int k0, const int tq0, const int fr, const int fq, const bool masked) {
    f32x4 st[2][2];
#pragma unroll
    for (int u2 = 0; u2 < 2; ++u2)
#pragma unroll
        for (int qt = 0; qt < 2; ++qt) st[u2][qt] = __builtin_amdgcn_mfma_f32_16x16x32_bf16(kf[u2][0], qf[qt][0], (f32x4){0.f, 0.f, 0.f, 0.f}, 0, 0, 0);
#pragma unroll
    for (int u2 = 0; u2 < 2; ++u2)
#pragma unroll
        for (int qt = 0; qt < 2; ++qt) st[u2][qt] = __builtin_amdgcn_mfma_f32_16x16x32_bf16(kf[u2][1], qf[qt][1], st[u2][qt], 0, 0, 0);
    float c[2][2][4]; bool valid[2][2][4];
#pragma unroll
    for (int u2 = 0; u2 < 2; ++u2)
#pragma unroll
        for (int qt = 0; qt < 2; ++qt)
#pragma unroll
            for (int j = 0; j < 4; ++j) {
                const float z = st[u2][qt][j];
                const float sp = fmaxf(z, 0.f) + 0.6931471805599453f * __builtin_amdgcn_logf(1.0f + __builtin_amdgcn_exp2f(-1.4426950408889634f * fabsf(z)));
                valid[u2][qt][j] = masked ? ((k0 + 16 * u2 + fq * 4 + j) < (tq0 + qt * 16 + fr)) : true;
                c[u2][qt][j] = valid[u2][qt][j] ? -sp : 0.f;
            }
#pragma unroll
    for (int u2 = 0; u2 < 2; ++u2)
#pragma unroll
        for (int qt = 0; qt < 2; ++qt) { c[u2][qt][2] += c[u2][qt][3]; c[u2][qt][1] += c[u2][qt][2]; c[u2][qt][0] += c[u2][qt][1]; }
    float a[2][2], b2[2][2];
#pragma unroll
    for (int u2 = 0; u2 < 2; ++u2)
#pragma unroll
        for (int qt = 0; qt < 2; ++qt) a[u2][qt] = c[u2][qt][0] + sx16(c[u2][qt][0], fq);
#pragma unroll
    for (int u2 = 0; u2 < 2; ++u2)
#pragma unroll
        for (int qt = 0; qt < 2; ++qt) b2[u2][qt] = sx32(a[u2][qt], fq);
    const float m1 = (fq & 1) ? 0.f : 1.f, m2 = (fq & 2) ? 0.f : 1.f;
    float w[2][2][4];
#pragma unroll
    for (int qt = 0; qt < 2; ++qt) {
        const float tot1 = a[1][qt] + b2[1][qt], tot0 = a[0][qt] + b2[0][qt];
        const float base1 = carry[qt] + m1 * (a[1][qt] - c[1][qt][0]) + m2 * b2[1][qt];
        const float base0 = carry[qt] + tot1 + m1 * (a[0][qt] - c[0][qt][0]) + m2 * b2[0][qt];
#pragma unroll
        for (int j = 0; j < 4; ++j) {
            const float e1 = __builtin_amdgcn_exp2f(1.4426950408889634f * (st[1][qt][j] + base1 + c[1][qt][j]));
            const float e0 = __builtin_amdgcn_exp2f(1.4426950408889634f * (st[0][qt][j] + base0 + c[0][qt][j]));
            w[1][qt][j] = valid[1][qt][j] ? e1 : 0.f; w[0][qt][j] = valid[0][qt][j] ? e0 : 0.f;
        }
        carry[qt] += tot1 + tot0;
    }
    bf16x8 pf[2];
#pragma unroll
    for (int qt = 0; qt < 2; ++qt) {
        const uint4 pu = make_uint4(pack2(w[0][qt][0], w[0][qt][1]), pack2(w[0][qt][2], w[0][qt][3]), pack2(w[1][qt][0], w[1][qt][1]), pack2(w[1][qt][2], w[1][qt][3]));
        pf[qt] = *(const bf16x8*)&pu;
    }
#pragma unroll
    for (int dt = 0; dt < 4; ++dt) {
        bf16x8 vf;
        vf[0] = vlo[dt][0]; vf[1] = vlo[dt][1]; vf[2] = vlo[dt][2]; vf[3] = vlo[dt][3];
        vf[4] = vhi[dt][0]; vf[5] = vhi[dt][1]; vf[6] = vhi[dt][2]; vf[7] = vhi[dt][3];
        o[dt][0] = __builtin_amdgcn_mfma_f32_16x16x32_bf16(vf, pf[0], o[dt][0], 0, 0, 0);
        o[dt][1] = __builtin_amdgcn_mfma_f32_16x16x32_bf16(vf, pf[1], o[dt][1], 0, 0, 0);
    }
}

DEVI void sb_phase(const Params& p, char* smem) {
    bf16_t* Ks = (bf16_t*)smem;
    bf16_t* Vs = (bf16_t*)(smem + 55296);
    const int tid = threadIdx.x, wave = tid >> 6, lane = tid & 63, fr = lane & 15, fq = lane >> 4;
    uint4 kq0, kq1, kq2, kq3, kq4, kq5, vq0, vq1, vq2, vq3, vq4, vq5;
#define SB_KG(q_) ((kb_ + ((tid + (q_) * 512) >> 3)) >= 0 ? *(const uint4*)(Kp_ + (size_t)(kb_ + ((tid + (q_) * 512) >> 3)) * 64 + ((tid + (q_) * 512) & 7) * 8) : make_uint4(0, 0, 0, 0))
#define SB_VG(q_) ((kb_ + ((tid + (q_) * 512) % 48) * 8) >= 0 ? *(const uint4*)(Vt_ + (size_t)((tid + (q_) * 512) / 48) * 4096 + kb_ + ((tid + (q_) * 512) % 48) * 8) : make_uint4(0, 0, 0, 0))
#define SB_LOAD(u_) do { const int bh_ = (u_) >> 4, kb_ = ((u_) & 15) * 256 - 128; \
        const bf16_t* Kp_ = p.ka + (size_t)bh_ * 4096 * 64; const bf16_t* Vt_ = p.vta + (size_t)bh_ * 64 * 4096; \
        kq0 = SB_KG(0); kq1 = SB_KG(1); kq2 = SB_KG(2); kq3 = SB_KG(3); kq4 = SB_KG(4); kq5 = SB_KG(5); \
        vq0 = SB_VG(0); vq1 = SB_VG(1); vq2 = SB_VG(2); vq3 = SB_VG(3); vq4 = SB_VG(4); vq5 = SB_VG(5); } while (0)
#define SB_KS(q_) (*(uint4*)(Ks + ((tid + (q_) * 512) >> 3) * 72 + ((tid + (q_) * 512) & 7) * 8))
#define SB_VS(q_) (*(uint4*)(Vs + ((tid + (q_) * 512) / 48) * 392 + ((tid + (q_) * 512) % 48) * 8))
    int u = blockIdx.x;
    { const int u0 = u < 2048 ? u : 0; SB_LOAD(u0); }
    for (; u < 2048; u += gridDim.x) {
        const int bh = u >> 4, t0 = (u & 15) * 256, kbase = t0 - 128;
        __syncthreads();
        SB_KS(0) = kq0; SB_KS(1) = kq1; SB_KS(2) = kq2; SB_KS(3) = kq3; SB_KS(4) = kq4; SB_KS(5) = kq5;
        SB_VS(0) = vq0; SB_VS(1) = vq1; SB_VS(2) = vq2; SB_VS(3) = vq3; SB_VS(4) = vq4; SB_VS(5) = vq5;
        __syncthreads();
        { const int un = (u + (int)gridDim.x < 2048) ? u + (int)gridDim.x : u; SB_LOAD(un); }
        const int q0 = t0 + wave * 32;
        const bf16_t* Q = p.qa + (size_t)bh * 4096 * 64;
        bf16x8 qf[2][2];
#pragma unroll
        for (int qt = 0; qt < 2; ++qt)
#pragma unroll
            for (int kk = 0; kk < 2; ++kk) qf[qt][kk] = *(const bf16x8*)(Q + (size_t)(q0 + qt * 16 + fr) * 64 + kk * 32 + fq * 8);
        f32x4 o[4][2];
#pragma unroll
        for (int dt = 0; dt < 4; ++dt) { o[dt][0] = (f32x4){0.f, 0.f, 0.f, 0.f}; o[dt][1] = (f32x4){0.f, 0.f, 0.f, 0.f}; }
        float carry[2] = {0.f, 0.f};
        const int lo = kbase > 0 ? kbase : 0;
        bool done = false;
        for (int k0 = q0; k0 >= lo; k0 -= 32) {
            const int kl = k0 - kbase;
            bf16x8 kf[2][2]; bf16x4 vlo[4], vhi[4];
#pragma unroll
            for (int u2 = 0; u2 < 2; ++u2)
#pragma unroll
                for (int kk = 0; kk < 2; ++kk) kf[u2][kk] = *(const bf16x8*)(Ks + (kl + 16 * u2 + fr) * 72 + kk * 32 + fq * 8);
#pragma unroll
            for (int dt = 0; dt < 4; ++dt) {
                vlo[dt] = *(const bf16x4*)(Vs + (dt * 16 + fr) * 392 + kl + fq * 4);
                vhi[dt] = *(const bf16x4*)(Vs + (dt * 16 + fr) * 392 + kl + 16 + fq * 4);
            }
            sb_tile2(kf, vlo, vhi, qf, o, carry, k0, q0, fr, fq, k0 == q0);
            if (__all(carry[0] < SB_EXIT && carry[1] < SB_EXIT)) { done = true; break; }
        }
        if (!done && lo > 0) {
            const bf16_t* Kp = p.ka + (size_t)bh * 4096 * 64;
            const bf16_t* Vt = p.vta + (size_t)bh * 64 * 4096;
            for (int k0 = lo - 32; k0 >= 0; k0 -= 32) {
                bf16x8 kf[2][2]; bf16x4 vlo[4], vhi[4];
#pragma unroll
                for (int u2 = 0; u2 < 2; ++u2)
#pragma unroll
                    for (int kk = 0; kk < 2; ++kk) kf[u2][kk] = *(const bf16x8*)(Kp + (size_t)(k0 + 16 * u2 + fr) * 64 + kk * 32 + fq * 8);
#pragma unroll
                for (int dt = 0; dt < 4; ++dt) {
                    vlo[dt] = *(const bf16x4*)(Vt + (size_t)(dt * 16 + fr) * 4096 + k0 + fq * 4);
                    vhi[dt] = *(const bf16x4*)(Vt + (size_t)(dt * 16 + fr) * 4096 + k0 + 16 + fq * 4);
                }
                sb_tile2(kf, vlo, vhi, qf, o, carry, k0, q0, fr, fq, false);
                if (__all(carry[0] < SB_EXIT && carry[1] < SB_EXIT)) break;
            }
        }
        const int hcol = (bh & 7) * 64;
#pragma unroll
        for (int qt = 0; qt < 2; ++qt) {
            const size_t tok = (size_t)(bh >> 3) * 4096 + q0 + qt * 16 + fr;
#pragma unroll
            for (int dt = 0; dt < 4; ++dt) {
                const int dh = dt * 16 + fq * 4;
                const uint2 gu = *(const uint2*)(p.gates + tok * 1024 + hcol + dh);
                const float g0 = bf2f((bf16_t)(gu.x & 0xffff)), g1 = bf2f((bf16_t)(gu.x >> 16)), g2 = bf2f((bf16_t)(gu.y & 0xffff)), g3 = bf2f((bf16_t)(gu.y >> 16));
                const float y0 = o[dt][qt][0] * g0 * sigmoidf_(g0), y1 = o[dt][qt][1] * g1 * sigmoidf_(g1), y2 = o[dt][qt][2] * g2 * sigmoidf_(g2), y3 = o[dt][qt][3] * g3 * sigmoidf_(g3);
                *(uint2*)(p.ypre + tok * 1024 + hcol + dh) = make_uint2(pack2(y0, y1), pack2(y2, y3));
            }
        }
    }
#undef SB_LOAD
#undef SB_KG
#undef SB_VG
#undef SB_KS
#undef SB_VS
}

constexpr float SM_C = 0.125f * 1.4426950408889634f;
constexpr int LCAP = 4096;

DEVI void moba_select_phase(const Params& p, char* smem) {
    float* km = (float*)smem;
    const int tid = threadIdx.x, wave = tid >> 6, lane = tid & 63;
    for (int w = blockIdx.x; w < 256; w += gridDim.x) {
        const int bh = w >> 1, hf = w & 1;
        __syncthreads();
        for (int i = tid; i < 1024; i += 512) km[i] = p.kmean[(size_t)bh * 1024 + i];
        __syncthreads();
        bf16x8 qv[8];
        { const bf16_t* qrow = p.qb + ((size_t)bh * 4096 + wave * 256 + hf * 128 + (lane & 31)) * 64;
#pragma unroll
          for (int c = 0; c < 8; ++c) qv[c] = *(const bf16x8*)(qrow + c * 8); }
#pragma unroll 1
        for (int ws8 = 0; ws8 < 8; ++ws8) {
            const int qb = (ws8 < 4) ? wave : 15 - wave;
            const int q = qb * 256 + (hf * 4 + (ws8 & 3)) * 32 + (lane & 31);
            bf16x8 qn[8];
            { const int wn = ws8 < 7 ? ws8 + 1 : ws8; const int qbn = (wn < 4) ? wave : 15 - wave;
              const bf16_t* qrow = p.qb + ((size_t)bh * 4096 + qbn * 256 + (hf * 4 + (wn & 3)) * 32 + (lane & 31)) * 64;
#pragma unroll
              for (int c = 0; c < 8; ++c) qn[c] = *(const bf16x8*)(qrow + c * 8); }
            float b0 = -INFINITY, b1 = -INFINITY, b2 = -INFINITY; int i0 = -1, i1 = -1, i2 = -1;
            for (int n = 0; n < qb; ++n) {
                float s = 0.f;
#pragma unroll
                for (int c = 0; c < 8; ++c) {
                    const f32x4 k0 = *(const f32x4*)(km + n * 64 + c * 8), k1 = *(const f32x4*)(km + n * 64 + c * 8 + 4);
                    s += bfs2f(qv[c][0]) * k0[0]; s += bfs2f(qv[c][1]) * k0[1]; s += bfs2f(qv[c][2]) * k0[2]; s += bfs2f(qv[c][3]) * k0[3];
                    s += bfs2f(qv[c][4]) * k1[0]; s += bfs2f(qv[c][5]) * k1[1]; s += bfs2f(qv[c][6]) * k1[2]; s += bfs2f(qv[c][7]) * k1[3];
                }
                if (s > b0) { b2 = b1; i2 = i1; b1 = b0; i1 = i0; b0 = s; i0 = n; }
                else if (s > b1) { b2 = b1; i2 = i1; b1 = s; i1 = n; }
                else if (s > b2) { b2 = s; i2 = n; }
            }
            for (int n = 0; n < qb; ++n) {
                const bool pred = (lane < 32) && (i0 == n || i1 == n || i2 == n);
                const unsigned long long mask = __ballot(pred);
                if (mask == 0ull) continue;
                const int leader = __ffsll((long long)mask) - 1;
                int base = 0;
                if (lane == leader) base = atomicAdd(p.mcnt + bh * 16 + n, __popcll(mask));
                base = __shfl(base, leader);
                if (pred) {
                    const int pos = base + __popcll(mask & ((1ull << lane) - 1ull));
                    const int j = (i0 == n) ? 0 : (i1 == n) ? 1 : 2;
                    __hip_atomic_store(p.mlist + (size_t)(bh * 16 + n) * LCAP + pos, (unsigned short)(q | (j << 12)), __ATOMIC_RELAXED, __HIP_MEMORY_SCOPE_AGENT);
                }
            }
#pragma unroll
            for (int c = 0; c < 8; ++c) qv[c] = qn[c];
        }
    }
}

template <bool MASK>
DEVI void moba_subtile(const bf16_t* Kt  , const bf16_t* Vt  , const int vstr,
                       const bf16x8 (&qf)[2][2], f32x4 (&o)[4][2], float (&mrun)[2], float (&lrun)[2], const int kl0, const int ql0, const int fr, const int fq) {
    f32x4 st[4][2];
#pragma unroll
    for (int kt = 0; kt < 4; ++kt) {
        st[kt][0] = (f32x4){0.f, 0.f, 0.f, 0.f}; st[kt][1] = (f32x4){0.f, 0.f, 0.f, 0.f};
#pragma unroll
        for (int kk = 0; kk < 2; ++kk) {
            const bf16x8 kf = *(const bf16x8*)(Kt + (kt * 16 + fr) * 72 + kk * 32 + fq * 8);
            st[kt][0] = __builtin_amdgcn_mfma_f32_16x16x32_bf16(kf, qf[0][kk], st[kt][0], 0, 0, 0);
            st[kt][1] = __builtin_amdgcn_mfma_f32_16x16x32_bf16(kf, qf[1][kk], st[kt][1], 0, 0, 0);
        }
    }
    bf16x8 pf[2][2];
    float sv[2][4][4], tmax[2], mnew[2], alpha[2], psum[2];
#pragma unroll
    for (int qt = 0; qt < 2; ++qt) {
        const int ql = ql0 + qt * 16 + fr;
        tmax[qt] = -1e30f;
#pragma unroll
        for (int kt = 0; kt < 4; ++kt)
#pragma unroll
            for (int j = 0; j < 4; ++j) {
                float v = st[kt][qt][j];
                if (MASK) { const int kl = kl0 + kt * 16 + fq * 4 + j; v = (kl <= ql) ? v : -1e30f; }
                sv[qt][kt][j] = v; tmax[qt] = fmaxf(tmax[qt], v);
            }
    }
#pragma unroll
    for (int qt = 0; qt < 2; ++qt) tmax[qt] = fmaxf(tmax[qt], sx16(tmax[qt], fq));
#pragma unroll
    for (int qt = 0; qt < 2; ++qt) tmax[qt] = fmaxf(tmax[qt], sx32(tmax[qt], fq));
#pragma unroll
    for (int qt = 0; qt < 2; ++qt) { mnew[qt] = fmaxf(mrun[qt], tmax[qt]); alpha[qt] = __builtin_amdgcn_exp2f(mrun[qt] - mnew[qt]); mrun[qt] = mnew[qt]; psum[qt] = 0.f; }
#pragma unroll
    for (int kt = 0; kt < 4; ++kt)
#pragma unroll
        for (int j = 0; j < 4; ++j)
#pragma unroll
            for (int qt = 0; qt < 2; ++qt) {
                float pv = __builtin_amdgcn_exp2f(sv[qt][kt][j] - mnew[qt]);
                if (MASK) pv = (sv[qt][kt][j] > -1e29f) ? pv : 0.f;
                sv[qt][kt][j] = pv; psum[qt] += pv;
            }
#pragma unroll
    for (int qt = 0; qt < 2; ++qt) psum[qt] += sx16(psum[qt], fq);
#pragma unroll
    for (int qt = 0; qt < 2; ++qt) psum[qt] += sx32(psum[qt], fq);
#pragma unroll
    for (int qt = 0; qt < 2; ++qt) {
        lrun[qt] = lrun[qt] * alpha[qt] + psum[qt];
#pragma unroll
        for (int dt = 0; dt < 4; ++dt) o[dt][qt] *= alpha[qt];
#pragma unroll
        for (int kk2 = 0; kk2 < 2; ++kk2) {
            const uint4 pu = make_uint4(pack2(sv[qt][2 * kk2][0], sv[qt][2 * kk2][1]), pack2(sv[qt][2 * kk2][2], sv[qt][2 * kk2][3]),
                                        pack2(sv[qt][2 * kk2 + 1][0], sv[qt][2 * kk2 + 1][1]), pack2(sv[qt][2 * kk2 + 1][2], sv[qt][2 * kk2 + 1][3]));
            pf[kk2][qt] = *(const bf16x8*)&pu;
        }
    }
#pragma unroll
    for (int dt = 0; dt < 4; ++dt)
#pragma unroll
        for (int kk2 = 0; kk2 < 2; ++kk2) {
            const uint2 lo = *(const uint2*)(Vt + (dt * 16 + fr) * vstr + kk2 * 32 + fq * 4);
            const uint2 hi = *(const uint2*)(Vt + (dt * 16 + fr) * vstr + kk2 * 32 + 16 + fq * 4);
            const uint4 vu = make_uint4(lo.x, lo.y, hi.x, hi.y);
            const bf16x8 vf = *(const bf16x8*)&vu;
            o[dt][0] = __builtin_amdgcn_mfma_f32_16x16x32_bf16(vf, pf[kk2][0], o[dt][0], 0, 0, 0);
            o[dt][1] = __builtin_amdgcn_mfma_f32_16x16x32_bf16(vf, pf[kk2][1], o[dt][1], 0, 0, 0);
        }
}

DEVI void moba_past_item(const Params& p, const int bh, const int n, char* smem) {
    bf16_t* Ks = (bf16_t*)smem;
    bf16_t* Vs = (bf16_t*)(smem + 36864);
    const int tid = threadIdx.x, wave = tid >> 6, lane = tid & 63, fr = lane & 15, fq = lane >> 4;
    const bf16_t* Qg = p.qb + (size_t)bh * 4096 * 64;
    const bf16_t* Kg = p.kb + ((size_t)bh * 4096 + (size_t)n * 256) * 64;
    const bf16_t* Vtg = p.vtb + (size_t)bh * 64 * 4096 + n * 256;
    __syncthreads();
#pragma unroll
    for (int q = 0; q < 4; ++q) {
        const int i = tid + q * 512;
        *(uint4*)(Ks + (i >> 3) * 72 + (i & 7) * 8) = *(const uint4*)(Kg + (size_t)(i >> 3) * 64 + (i & 7) * 8);
        *(uint4*)(Vs + (i >> 5) * 264 + (i & 31) * 8) = *(const uint4*)(Vtg + (size_t)(i >> 5) * 4096 + (i & 31) * 8);
    }
    __syncthreads();
    const int cnt = p.mcnt[bh * 16 + n];
    const unsigned short* lst = p.mlist + (size_t)(bh * 16 + n) * LCAP;
    const int ngroups = (cnt + 31) >> 5;
    int qidx[2], slot[2]; bool valid[2];
    bf16x8 qf[2][2];
#define D2_FETCH(g_) do { _Pragma("unroll") for (int qt = 0; qt < 2; ++qt) { const int idx = (g_) * 32 + qt * 16 + fr; valid[qt] = idx < cnt; \
        const unsigned e = lst[valid[qt] ? idx : 0]; qidx[qt] = e & 4095; slot[qt] = e >> 12; \
        _Pragma("unroll") for (int kk = 0; kk < 2; ++kk) qf[qt][kk] = *(const bf16x8*)(Qg + (size_t)qidx[qt] * 64 + kk * 32 + fq * 8); } } while (0)
    if (wave < ngroups) D2_FETCH(wave);
    for (int g = wave; g < ngroups; g += 8) {
        int cq[2], cs[2]; bool cv[2]; bf16x8 cf[2][2];
#pragma unroll
        for (int qt = 0; qt < 2; ++qt) { cq[qt] = qidx[qt]; cs[qt] = slot[qt]; cv[qt] = valid[qt]; cf[qt][0] = qf[qt][0]; cf[qt][1] = qf[qt][1]; }
        { const int gn = (g + 8 < ngroups) ? g + 8 : g; D2_FETCH(gn); }
        f32x4 o[4][2];
#pragma unroll
        for (int dt = 0; dt < 4; ++dt) { o[dt][0] = (f32x4){0.f, 0.f, 0.f, 0.f}; o[dt][1] = (f32x4){0.f, 0.f, 0.f, 0.f}; }
        float mrun[2] = {-1e30f, -1e30f}, lrun[2] = {0.f, 0.f};
#pragma unroll 1
        for (int jt = 0; jt < 4; ++jt)
            moba_subtile<false>(Ks + jt * 64 * 72, Vs + jt * 64, 264, cf, o, mrun, lrun, 0, 0, fr, fq);
#pragma unroll
        for (int qt = 0; qt < 2; ++qt) {
            if (cv[qt]) {
                const size_t pair = ((size_t)bh * 4096 + cq[qt]) * 3 + cs[qt];
                const float linv = __builtin_amdgcn_rcpf(lrun[qt]);
#pragma unroll
                for (int dt = 0; dt < 4; ++dt) {
                    const f32x4 v = o[dt][qt];
                    *(uint2*)(p.part_o + pair * 64 + dt * 16 + fq * 4) = make_uint2(pack2(v[0] * linv, v[1] * linv), pack2(v[2] * linv, v[3] * linv));
                }
                if (fq == 0) __hip_atomic_store((unsigned long long*)(p.part_ml + pair * 2), ((unsigned long long)__float_as_uint(lrun[qt]) << 32) | (unsigned long long)__float_as_uint(mrun[qt]), __ATOMIC_RELAXED, __HIP_MEMORY_SCOPE_AGENT);
            }
        }
    }
#undef D2_FETCH
}

DEVI void moba_past_phase(const Params& p, char* smem) {
    for (int w = blockIdx.x; w < 256; w += gridDim.x) {
        const int bh = w >> 1, set = w & 1;
#pragma unroll 1
        for (int n = 0; n < 15; ++n) {
            const int inA = (n == 0) | (n == 3) | (n == 4) | (n == 7) | (n == 8) | (n == 11) | (n == 12);
            if (inA == set) continue;
            moba_past_item(p, bh, n, smem);
        }
    }
}

DEVI void moba_own_item(const Params& p, const int bh, const int qb, char* smem) {
    bf16_t* Ks = (bf16_t*)smem;
    bf16_t* Vs = (bf16_t*)(smem + 36864);
    const int tid = threadIdx.x, wave = tid >> 6, lane = tid & 63, fr = lane & 15, fq = lane >> 4;
    const bf16_t* Qg = p.qb + ((size_t)bh * 4096 + (size_t)qb * 256) * 64;
    const bf16_t* Kg = p.kb + ((size_t)bh * 4096 + (size_t)qb * 256) * 64;
    const bf16_t* Vtg = p.vtb + (size_t)bh * 64 * 4096 + qb * 256;
#define OWN_K(q_) (*(const uint4*)(Kg + (size_t)((tid + (q_) * 512) >> 3) * 64 + ((tid + (q_) * 512) & 7) * 8))
#define OWN_V(q_) (*(const uint4*)(Vtg + (size_t)((tid + (q_) * 512) >> 5) * 4096 + ((tid + (q_) * 512) & 31) * 8))
    const uint4 kq0 = OWN_K(0), kq1 = OWN_K(1), kq2 = OWN_K(2), kq3 = OWN_K(3);
    const uint4 vq0 = OWN_V(0), vq1 = OWN_V(1), vq2 = OWN_V(2), vq3 = OWN_V(3);
#undef OWN_K
#undef OWN_V
    bf16x8 qf[2][2];
#pragma unroll
    for (int qt = 0; qt < 2; ++qt)
#pragma unroll
        for (int kk = 0; kk < 2; ++kk) qf[qt][kk] = *(const bf16x8*)(Qg + (size_t)(wave * 32 + qt * 16 + fr) * 64 + kk * 32 + fq * 8);
    f32x4 o[4][2];
#pragma unroll
    for (int dt = 0; dt < 4; ++dt) { o[dt][0] = (f32x4){0.f, 0.f, 0.f, 0.f}; o[dt][1] = (f32x4){0.f, 0.f, 0.f, 0.f}; }
    float mrun[2] = {-1e30f, -1e30f}, lrun[2] = {0.f, 0.f};
    const int hcol = 512 + (bh & 7) * 64;
    const int nsel = qb < 3 ? qb : 3;
    float2 pml[2][3]; uint2 po[2][3][4];
#pragma unroll
    for (int qt = 0; qt < 2; ++qt) {
        const int qs = qb * 256 + wave * 32 + qt * 16 + fr;
#pragma unroll
        for (int j = 0; j < 3; ++j) {
            const size_t pair = ((size_t)bh * 4096 + qs) * 3 + j;
            pml[qt][j] = make_float2(-1e30f, 0.f);
#pragma unroll
            for (int dt = 0; dt < 4; ++dt) po[qt][j][dt] = make_uint2(0u, 0u);
            if (j < nsel) {
                pml[qt][j] = *(const float2*)(p.part_ml + pair * 2);
#pragma unroll
                for (int dt = 0; dt < 4; ++dt) po[qt][j][dt] = *(const uint2*)(p.part_o + pair * 64 + dt * 16 + fq * 4);
            }
        }
    }
    __syncthreads();
#define OWN_KS(q_) (*(uint4*)(Ks + ((tid + (q_) * 512) >> 3) * 72 + ((tid + (q_) * 512) & 7) * 8))
#define OWN_VS(q_) (*(uint4*)(Vs + ((tid + (q_) * 512) >> 5) * 264 + ((tid + (q_) * 512) & 31) * 8))
    OWN_KS(0) = kq0; OWN_KS(1) = kq1; OWN_KS(2) = kq2; OWN_KS(3) = kq3;
    OWN_VS(0) = vq0; OWN_VS(1) = vq1; OWN_VS(2) = vq2; OWN_VS(3) = vq3;
#undef OWN_KS
#undef OWN_VS
    __syncthreads();
#pragma unroll 1
    for (int jt = 0; jt < 4; ++jt) {
        if (jt * 64 + 63 <= wave * 32)        moba_subtile<false>(Ks + jt * 64 * 72, Vs + jt * 64, 264, qf, o, mrun, lrun, 0, 0, fr, fq);
        else if (jt * 64 <= wave * 32 + 31)   moba_subtile<true>(Ks + jt * 64 * 72, Vs + jt * 64, 264, qf, o, mrun, lrun, jt * 64, wave * 32, fr, fq);
    }
#pragma unroll
    for (int qt = 0; qt < 2; ++qt) {
        float m = mrun[qt], l = lrun[qt];
        f32x4 acc[4];
#pragma unroll
        for (int dt = 0; dt < 4; ++dt) acc[dt] = o[dt][qt];
#pragma unroll
        for (int j = 0; j < 3; ++j) {
            const float2 ml = pml[qt][j];
            const float M = fmaxf(m, ml.x);
            const float wo = __builtin_amdgcn_exp2f(m - M), wj = ml.y * __builtin_amdgcn_exp2f(ml.x - M);
#pragma unroll
            for (int dt = 0; dt < 4; ++dt) {
                const uint2 ou = po[qt][j][dt];
                acc[dt][0] = acc[dt][0] * wo + wj * bf2f((bf16_t)(ou.x & 0xffff)); acc[dt][1] = acc[dt][1] * wo + wj * bf2f((bf16_t)(ou.x >> 16));
                acc[dt][2] = acc[dt][2] * wo + wj * bf2f((bf16_t)(ou.y & 0xffff)); acc[dt][3] = acc[dt][3] * wo + wj * bf2f((bf16_t)(ou.y >> 16));
            }
            l = l * wo + wj; m = M;
        }
        const float linv = __builtin_amdgcn_rcpf(l);
        const size_t tok = (size_t)(bh >> 3) * 4096 + qb * 256 + wave * 32 + qt * 16 + fr;
#pragma unroll
        for (int dt = 0; dt < 4; ++dt) {
            const int dh = dt * 16 + fq * 4;
            const uint2 gu = *(const uint2*)(p.gates + tok * 1024 + hcol + dh);
            const float g0 = bf2f((bf16_t)(gu.x & 0xffff)), g1 = bf2f((bf16_t)(gu.x >> 16)), g2 = bf2f((bf16_t)(gu.y & 0xffff)), g3 = bf2f((bf16_t)(gu.y >> 16));
            const float y0 = acc[dt][0] * linv * g0 * sigmoidf_(g0), y1 = acc[dt][1] * linv * g1 * sigmoidf_(g1);
            const float y2 = acc[dt][2] * linv * g2 * sigmoidf_(g2), y3 = acc[dt][3] * linv * g3 * sigmoidf_(g3);
            *(uint2*)(p.ypre + tok * 1024 + hcol + dh) = make_uint2(pack2(y0, y1), pack2(y2, y3));
        }
    }
}

DEVI void moba_own_phase(const Params& p, char* smem) {
    for (int it = blockIdx.x; it < 2048; it += gridDim.x) moba_own_item(p, it >> 4, it & 15, smem);
}

DEVI void lru_item(const Params& p, const int item, char* smem) {
    const int b = item >> 4, n = (item >> 1) & 7, half = item & 1;
    const int tid = threadIdx.x, wave = tid >> 6, lane = tid & 63, fr = lane & 15, fq = lane >> 4;
    bf16_t* xs = (bf16_t*)smem;
    bf16_t* wa = (bf16_t*)(smem + 35840);
    bf16_t* wx = (bf16_t*)(smem + 35840 + 17408);
    float* cw = (float*)(smem + 70656);
    float* agg = cw + 640;
    float* xcw = (float*)(smem + 81408) + wave * (16 * 68);
    bf16_t* gs = (bf16_t*)(smem + 81408 + 8 * 16 * 68 * 4);
    __syncthreads();
    for (int i = tid; i < 64 * 16; i += 512) {
        const int r = i >> 4, c = i & 15;
        *(uint4*)(wa + r * 136 + c * 8) = *(const uint4*)(p.wa_t + ((size_t)(n * 128 + half * 64 + r)) * 128 + c * 8);
        *(uint4*)(wx + r * 136 + c * 8) = *(const uint4*)(p.wx_t + ((size_t)(n * 128 + half * 64 + r)) * 128 + c * 8);
    }
    cw[tid] = p.lru_conv_w[(tid >> 7) * 1024 + n * 128 + (tid & 127)];
    if (tid < 128) cw[512 + tid] = p.lru_conv_b[n * 128 + tid];
    float ba[4], bx[4], lsl[4], hstart[4];
#pragma unroll
    for (int ct = 0; ct < 4; ++ct) {
        const int C = n * 128 + half * 64 + ct * 16 + fr;
        ba[ct] = p.lru_b_a[C]; bx[ct] = p.lru_b_x[C];
        const float lam = p.lru_lambda[C];
        lsl[ct] = -8.0f * (fmaxf(-lam, 0.f) + log1pf(expf(-fabsf(lam))));
        hstart[ct] = 0.f;
    }
    const bf16_t* xbase = p.xb + ((size_t)b * 4096) * 1024 + n * 128;
    const bf16_t* gbase = p.gl + ((size_t)b * 4096) * 1024 + n * 128 + half * 64;
    uint4 xr[5], gr0, gr1;
#define LRU_LOAD(t0_) do { \
        _Pragma("unroll") for (int q = 0; q < 5; ++q) { const int i = tid + q * 512; const int r = i >> 4, c = i & 15; const int t = (t0_) - 3 + r; \
            xr[q] = make_uint4(0, 0, 0, 0); if (i < 131 * 16 && t >= 0) xr[q] = *(const uint4*)(xbase + (size_t)t * 1024 + c * 8); } \
        gr0 = *(const uint4*)(gbase + (size_t)((t0_) + (tid >> 3)) * 1024 + (tid & 7) * 8); \
        gr1 = *(const uint4*)(gbase + (size_t)((t0_) + 64 + (tid >> 3)) * 1024 + (tid & 7) * 8); } while (0)
#define LRU_STORE() do { \
        _Pragma("unroll") for (int q = 0; q < 5; ++q) { const int i = tid + q * 512; const int r = i >> 4, c = i & 15; if (i < 131 * 16) *(uint4*)(xs + r * 136 + c * 8) = xr[q]; } \
        *(uint4*)(gs + (tid >> 3) * 72 + (tid & 7) * 8) = gr0; *(uint4*)(gs + (64 + (tid >> 3)) * 72 + (tid & 7) * 8) = gr1; } while (0)
    LRU_LOAD(0);
    LRU_STORE();
    __syncthreads();
    int par = 0;
    for (int ch = 0; ch < 32; ++ch) {
        const int t0 = ch * 128;
        { const int tn = (ch + 1 < 32) ? t0 + 128 : t0; LRU_LOAD(tn); }
        f32x4 ar[4], ax[4];
#pragma unroll
        for (int ct = 0; ct < 4; ++ct) { ar[ct] = (f32x4){0.f, 0.f, 0.f, 0.f}; ax[ct] = (f32x4){0.f, 0.f, 0.f, 0.f}; }
#pragma unroll
        for (int kk = 0; kk < 4; ++kk) {
            const int c0 = kk * 32 + fq * 8;
            float xcv[8];
            { const f32x4 b0 = *(const f32x4*)(cw + 512 + c0), b1 = *(const f32x4*)(cw + 512 + c0 + 4);
              xcv[0] = b0[0]; xcv[1] = b0[1]; xcv[2] = b0[2]; xcv[3] = b0[3]; xcv[4] = b1[0]; xcv[5] = b1[1]; xcv[6] = b1[2]; xcv[7] = b1[3]; }
#pragma unroll
            for (int tap = 0; tap < 4; ++tap) {
                const bf16x8 xv = *(const bf16x8*)(xs + (wave * 16 + fr + tap) * 136 + c0);
                const f32x4 w0 = *(const f32x4*)(cw + tap * 128 + c0), w1 = *(const f32x4*)(cw + tap * 128 + c0 + 4);
#pragma unroll
                for (int e = 0; e < 4; ++e) { xcv[e] += w0[e] * bfs2f(xv[e]); xcv[4 + e] += w1[e] * bfs2f(xv[4 + e]); }
            }
            if ((kk >> 1) == half) {
                float* d = xcw + fr * 68 + (kk & 1) * 32 + fq * 8;
                *(f32x4*)d = (f32x4){xcv[0], xcv[1], xcv[2], xcv[3]}; *(f32x4*)(d + 4) = (f32x4){xcv[4], xcv[5], xcv[6], xcv[7]};
            }
            const uint4 au = make_uint4(pack2(xcv[0], xcv[1]), pack2(xcv[2], xcv[3]), pack2(xcv[4], xcv[5]), pack2(xcv[6], xcv[7]));
            const bf16x8 af = *(const bf16x8*)&au;
#pragma unroll
            for (int ct = 0; ct < 4; ++ct) {
                const bf16x8 fa = *(const bf16x8*)(wa + (ct * 16 + fr) * 136 + c0);
                const bf16x8 fx = *(const bf16x8*)(wx + (ct * 16 + fr) * 136 + c0);
                ar[ct] = __builtin_amdgcn_mfma_f32_16x16x32_bf16(af, fa, ar[ct], 0, 0, 0);
                ax[ct] = __builtin_amdgcn_mfma_f32_16x16x32_bf16(af, fx, ax[ct], 0, 0, 0);
            }
        }
        float pa[4][4], pb[4][4];
#pragma unroll
        for (int ct = 0; ct < 4; ++ct) {
            float A[4], B[4];
#pragma unroll
            for (int j = 0; j < 4; ++j) {
                const float xc = xcw[(fq * 4 + j) * 68 + ct * 16 + fr];
                const float r = sigmoidf_(ar[ct][j] + ba[ct]);
                const float ig = sigmoidf_(ax[ct][j] + bx[ct]);
                const float av = __expf(lsl[ct] * r);
                const float mult = __builtin_amdgcn_sqrtf(fmaxf(1.0f - av * av, 0.f));
                A[j] = av; B[j] = mult * ig * xc;
            }
#pragma unroll
            for (int j = 1; j < 4; ++j) { B[j] = A[j] * B[j - 1] + B[j]; A[j] = A[j] * A[j - 1]; }
            float EA = 1.f, EB = 0.f, TA = 1.f, TB = 0.f;
#pragma unroll
            for (int g = 0; g < 4; ++g) {
                const float Ag = __shfl(A[3], fr + 16 * g), Bg = __shfl(B[3], fr + 16 * g);
                if (g < fq) { EB = Ag * EB + Bg; EA = Ag * EA; }
                TB = Ag * TB + Bg; TA = Ag * TA;
            }
#pragma unroll
            for (int j = 0; j < 4; ++j) { pa[ct][j] = A[j] * EA; pb[ct][j] = A[j] * EB + B[j]; }
            if (fq == 0) { float* ag = agg + ((par * 8 + wave) * 64 + ct * 16 + fr) * 2; ag[0] = TA; ag[1] = TB; }
        }
        __syncthreads();
#pragma unroll
        for (int ct = 0; ct < 4; ++ct) {
            float h = hstart[ct], hin = 0.f;
#pragma unroll
            for (int w = 0; w < 8; ++w) {
                const float2 ab = *(const float2*)(agg + ((par * 8 + w) * 64 + ct * 16 + fr) * 2);
                if (w == wave) hin = h;
                h = ab.x * h + ab.y;
            }
            hstart[ct] = h;
            const int C = n * 128 + half * 64 + ct * 16 + fr;
#pragma unroll
            for (int j = 0; j < 4; ++j) {
                const int tl = wave * 16 + fq * 4 + j;
                const size_t tok = (size_t)b * 4096 + t0 + tl;
                const float hs = pa[ct][j] * hin + pb[ct][j];
                const float g = bf2f(gs[tl * 72 + ct * 16 + fr]);
                p.ypre[tok * 1024 + C] = f2bf(hs * g * sigmoidf_(g));
            }
        }
        __syncthreads();
        LRU_STORE();
        __syncthreads();
        par ^= 1;
    }
#undef LRU_LOAD
#undef LRU_STORE
}

DEVI void lru_phase(const Params& p, char* smem) {
    for (int it = blockIdx.x; it < 256; it += gridDim.x) { const int pr = (it & 7) + 8 * (it >> 4), hf = (it >> 3) & 1; lru_item(p, pr * 2 + hf, smem); }
}

#define GRID_SYNC_CG() do { asm volatile("s_waitcnt vmcnt(0) lgkmcnt(0)" ::: "memory"); grid.sync(); \
    if (threadIdx.x < 64) { __builtin_amdgcn_fence(__ATOMIC_ACQUIRE, "agent"); asm volatile("s_waitcnt vmcnt(0) lgkmcnt(0)" ::: "memory"); } __syncthreads(); } while (0)
DEVI void grid_barrier(unsigned* bar, const unsigned k, const unsigned xcc, const unsigned nx, const unsigned nxcd) {
    asm volatile("s_waitcnt vmcnt(0) lgkmcnt(0)" ::: "memory");
    __syncthreads();
    if (threadIdx.x == 0) {
        const unsigned old = __hip_atomic_fetch_add(bar + 64 * (17 + xcc), 1u, __ATOMIC_RELAXED, __HIP_MEMORY_SCOPE_AGENT);
        if (old + 1 == k * nx) {
            __builtin_amdgcn_fence(__ATOMIC_RELEASE, "agent");
            asm volatile("s_waitcnt vmcnt(0) lgkmcnt(0)" ::: "memory");
            __hip_atomic_fetch_add(bar, 1u, __ATOMIC_RELAXED, __HIP_MEMORY_SCOPE_AGENT);
        }
        while (__hip_atomic_load(bar, __ATOMIC_RELAXED, __HIP_MEMORY_SCOPE_AGENT) < k * nxcd) __builtin_amdgcn_s_sleep(1);
        __builtin_amdgcn_fence(__ATOMIC_ACQUIRE, "agent");
        asm volatile("s_waitcnt vmcnt(0) lgkmcnt(0)" ::: "memory");
    }
    __syncthreads();
}
#define GRID_SYNC() do { ++bar_k; grid_barrier(p.bar, bar_k, xcc, nx, nxcd); } while (0)
__global__ void __launch_bounds__(512, 2) mega_fwd(Params p) {
    extern __shared__ __attribute__((aligned(16))) char smem[];
    cg::grid_group grid = cg::this_grid();
    unsigned bar_k = 0;
    const unsigned xcc = (unsigned)__builtin_amdgcn_s_getreg((3 << 11) | 20) & 0xFu;
    if (threadIdx.x == 0) {
        __hip_atomic_fetch_add(p.bar + 64 * (1 + xcc), 1u, __ATOMIC_RELAXED, __HIP_MEMORY_SCOPE_AGENT);
        __hip_atomic_fetch_add(p.bar + 64 * 40, 1u, __ATOMIC_RELEASE, __HIP_MEMORY_SCOPE_AGENT);
        while (__hip_atomic_load(p.bar + 64 * 40, __ATOMIC_RELAXED, __HIP_MEMORY_SCOPE_AGENT) < gridDim.x) __builtin_amdgcn_s_sleep(1);
    }
    __syncthreads();
    if (p.bar == nullptr) GRID_SYNC_CG();
    unsigned nx = 0, nxcd = 0;
    for (unsigned j = 0; j < 16; ++j) { const unsigned c = __hip_atomic_load(p.bar + 64 * (1 + j), __ATOMIC_RELAXED, __HIP_MEMORY_SCOPE_AGENT); nxcd += (c != 0u); if (j == xcc) nx = c; }
    phase_a(p, smem);
    GRID_SYNC();
    prenorm_phase(p.x, p.norm_g, p.mod, p.h);
    GRID_SYNC();
    gemm_phase(p.h, p.wt_in0, NTOK, 4096, 1024, smem, Epi1{Epi1P{p.positions, p.kmean, p.gates, p.qa}});
    GRID_SYNC();
    moba_select_phase(p, smem);
    sb_phase(p, smem);
    GRID_SYNC();
    moba_past_phase(p, smem);
    GRID_SYNC();
    moba_own_phase(p, smem);
    GRID_SYNC();
    gemm_phase(p.ypre, p.wt_out0, NTOK, 1024, 1024, smem, EpiResP<false>{p.x, p.kb  , p.mod + 2048});
    GRID_SYNC();
    prenorm_bf_phase(p.kb, p.norm_g + 1024, p.mod + 16 * 3072, p.h);
    GRID_SYNC();
    gemm_phase(p.h, p.wt_in1, NTOK, 2048, 1024, smem, Epi3P{p.xb, p.gl});
    GRID_SYNC();
    lru_phase(p, smem);
    GRID_SYNC();
    gemm_phase(p.ypre, p.wt_out1, NTOK, 1024, 1024, smem, EpiResP<true>{p.kb, p.gates  , p.mod + 16 * 3072 + 2048});
    GRID_SYNC();
    final_norm_bf_phase(p.gates, p.out, p.final_g);
}

extern "C" void kernel_launch(void* const* d_in, const int* in_sizes, int n_in, void* d_out, int out_size, void* d_ws, size_t ws_size, hipStream_t stream) {
    constexpr size_t kDynLds = 147456;
    static int grid_blocks = 0;
    if (!grid_blocks) {
        hipFuncSetAttribute((const void*)mega_fwd, hipFuncAttributeMaxDynamicSharedMemorySize, (int)kDynLds);
        int dev = 0, cus = 0, per_cu = 0;
        hipGetDevice(&dev);
        hipDeviceGetAttribute(&cus, hipDeviceAttributeMultiprocessorCount, dev);
        hipOccupancyMaxActiveBlocksPerMultiprocessor(&per_cu, mega_fwd, 512, kDynLds);
        if (per_cu < 1) per_cu = 1;
        grid_blocks = cus * 1;
    }
    Params p{};
    p.x = (const float*)d_in[0]; p.c = (const float*)d_in[1]; p.positions = (const int*)d_in[2];
    p.norm_g = (const float*)d_in[3]; p.w_mod = (const float*)d_in[4]; p.b_mod = (const float*)d_in[5];
    p.attn_w_in = (const float*)d_in[6]; p.attn_w_out = (const float*)d_in[7]; p.lru_w_in = (const float*)d_in[8];
    p.lru_conv_w = (const float*)d_in[9]; p.lru_conv_b = (const float*)d_in[10]; p.lru_w_a = (const float*)d_in[11];
    p.lru_b_a = (const float*)d_in[12]; p.lru_w_x = (const float*)d_in[13]; p.lru_b_x = (const float*)d_in[14];
    p.lru_lambda = (const float*)d_in[15]; p.lru_w_out = (const float*)d_in[16]; p.final_g = (const float*)d_in[17];
    p.out = (float*)d_out;
    char* w = (char*)d_ws; size_t off = 0;
    auto take = [&](size_t bytes) { char* r = w + off; off += (bytes + 255) & ~(size_t)255; return r; };
    p.wt_in0 = (bf16_t*)take((size_t)4096 * 1024 * 2);
    p.wt_out0 = (bf16_t*)take((size_t)1024 * 1024 * 2);
    p.wt_in1 = (bf16_t*)take((size_t)2048 * 1024 * 2);
    p.wt_out1 = (bf16_t*)take((size_t)1024 * 1024 * 2);
    p.wa_t = (bf16_t*)take((size_t)8 * 128 * 128 * 2);
    p.wx_t = (bf16_t*)take((size_t)8 * 128 * 128 * 2);
    p.mod = (float*)take((size_t)2 * 16 * 3072 * 4);
    p.kmean = (float*)take((size_t)16 * 8 * 16 * 64 * 4);
    p.h = (bf16_t*)take((size_t)NTOK * 1024 * 2);
    const size_t hd = (size_t)16 * 8 * 4096 * 64 * 2;
    p.qa = (bf16_t*)take(hd); p.ka = (bf16_t*)take(hd); p.vta = (bf16_t*)take(hd);
    p.qb = (bf16_t*)take(hd); p.kb = (bf16_t*)take(hd); p.vtb = (bf16_t*)take(hd);
    p.gates = (bf16_t*)take((size_t)NTOK * 1024 * 2);
    p.ypre = (bf16_t*)take((size_t)NTOK * 1024 * 2);
    p.bar = (unsigned*)take(16384);
    p.mcnt = (int*)take((size_t)128 * 16 * 4);
    p.mlist = (unsigned short*)take((size_t)128 * 16 * LCAP * 2);
    p.part_ml = (float*)take((size_t)128 * 4096 * 3 * 2 * 4);
    p.part_o = (bf16_t*)take((size_t)128 * 4096 * 3 * 64 * 2);
    p.xb = p.qa;
    p.gl = p.vta;
    hipMemsetAsync(p.bar, 0, 16384, stream);
    void* args[] = {&p};
    hipError_t e = hipLaunchCooperativeKernel((const void*)mega_fwd, dim3(grid_blocks), dim3(512), args, kDynLds, stream);
    if (e != hipSuccess) fprintf(stderr, "cooperative launch failed: %s (grid %d)\n", hipGetErrorString(e), grid_blocks);
}
```

```cpp
#include <hip/hip_runtime.h>
#include <hip/hip_cooperative_groups.h>
#include <stdint.h>
#include <cstdio>
namespace cg = cooperative_groups;

#define DEVI __device__ __forceinline__
typedef unsigned short bf16_t;
typedef short bf16x8 __attribute__((ext_vector_type(8)));
typedef short bf16x4 __attribute__((ext_vector_type(4)));
typedef float f32x4 __attribute__((ext_vector_type(4)));

constexpr int NB = 16, SEQ = 4096, DM = 1024, NTOK = NB * SEQ;

struct Params {
    const float *x, *c; const int* positions;
    const float *norm_g, *w_mod, *b_mod, *attn_w_in, *attn_w_out, *lru_w_in, *lru_conv_w, *lru_conv_b,
        *lru_w_a, *lru_b_a, *lru_w_x, *lru_b_x, *lru_lambda, *lru_w_out, *final_g;
    float* out;
    bf16_t *wt_in0, *wt_out0, *wt_in1, *wt_out1, *wa_t, *wx_t;
    float *mod, *kmean, *part_ml; unsigned* bar; int* mcnt; unsigned short* mlist; bf16_t* part_o;
    bf16_t *h, *qa, *ka, *vta, *qb, *kb, *vtb, *gates, *ypre, *xb, *gl;
};

DEVI bf16_t f2bf(float f) { unsigned u = __float_as_uint(f); u += 0x7fffu + ((u >> 16) & 1u); return (bf16_t)(u >> 16); }
DEVI float bf2f(bf16_t h) { return __uint_as_float(((unsigned)h) << 16); }
DEVI float bfs2f(short h) { return __uint_as_float(((unsigned)(unsigned short)h) << 16); }
typedef __bf16 bf16x2_t __attribute__((ext_vector_type(2)));
typedef float f32x2_t __attribute__((ext_vector_type(2)));
DEVI unsigned pack2(float a, float b) { const f32x2_t v = {a, b}; const bf16x2_t h = __builtin_convertvector(v, bf16x2_t); return __builtin_bit_cast(unsigned, h); }
DEVI float wave_sum(float v) {
#pragma unroll
    for (int o = 32; o > 0; o >>= 1) v += __shfl_xor(v, o);
    return v;
}
DEVI float sx16(float x, int fq) { const auto r = __builtin_amdgcn_permlane16_swap(__float_as_uint(x), __float_as_uint(x), false, false); return __uint_as_float((fq & 1) ? r[0] : r[1]); }
DEVI float sx32(float x, int fq) { const auto r = __builtin_amdgcn_permlane32_swap(__float_as_uint(x), __float_as_uint(x), false, false); return __uint_as_float((fq & 2) ? r[0] : r[1]); }
typedef unsigned u32x4v __attribute__((ext_vector_type(4)));
typedef float f32x4v __attribute__((ext_vector_type(4)));
DEVI uint4 ld_nt16(const void* p) { const u32x4v w = __builtin_nontemporal_load((const u32x4v*)p); return make_uint4(w[0], w[1], w[2], w[3]); }
DEVI float4 ld_nt16f(const void* p) { const f32x4v w = __builtin_nontemporal_load((const f32x4v*)p); return make_float4(w[0], w[1], w[2], w[3]); }
DEVI void st_nt16f(void* p, const float4 v) { const f32x4v w = {v.x, v.y, v.z, v.w}; __builtin_nontemporal_store(w, (f32x4v*)p); }
DEVI float sigmoidf_(float x) { return __builtin_amdgcn_rcpf(1.0f + __expf(-x)); }

DEVI void transpose_tile(const float* __restrict__ W, bf16_t* Wt, int K, int N, int tile, float* lds) {
    const int tn = N >> 6; const int tk = tile / tn, tnn = tile - tk * tn; const int k0 = tk * 64, n0 = tnn * 64;
    const int tid = threadIdx.x;
#pragma unroll
    for (int i = 0; i < 2; ++i) {
        const int r = (tid >> 4) + i * 32, c4 = tid & 15;
        const float4 v = *(const float4*)(W + (size_t)(k0 + r) * N + n0 + c4 * 4);
        float* d = lds + r * 65 + c4 * 4; d[0] = v.x; d[1] = v.y; d[2] = v.z; d[3] = v.w;
    }
    __syncthreads();
    const int n = tid >> 3, kc = tid & 7;
    unsigned pk[4];
#pragma unroll
    for (int j = 0; j < 4; ++j) pk[j] = pack2(lds[(kc * 8 + 2 * j) * 65 + n], lds[(kc * 8 + 2 * j + 1) * 65 + n]);
    *(uint4*)(Wt + (size_t)(n0 + n) * K + k0 + kc * 8) = make_uint4(pk[0], pk[1], pk[2], pk[3]);
    __syncthreads();
}

DEVI void mod_unit(const Params& p, int unit, float* lds) {
    float* cl = lds;
    float* red = lds + 16384;
    const int tid = threadIdx.x;
    for (int i = tid; i < 4096; i += 512) ((float4*)cl)[i] = ((const float4*)p.c)[i];
    __syncthreads();
    const int l = unit / 96, n0 = (unit % 96) * 32; const int ks = tid >> 5, col = tid & 31;
    float acc[16];
#pragma unroll
    for (int b = 0; b < 16; ++b) acc[b] = 0.f;
    const float* w = p.w_mod + (size_t)l * 1024 * 3072 + n0 + col;
#pragma unroll 8
    for (int k = ks * 64; k < ks * 64 + 64; ++k) {
        const float wv = w[(size_t)k * 3072];
#pragma unroll
        for (int b = 0; b < 16; ++b) acc[b] += cl[b * 1024 + k] * wv;
    }
#pragma unroll
    for (int b = 0; b < 16; ++b) red[(ks * 16 + b) * 32 + col] = acc[b];
    __syncthreads();
    {
        const int b = tid >> 5; float s = 0.f;
#pragma unroll
        for (int k2 = 0; k2 < 16; ++k2) s += red[(k2 * 16 + b) * 32 + col];
        p.mod[(l * 16 + b) * 3072 + n0 + col] = s + p.b_mod[l * 3072 + n0 + col];
    }
    __syncthreads();
}

DEVI void phase_a(const Params& p, char* smem) {
    float* lds = (float*)smem;
    constexpr int U_MOD = 192, T_IN0 = 16 * 64, T_OUT0 = 16 * 16, T_IN1 = 16 * 32, T_OUT1 = 16 * 16, T_G = 8 * 4;
    constexpr int TOTAL = U_MOD + T_IN0 + T_OUT0 + T_IN1 + T_OUT1 + 2 * T_G;
    for (int u = blockIdx.x; u < TOTAL; u += gridDim.x) {
        int v = u;
        if (v < U_MOD) { mod_unit(p, v, lds); continue; } v -= U_MOD;
        if (v < T_IN0) { transpose_tile(p.attn_w_in, p.wt_in0, 1024, 4096, v, lds); continue; } v -= T_IN0;
        if (v < T_OUT0) { transpose_tile(p.attn_w_out, p.wt_out0, 1024, 1024, v, lds); continue; } v -= T_OUT0;
        if (v < T_IN1) { transpose_tile(p.lru_w_in, p.wt_in1, 1024, 2048, v, lds); continue; } v -= T_IN1;
        if (v < T_OUT1) { transpose_tile(p.lru_w_out, p.wt_out1, 1024, 1024, v, lds); continue; } v -= T_OUT1;
        if (v < T_G) { const int blk = v >> 2; transpose_tile(p.lru_w_a + blk * 16384, p.wa_t + blk * 16384, 128, 128, v & 3, lds); continue; } v -= T_G;
        { const int blk = v >> 2; transpose_tile(p.lru_w_x + blk * 16384, p.wx_t + blk * 16384, 128, 128, v & 3, lds); }
    }
    for (int i = blockIdx.x * 512 + threadIdx.x; i < 16 * 8 * 16 * 64; i += gridDim.x * 512) __hip_atomic_store(p.kmean + i, 0.f, __ATOMIC_RELAXED, __HIP_MEMORY_SCOPE_AGENT);
    for (int i = blockIdx.x * 512 + threadIdx.x; i < 128 * 16; i += gridDim.x * 512) __hip_atomic_store(p.mcnt + i, 0, __ATOMIC_RELAXED, __HIP_MEMORY_SCOPE_AGENT);
}

DEVI void prenorm_phase(const float* xin, const float* __restrict__ g, const float* modl, bf16_t* hout) {
    const int wave = threadIdx.x >> 6, lane = threadIdx.x & 63;
    const int stride = gridDim.x * 8;
    int row = blockIdx.x * 8 + wave;
    float4 nx[4];
#pragma unroll
    for (int i = 0; i < 4; ++i) nx[i] = ld_nt16f((const float4*)(xin + (size_t)(row < NTOK ? row : 0) * DM) + lane + 64 * i);
    for (; row < NTOK; row += stride) {
        float4 v[4]; float ss = 0.f;
#pragma unroll
        for (int i = 0; i < 4; ++i) { v[i] = nx[i]; ss += v[i].x * v[i].x + v[i].y * v[i].y + v[i].z * v[i].z + v[i].w * v[i].w; }
        { const int rn = (row + stride < NTOK) ? row + stride : row;
#pragma unroll
          for (int i = 0; i < 4; ++i) nx[i] = ld_nt16f((const float4*)(xin + (size_t)rn * DM) + lane + 64 * i); }
        ss = wave_sum(ss);
        const float rinv = rsqrtf(ss * (1.0f / 1024.0f) + 1e-6f);
        const float* md = modl + (row >> 12) * 3072;
#pragma unroll
        for (int i = 0; i < 4; ++i) {
            const int k = (lane + 64 * i) * 4;
            const float4 gg = *(const float4*)(g + k), sh = *(const float4*)(md + k), sc = *(const float4*)(md + 1024 + k);
            const float o0 = v[i].x * rinv * gg.x * (1.f + sc.x) + sh.x, o1 = v[i].y * rinv * gg.y * (1.f + sc.y) + sh.y;
            const float o2 = v[i].z * rinv * gg.z * (1.f + sc.z) + sh.z, o3 = v[i].w * rinv * gg.w * (1.f + sc.w) + sh.w;
            *(uint2*)(hout + (size_t)row * DM + k) = make_uint2(pack2(o0, o1), pack2(o2, o3));
        }
    }
}

DEVI void bf8_to_f(const uint4 u, float (&f)[8]) {
    f[0] = __uint_as_float(u.x << 16); f[1] = __uint_as_float(u.x & 0xffff0000u); f[2] = __uint_as_float(u.y << 16); f[3] = __uint_as_float(u.y & 0xffff0000u);
    f[4] = __uint_as_float(u.z << 16); f[5] = __uint_as_float(u.z & 0xffff0000u); f[6] = __uint_as_float(u.w << 16); f[7] = __uint_as_float(u.w & 0xffff0000u);
}
DEVI void prenorm_bf_phase(const bf16_t* xin, const float* __restrict__ g, const float* modl, bf16_t* hout) {
    const int wave = threadIdx.x >> 6, lane = threadIdx.x & 63;
    const int stride = gridDim.x * 8;
    int row = blockIdx.x * 8 + wave;
    uint4 nx0 = ld_nt16((const uint4*)(xin + (size_t)(row < NTOK ? row : 0) * DM) + lane), nx1 = ld_nt16((const uint4*)(xin + (size_t)(row < NTOK ? row : 0) * DM) + lane + 64);
    for (; row < NTOK; row += stride) {
        float v[2][8]; float ss = 0.f;
        bf8_to_f(nx0, v[0]); bf8_to_f(nx1, v[1]);
        { const int rn = (row + stride < NTOK) ? row + stride : row;
          nx0 = ld_nt16((const uint4*)(xin + (size_t)rn * DM) + lane); nx1 = ld_nt16((const uint4*)(xin + (size_t)rn * DM) + lane + 64); }
#pragma unroll
        for (int i = 0; i < 2; ++i)
#pragma unroll
            for (int e = 0; e < 8; ++e) ss += v[i][e] * v[i][e];
        ss = wave_sum(ss);
        const float rinv = rsqrtf(ss * (1.0f / 1024.0f) + 1e-6f);
        const float* md = modl + (row >> 12) * 3072;
#pragma unroll
        for (int i = 0; i < 2; ++i) {
            const int k = (lane + 64 * i) * 8;
            float o[8];
#pragma unroll
            for (int h2 = 0; h2 < 2; ++h2) {
                const float4 gg = *(const float4*)(g + k + 4 * h2), sh = *(const float4*)(md + k + 4 * h2), sc = *(const float4*)(md + 1024 + k + 4 * h2);
                o[4 * h2 + 0] = v[i][4 * h2 + 0] * rinv * gg.x * (1.f + sc.x) + sh.x; o[4 * h2 + 1] = v[i][4 * h2 + 1] * rinv * gg.y * (1.f + sc.y) + sh.y;
                o[4 * h2 + 2] = v[i][4 * h2 + 2] * rinv * gg.z * (1.f + sc.z) + sh.z; o[4 * h2 + 3] = v[i][4 * h2 + 3] * rinv * gg.w * (1.f + sc.w) + sh.w;
            }
            *(uint4*)(hout + (size_t)row * DM + k) = make_uint4(pack2(o[0], o[1]), pack2(o[2], o[3]), pack2(o[4], o[5]), pack2(o[6], o[7]));
        }
    }
}
DEVI void final_norm_bf_phase(const bf16_t* xin, float* out, const float* __restrict__ g) {
    const int wave = threadIdx.x >> 6, lane = threadIdx.x & 63;
    const int stride = gridDim.x * 8;
    int row = blockIdx.x * 8 + wave;
    uint4 nx0 = ld_nt16((const uint4*)(xin + (size_t)(row < NTOK ? row : 0) * DM) + lane), nx1 = ld_nt16((const uint4*)(xin + (size_t)(row < NTOK ? row : 0) * DM) + lane + 64);
    for (; row < NTOK; row += stride) {
        float v[2][8]; float ss = 0.f;
        bf8_to_f(nx0, v[0]); bf8_to_f(nx1, v[1]);
        { const int rn = (row + stride < NTOK) ? row + stride : row;
          nx0 = ld_nt16((const uint4*)(xin + (size_t)rn * DM) + lane); nx1 = ld_nt16((const uint4*)(xin + (size_t)rn * DM) + lane + 64); }
#pragma unroll
        for (int i = 0; i < 2; ++i)
#pragma unroll
            for (int e = 0; e < 8; ++e) ss += v[i][e] * v[i][e];
        ss = wave_sum(ss);
        const float rinv = rsqrtf(ss * (1.0f / 1024.0f) + 1e-6f);
#pragma unroll
        for (int i = 0; i < 2; ++i) {
            const int k = (lane + 64 * i) * 8;
#pragma unroll
            for (int h2 = 0; h2 < 2; ++h2) {
                const float4 gg = *(const float4*)(g + k + 4 * h2);
                float4 o; o.x = v[i][4 * h2 + 0] * rinv * gg.x; o.y = v[i][4 * h2 + 1] * rinv * gg.y; o.z = v[i][4 * h2 + 2] * rinv * gg.z; o.w = v[i][4 * h2 + 3] * rinv * gg.w;
                st_nt16f(out + (size_t)row * DM + k + 4 * h2, o);
            }
        }
    }
}

DEVI void final_norm_phase(float* xio, const float* __restrict__ g) {
    const int wave = threadIdx.x >> 6, lane = threadIdx.x & 63;
    for (int row = blockIdx.x * 8 + wave; row < NTOK; row += gridDim.x * 8) {
        float4* xr = (float4*)(xio + (size_t)row * DM);
        float4 v[4]; float ss = 0.f;
#pragma unroll
        for (int i = 0; i < 4; ++i) { v[i] = xr[lane + 64 * i]; ss += v[i].x * v[i].x + v[i].y * v[i].y + v[i].z * v[i].z + v[i].w * v[i].w; }
        ss = wave_sum(ss);
        const float rinv = rsqrtf(ss * (1.0f / 1024.0f) + 1e-6f);
#pragma unroll
        for (int i = 0; i < 4; ++i) {
            const float4 gg = *(const float4*)(g + (lane + 64 * i) * 4);
            float4 o; o.x = v[i].x * rinv * gg.x; o.y = v[i].y * rinv * gg.y; o.z = v[i].z * rinv * gg.z; o.w = v[i].w * rinv * gg.w;
            xr[lane + 64 * i] = o;
        }
    }
}

#define LAS __attribute__((address_space(3)))
constexpr int BM = 256, BK = 64, HALF = 128, HTB = HALF * BK * 2, NXCD = 8, WGM = 8;
DEVI int lds_byte(int r, int c) { const int st = (r >> 4) * 2 + (c >> 5), rr = r & 15, cc = c & 31, ob = rr * 64 + cc * 2; return st * 1024 + (ob ^ (((ob >> 9) & 1) << 5)); }
DEVI void stage_rc(int b, int& R, int& C) { const int st = b / 1024, sb = b % 1024, swz = sb ^ (((sb >> 9) & 1) << 5); R = (st >> 1) * 16 + swz / 64; C = (st & 1) * 32 + (swz % 64) / 2; }
DEVI int perm32(int rho) { const int n = rho >> 4, i = rho & 15; return 8 * (i >> 2) + 4 * n + (i & 3); }
struct Unit { int pm, pn; };
struct StaticOrder {
    int nM, nN, nwg, G, c;
    DEVI void init(int M, int N, int G_, int c_) { nM = M / BM; nN = N / BM; nwg = nM * nN; G = G_; c = c_; }
    DEVI bool next(int i, Unit& u) const {
        const long L = (long)i * G + c; if (L >= nwg) return false;
        int wgid = (int)L; { const int q = nwg / NXCD, r = nwg % NXCD, xcd = wgid % NXCD, off = wgid / NXCD; wgid = (xcd < r ? xcd * (q + 1) : r * (q + 1) + (xcd - r) * q) + off; }
        const int nig = WGM * nN, gid = wgid / nig, fm = gid * WGM, gsz = (nM - fm) < WGM ? (nM - fm) : WGM;
        u.pm = fm + ((wgid % nig) % gsz); u.pn = (wgid % nig) / gsz; return true;
    }
};

template <class Epi>
DEVI void gemm_phase(const bf16_t* gA, const bf16_t* gBt, const int M, const int N, const int K, char* smem, const Epi& E) {
    LAS unsigned char* lds = (LAS unsigned char*)smem;
    StaticOrder S; S.init(M, N, gridDim.x, blockIdx.x);
    int tid = threadIdx.x; asm volatile("" : "+v"(tid));
    const int wid = __builtin_amdgcn_readfirstlane(tid >> 6), lane = tid & 63, wr = wid >> 2, wc = wid & 3, fr = lane & 15, fq = lane >> 4;
    const int nt = K / BK;
    unsigned voffA[2], voffB[2];
#pragma unroll
    for (int i = 0; i < 2; ++i) { int R, C; stage_rc(tid * 16 + i * 8192, R, C); voffA[i] = (unsigned)(R * K + C) * 2u;
        const int Rb = Epi::PERM ? ((R & ~31) + perm32(R & 31)) : R; voffB[i] = (unsigned)(Rb * K + C) * 2u; }
    const size_t kstep = (size_t)(BK * 2);
    const size_t hstep = (size_t)HALF * K * 2;
    const size_t tstep = 2 * hstep;
    const unsigned ldsw = (unsigned)wid * 1024u;
    const int aoff = lds_byte(wr * 64 + fr, fq * 8), boff = lds_byte(wc * 32 + fr, fq * 8);
#define PG8_SA(b, h) (((b) * 2 + (h)) * HTB)
#define PG8_SB(b, h) ((4 + (b) * 2 + (h)) * HTB)
#define PG8_STAGE(bufoff, gbase, voff) do { _Pragma("unroll") for (int _i = 0; _i < 2; ++_i) \
        __builtin_amdgcn_global_load_lds((const __attribute__((address_space(1))) unsigned*)((const char*)(gbase) + (voff)[_i]), (LAS unsigned*)(lds + (bufoff) + ldsw + _i * 8192), 16, 0, 0); } while (0)
#define PG8_LDA(dst, b, h) do { _Pragma("unroll") for (int m = 0; m < 4; ++m) _Pragma("unroll") for (int k = 0; k < 2; ++k) dst[m][k] = *(const LAS bf16x8*)(lds + PG8_SA(b, h) + aoff + m * 2048 + k * 1024); } while (0)
#define PG8_LDB(dst, b, h) do { _Pragma("unroll") for (int n = 0; n < 2; ++n) _Pragma("unroll") for (int k = 0; k < 2; ++k) dst[n][k] = *(const LAS bf16x8*)(lds + PG8_SB(b, h) + boff + n * 2048 + k * 1024); } while (0)
#define PG8_MMA(ai, bj, At, Bt) do { __builtin_amdgcn_s_setprio(1); _Pragma("unroll") for (int m = 0; m < 4; ++m) _Pragma("unroll") for (int n = 0; n < 2; ++n) _Pragma("unroll") for (int k = 0; k < 2; ++k) \
        acc[ai][bj][m][n] = __builtin_amdgcn_mfma_f32_16x16x32_bf16(Bt[n][k], At[m][k], acc[ai][bj][m][n], 0, 0, 0); __builtin_amdgcn_s_setprio(0); } while (0)
#define PG8_WAIT_V(n) asm volatile("s_waitcnt vmcnt(" #n ")" ::: "memory")
#define PG8_WAIT_L(n) asm volatile("s_waitcnt lgkmcnt(" #n ")" ::: "memory")
#define PG8_BAR __builtin_amdgcn_s_barrier()
#define PG8_SCHED __builtin_amdgcn_sched_barrier(0)
    Unit cur, nxt; int ui = 0;
    if (!S.next(0, cur)) return;
    f32x4 acc[2][2][4][2];
#pragma unroll
    for (int a = 0; a < 2; ++a)
#pragma unroll
        for (int b = 0; b < 2; ++b)
#pragma unroll
            for (int m = 0; m < 4; ++m)
#pragma unroll
                for (int n = 0; n < 2; ++n) acc[a][b][m][n] = (f32x4){0.f, 0.f, 0.f, 0.f};
    bf16x8 At[4][2], B0[2][2], B1[2][2];
    const char* cA = (const char*)gA + (size_t)cur.pm * tstep; const char* cB = (const char*)gBt + (size_t)cur.pn * tstep;
    PG8_STAGE(PG8_SB(0, 0), cB, voffB); PG8_STAGE(PG8_SB(0, 1), cB + hstep, voffB); PG8_STAGE(PG8_SA(0, 0), cA, voffA); PG8_STAGE(PG8_SA(0, 1), cA + hstep, voffA);
    if (wr == 1) PG8_BAR;
    PG8_WAIT_V(2); PG8_BAR;
    PG8_STAGE(PG8_SB(1, 0), cB + kstep, voffB); PG8_STAGE(PG8_SA(1, 0), cA + kstep, voffA); PG8_STAGE(PG8_SB(1, 1), cB + hstep + kstep, voffB);
    PG8_WAIT_V(6); PG8_BAR;
    for (;;) {
        const bool has_next = S.next(ui + 1, nxt);
        const char* nA = has_next ? (const char*)gA + (size_t)nxt.pm * tstep : cA; const char* nB = has_next ? (const char*)gBt + (size_t)nxt.pn * tstep : cB;
        for (int t = 0; t < nt; t += 2) {
            const bool last = (t == nt - 2);
            const char* a1 = cA + (size_t)(t + 1) * kstep;
            const char* a2 = last ? nA : cA + (size_t)(t + 2) * kstep; const char* b2 = last ? nB : cB + (size_t)(t + 2) * kstep;
            const char* a3 = a2 + kstep; const char* b3 = b2 + kstep;
            PG8_LDB(B0, 0, 0); PG8_LDB(B1, 0, 1); PG8_SCHED; PG8_LDA(At, 0, 0); PG8_STAGE(PG8_SA(1, 1), a1 + hstep, voffA);
            PG8_WAIT_V(8); PG8_WAIT_L(0); PG8_BAR; PG8_MMA(0, 0, At, B0); PG8_MMA(0, 1, At, B1); PG8_BAR; PG8_SCHED;
            PG8_LDA(At, 0, 1); PG8_STAGE(PG8_SB(0, 0), b2, voffB); PG8_STAGE(PG8_SB(0, 1), b2 + hstep, voffB); PG8_STAGE(PG8_SA(0, 0), a2, voffA);
            PG8_WAIT_V(8); PG8_WAIT_L(0); PG8_BAR; PG8_MMA(1, 0, At, B0); PG8_MMA(1, 1, At, B1); PG8_BAR; PG8_SCHED;
            PG8_LDB(B0, 1, 0); PG8_LDB(B1, 1, 1); PG8_SCHED; PG8_LDA(At, 1, 0); PG8_STAGE(PG8_SA(0, 1), a2 + hstep, voffA);
            PG8_WAIT_V(8); PG8_WAIT_L(0); PG8_BAR; PG8_MMA(0, 0, At, B0); PG8_MMA(0, 1, At, B1); PG8_BAR; PG8_SCHED;
            PG8_LDA(At, 1, 1); PG8_STAGE(PG8_SB(1, 0), b3, voffB); PG8_STAGE(PG8_SB(1, 1), b3 + hstep, voffB); PG8_STAGE(PG8_SA(1, 0), a3, voffA);
            PG8_WAIT_V(8); PG8_WAIT_L(0); PG8_BAR; PG8_MMA(1, 0, At, B0); PG8_MMA(1, 1, At, B1); PG8_BAR; PG8_SCHED;
        }
        if (wr == 0) PG8_BAR;
        E(acc, cur.pm * BM, cur.pn * BM, wr, wc, fr, fq);
        PG8_WAIT_V(0);
        if (!has_next) break;
#pragma unroll
        for (int a = 0; a < 2; ++a)
#pragma unroll
            for (int b = 0; b < 2; ++b)
#pragma unroll
                for (int m = 0; m < 4; ++m)
#pragma unroll
                    for (int n = 0; n < 2; ++n) acc[a][b][m][n] = (f32x4){0.f, 0.f, 0.f, 0.f};
        cur = nxt; cA = nA; cB = nB; ++ui;
        if (wr == 1) PG8_BAR;
    }
    PG8_WAIT_V(0);
    PG8_BAR;
#undef PG8_SA
#undef PG8_SB
#undef PG8_STAGE
#undef PG8_LDA
#undef PG8_LDB
#undef PG8_MMA
}

constexpr size_t HD = (size_t)16 * 8 * 4096 * 64;
struct Epi1P { const int* positions; float* kmean; bf16_t* gates; bf16_t* qkv; };
struct Epi1 {
    static constexpr bool PERM = true;
    Epi1P p;
    DEVI void operator()(f32x4 (&acc)[2][2][4][2], int brow, int bcol, int wr, int wc, int fr, int fq) const {
        const int grp = bcol >> 9, cbase = bcol & 511;
        const int b = brow >> 12, s0 = brow & 4095;
        if ((grp == 3 || grp == 4) && ((wc & 1) == 0)) {
            const float invt[8] = {1.0f, 0.19392274474868576f, 0.03760603093086393f, 0.007292664737217109f,
                                   0.001414213562373095f, 0.0002742481756762073f, 5.318295896944988e-05f, 1.031338537721246e-05f};
#pragma unroll
            for (int ai = 0; ai < 2; ++ai)
#pragma unroll
                for (int m = 0; m < 4; ++m) {
                    const int s = s0 + ai * 128 + wr * 64 + m * 16 + fr;
                    const float pos = (float)p.positions[b * 4096 + s];
#pragma unroll
                    for (int n = 0; n < 2; ++n)
#pragma unroll
                        for (int j = 0; j < 4; ++j) {
                            const float ang = pos * invt[n * 4 + j];
                            const float rvf = __builtin_amdgcn_fractf(ang * 0.15915494309189535f);
                            const float sn = __builtin_amdgcn_sinf(rvf), cs = __builtin_amdgcn_cosf(rvf);
#pragma unroll
                            for (int bj = 0; bj < 2; ++bj) {
                                const float v = acc[ai][bj][m][n][j];
                                const float pr = sx16(v, fq);
                                const float rot = (fq == 0) ? (v * cs - pr * sn) : (v * cs + pr * sn);
                                acc[ai][bj][m][n][j] = (fq < 2) ? rot : v;
                            }
                        }
                }
        }
        if (grp == 4) {
            const int nblk = s0 >> 8;
#pragma unroll
            for (int bj = 0; bj < 2; ++bj)
#pragma unroll
                for (int n = 0; n < 2; ++n)
#pragma unroll
                    for (int j = 0; j < 4; ++j) {
                        float cs = 0.f;
#pragma unroll
                        for (int ai = 0; ai < 2; ++ai)
#pragma unroll
                            for (int m = 0; m < 4; ++m) cs += acc[ai][bj][m][n][j];
                        cs += __shfl_xor(cs, 1); cs += __shfl_xor(cs, 2); cs += __shfl_xor(cs, 4); cs += __shfl_xor(cs, 8);
                        if (fr == 0) {
                            const int colg = cbase + bj * 128 + wc * 32 + fq * 8 + n * 4 + j;
                            atomicAdd(p.kmean + ((size_t)((b * 8 + (colg >> 6)) * 16 + nblk)) * 64 + (colg & 63), cs);
                        }
                    }
        }
        if (grp >= 6) {
#pragma unroll
            for (int ai = 0; ai < 2; ++ai)
#pragma unroll
                for (int m = 0; m < 4; ++m) {
                    const size_t tok = (size_t)brow + ai * 128 + wr * 64 + m * 16 + fr;
#pragma unroll
                    for (int bj = 0; bj < 2; ++bj) {
                        const int gc = (grp - 6) * 512 + cbase + bj * 128 + wc * 32 + fq * 8;
                        const f32x4 v0 = acc[ai][bj][m][0], v1 = acc[ai][bj][m][1];
                        *(uint4*)(p.gates + tok * 1024 + gc) = make_uint4(pack2(v0[0], v0[1]), pack2(v0[2], v0[3]), pack2(v1[0], v1[1]), pack2(v1[2], v1[3]));
                    }
                }
        } else if (grp == 2 || grp == 5) {
            bf16_t* dst = p.qkv + (size_t)grp * HD;
#pragma unroll
            for (int ai = 0; ai < 2; ++ai)
#pragma unroll
                for (int m = 0; m < 4; ++m) {
                    const int s = s0 + ai * 128 + wr * 64 + m * 16 + fr;
#pragma unroll
                    for (int bj = 0; bj < 2; ++bj)
#pragma unroll
                        for (int n = 0; n < 2; ++n) {
                            const int colg = cbase + bj * 128 + wc * 32 + fq * 8 + n * 4;
                            const f32x4 v = acc[ai][bj][m][n];
                            bf16_t* d0 = dst + ((size_t)((b * 8 + (colg >> 6)) * 64 + (colg & 63))) * 4096 + s;
#pragma unroll
                            for (int j = 0; j < 4; ++j) d0[(size_t)j * 4096] = f2bf(v[j]);
                        }
                }
        } else {
            bf16_t* dst = p.qkv + (size_t)grp * HD;
            const float qsc = (grp == 0) ? 0.125f : (grp == 3) ? (0.125f * 1.4426950408889634f) : 1.0f;
#pragma unroll
            for (int ai = 0; ai < 2; ++ai)
#pragma unroll
                for (int m = 0; m < 4; ++m) {
                    const int s = s0 + ai * 128 + wr * 64 + m * 16 + fr;
#pragma unroll
                    for (int bj = 0; bj < 2; ++bj) {
                        const int colg = cbase + bj * 128 + wc * 32 + fq * 8;
                        const f32x4 v0 = acc[ai][bj][m][0], v1 = acc[ai][bj][m][1];
                        *(uint4*)(dst + ((size_t)((b * 8 + (colg >> 6)) * 4096 + s)) * 64 + (colg & 63)) =
                            make_uint4(pack2(v0[0] * qsc, v0[1] * qsc), pack2(v0[2] * qsc, v0[3] * qsc), pack2(v1[0] * qsc, v1[1] * qsc), pack2(v1[2] * qsc, v1[3] * qsc));
                    }
                }
        }
    }
};

struct EpiRes {
    static constexpr bool PERM = false;
    const float* base; float* out; const float* gate;
    DEVI void operator()(f32x4 (&acc)[2][2][4][2], int brow, int bcol, int wr, int wc, int fr, int fq) const {
        const float* gt = gate + (brow >> 12) * 3072;
#pragma unroll
        for (int ai = 0; ai < 2; ++ai)
#pragma unroll
            for (int m = 0; m < 4; ++m) {
                const size_t row = (size_t)brow + ai * 128 + wr * 64 + m * 16 + fr;
#pragma unroll
                for (int bj = 0; bj < 2; ++bj)
#pragma unroll
                    for (int n = 0; n < 2; ++n) {
                        const int col = bcol + bj * 128 + wc * 32 + n * 16 + fq * 4;
                        const float4 bs = *(const float4*)(base + row * DM + col);
                        const float4 g = *(const float4*)(gt + col);
                        const f32x4 v = acc[ai][bj][m][n];
                        float4 o; o.x = bs.x + g.x * v[0]; o.y = bs.y + g.y * v[1]; o.z = bs.z + g.z * v[2]; o.w = bs.w + g.w * v[3];
                        *(float4*)(out + row * DM + col) = o;
                    }
            }
    }
};

template <bool BASE_BF16> struct EpiResP {
    static constexpr bool PERM = true;
    const void* base; bf16_t* outb; const float* gate;
    DEVI void operator()(f32x4 (&acc)[2][2][4][2], int brow, int bcol, int wr, int wc, int fr, int fq) const {
        const float* gt = gate + (brow >> 12) * 3072;
        float4 gv[2][2];
#pragma unroll
        for (int bj = 0; bj < 2; ++bj) { const int c0 = bcol + bj * 128 + wc * 32 + fq * 8; gv[bj][0] = *(const float4*)(gt + c0); gv[bj][1] = *(const float4*)(gt + c0 + 4); }
#pragma unroll
        for (int ai = 0; ai < 2; ++ai)
#pragma unroll
            for (int m = 0; m < 4; ++m) {
                const size_t row = (size_t)brow + ai * 128 + wr * 64 + m * 16 + fr;
#pragma unroll
                for (int bj = 0; bj < 2; ++bj) {
                    const int col = bcol + bj * 128 + wc * 32 + fq * 8;
                    float b[8];
                    if (BASE_BF16) bf8_to_f(*(const uint4*)((const bf16_t*)base + row * DM + col), b);
                    else { const float4 b0 = *(const float4*)((const float*)base + row * DM + col), b1 = *(const float4*)((const float*)base + row * DM + col + 4);
                           b[0] = b0.x; b[1] = b0.y; b[2] = b0.z; b[3] = b0.w; b[4] = b1.x; b[5] = b1.y; b[6] = b1.z; b[7] = b1.w; }
                    const float4 g0 = gv[bj][0], g1 = gv[bj][1];
                    const f32x4 v0 = acc[ai][bj][m][0], v1 = acc[ai][bj][m][1];
                    *(uint4*)(outb + row * DM + col) = make_uint4(pack2(b[0] + g0.x * v0[0], b[1] + g0.y * v0[1]), pack2(b[2] + g0.z * v0[2], b[3] + g0.w * v0[3]),
                                                                   pack2(b[4] + g1.x * v1[0], b[5] + g1.y * v1[1]), pack2(b[6] + g1.z * v1[2], b[7] + g1.w * v1[3]));
                }
            }
    }
};
struct Epi3P {
    static constexpr bool PERM = true;
    bf16_t *xb, *gl;
    DEVI void operator()(f32x4 (&acc)[2][2][4][2], int brow, int bcol, int wr, int wc, int fr, int fq) const {
        bf16_t* dst = (bcol < 1024) ? xb : gl; const int cb = bcol & 1023;
#pragma unroll
        for (int ai = 0; ai < 2; ++ai)
#pragma unroll
            for (int m = 0; m < 4; ++m) {
                const size_t row = (size_t)brow + ai * 128 + wr * 64 + m * 16 + fr;
#pragma unroll
                for (int bj = 0; bj < 2; ++bj) {
                    const int col = cb + bj * 128 + wc * 32 + fq * 8;
                    const f32x4 v0 = acc[ai][bj][m][0], v1 = acc[ai][bj][m][1];
                    *(uint4*)(dst + row * DM + col) = make_uint4(pack2(v0[0], v0[1]), pack2(v0[2], v0[3]), pack2(v1[0], v1[1]), pack2(v1[2], v1[3]));
                }
            }
    }
};

template <bool BASE_BF16> struct EpiResB {   static constexpr bool PERM = false;
    const void* base; bf16_t* outb; const float* gate;
    DEVI void operator()(f32x4 (&acc)[2][2][4][2], int brow, int bcol, int wr, int wc, int fr, int fq) const {
        const float* gt = gate + (brow >> 12) * 3072;
#pragma unroll
        for (int ai = 0; ai < 2; ++ai)
#pragma unroll
            for (int m = 0; m < 4; ++m) {
                const size_t row = (size_t)brow + ai * 128 + wr * 64 + m * 16 + fr;
#pragma unroll
                for (int bj = 0; bj < 2; ++bj)
#pragma unroll
                    for (int n = 0; n < 2; ++n) {
                        const int col = bcol + bj * 128 + wc * 32 + n * 16 + fq * 4;
                        float b0, b1, b2, b3;
                        if (BASE_BF16) { const uint2 u = *(const uint2*)((const bf16_t*)base + row * DM + col);
                            b0 = __uint_as_float(u.x << 16); b1 = __uint_as_float(u.x & 0xffff0000u); b2 = __uint_as_float(u.y << 16); b3 = __uint_as_float(u.y & 0xffff0000u); }
                        else { const float4 bs = *(const float4*)((const float*)base + row * DM + col); b0 = bs.x; b1 = bs.y; b2 = bs.z; b3 = bs.w; }
                        const float4 g = *(const float4*)(gt + col);
                        const f32x4 v = acc[ai][bj][m][n];
                        *(uint2*)(outb + row * DM + col) = make_uint2(pack2(b0 + g.x * v[0], b1 + g.y * v[1]), pack2(b2 + g.z * v[2], b3 + g.w * v[3]));
                    }
            }
    }
};

struct Epi3 {   static constexpr bool PERM = false;
    bf16_t *xb, *gl;
    DEVI void operator()(f32x4 (&acc)[2][2][4][2], int brow, int bcol, int wr, int wc, int fr, int fq) const {
        bf16_t* dst = (bcol < 1024) ? xb : gl; const int cb = bcol & 1023;
#pragma unroll
        for (int ai = 0; ai < 2; ++ai)
#pragma unroll
            for (int m = 0; m < 4; ++m) {
                const size_t row = (size_t)brow + ai * 128 + wr * 64 + m * 16 + fr;
#pragma unroll
                for (int bj = 0; bj < 2; ++bj)
#pragma unroll
                    for (int n = 0; n < 2; ++n) {
                        const int col = cb + bj * 128 + wc * 32 + n * 16 + fq * 4;
                        const f32x4 v = acc[ai][bj][m][n];
                        *(uint2*)(dst + row * DM + col) = make_uint2(pack2(v[0], v[1]), pack2(v[2], v[3]));
                    }
            }
    }
};

constexpr float SB_EXIT = -40.0f;
DEVI void sb_tile(const bf16x8 (&kf)[2][2], const bf16x4 (&vlo)[4], const bf16x4 (&vhi)[4], const bf16x8 (&qf)[2], f32x4 (&o)[4], float& carry, const int k0, const int t, const int fq) {
    f32x4 st[2];
#pragma unroll
    for (int u2 = 0; u2 < 2; ++u2) {
        st[u2] = (f32x4){0.f, 0.f, 0.f, 0.f};
#pragma unroll
        for (int kk = 0; kk < 2; ++kk) st[u2] = __builtin_amdgcn_mfma_f32_16x16x32_bf16(kf[u2][kk], qf[kk], st[u2], 0, 0, 0);
    }
    float w[2][4];
#pragma unroll
    for (int u2 = 1; u2 >= 0; --u2) {
        float z[4], c[4]; bool valid[4];
#pragma unroll
        for (int j = 0; j < 4; ++j) {
            const int key = k0 + 16 * u2 + fq * 4 + j;
            z[j] = st[u2][j]; valid[j] = key < t;
            const float sp = fmaxf(z[j], 0.f) + 0.6931471805599453f * __builtin_amdgcn_logf(1.0f + __builtin_amdgcn_exp2f(-1.4426950408889634f * fabsf(z[j])));
            c[j] = valid[j] ? -sp : 0.f;
        }
        c[2] += c[3]; c[1] += c[2]; c[0] += c[1];
        const float T = c[0];
        const float a = T + sx16(T, fq);
        const float b2 = sx32(a, fq);
        const float above = ((fq & 1) ? 0.f : 1.f) * (a - T) + ((fq & 2) ? 0.f : 1.f) * b2;
        const float base = carry + above;
#pragma unroll
        for (int j = 0; j < 4; ++j) w[u2][j] = valid[j] ? __builtin_amdgcn_exp2f(1.4426950408889634f * (z[j] + base + c[j])) : 0.f;
        carry += a + b2;
    }
    bf16x8 pf;
    { const uint4 pu = make_uint4(pack2(w[0][0], w[0][1]), pack2(w[0][2], w[0][3]), pack2(w[1][0], w[1][1]), pack2(w[1][2], w[1][3])); pf = *(const bf16x8*)&pu; }
#pragma unroll
    for (int dt = 0; dt < 4; ++dt) {
        bf16x8 vf;
        vf[0] = vlo[dt][0]; vf[1] = vlo[dt][1]; vf[2] = vlo[dt][2]; vf[3] = vlo[dt][3];
        vf[4] = vhi[dt][0]; vf[5] = vhi[dt][1]; vf[6] = vhi[dt][2]; vf[7] = vhi[dt][3];
        o[dt] = __builtin_amdgcn_mfma_f32_16x16x32_bf16(vf, pf, o[dt], 0, 0, 0);
    }
}

DEVI void sb_tile2(const bf16x8 (&kf)[2][2], const bf16x4 (&vlo)[4], const bf16x4 (&vhi)[4], const bf16x8 (&qf)[2][2], f32x4 (&o)[4][2], float (&carry)[2], const int k0, const int tq0, const int fr, const int fq, const bool masked) {
    f32x4 st[2][2];
#pragma unroll
    for (int u2 = 0; u2 < 2; ++u2)
#pragma unroll
        for (int qt = 0; qt < 2; ++qt) st[u2][qt] = __builtin_amdgcn_mfma_f32_16x16x32_bf16(kf[u2][0], qf[qt][0], (f32x4){0.f, 0.f, 0.f, 0.f}, 0, 0, 0);
#pragma unroll
    for (int u2 = 0; u2 < 2; ++u2)
#pragma unroll
        for (int qt = 0; qt < 2; ++qt) st[u2][qt] = __builtin_amdgcn_mfma_f32_16x16x32_bf16(kf[u2][1], qf[qt][1], st[u2][qt], 0, 0, 0);
    float c[2][2][4]; bool valid[2][2][4];
#pragma unroll
    for (int u2 = 0; u2 < 2; ++u2)
#pragma unroll
        for (int qt = 0; qt < 2; ++qt)
#pragma unroll
            for (int j = 0; j < 4; ++j) {
                const float z = st[u2][qt][j];
                const float sp = fmaxf(z, 0.f) + 0.6931471805599453f * __builtin_amdgcn_logf(1.0f + __builtin_amdgcn_exp2f(-1.4426950408889634f * fabsf(z)));
                valid[u2][qt][j] = masked ? ((k0 + 16 * u2 + fq * 4 + j) < (tq0 + qt * 16 + fr)) : true;
                c[u2][qt][j] = valid[u2][qt][j] ? -sp : 0.f;
            }
#pragma unroll
    for (int u2 = 0; u2 < 2; ++u2)
#pragma unroll
        for (int qt = 0; qt < 2; ++qt) { c[u2][qt][2] += c[u2][qt][3]; c[u2][qt][1] += c[u2][qt][2]; c[u2][qt][0] += c[u2][qt][1]; }
    float a[2][2], b2[2][2];
#pragma unroll
    for (int u2 = 0; u2 < 2; ++u2)
#pragma unroll
        for (int qt = 0; qt < 2; ++qt) a[u2][qt] = c[u2][qt][0] + sx16(c[u2][qt][0], fq);
#pragma unroll
    for (int u2 = 0; u2 < 2; ++u2)
#pragma unroll
        for (int qt = 0; qt < 2; ++qt) b2[u2][qt] = sx32(a[u2][qt], fq);
    const float m1 = (fq & 1) ? 0.f : 1.f, m2 = (fq & 2) ? 0.f : 1.f;
    float w[2][2][4];
#pragma unroll
    for (int qt = 0; qt < 2; ++qt) {
        const float tot1 = a[1][qt] + b2[1][qt], tot0 = a[0][qt] + b2[0][qt];
        const float base1 = carry[qt] + m1 * (a[1][qt] - c[1][qt][0]) + m2 * b2[1][qt];
        const float base0 = carry[qt] + tot1 + m1 * (a[0][qt] - c[0][qt][0]) + m2 * b2[0][qt];
#pragma unroll
        for (int j = 0; j < 4; ++j) {
            const float e1 = __builtin_amdgcn_exp2f(1.4426950408889634f * (st[1][qt][j] + base1 + c[1][qt][j]));
            const float e0 = __builtin_amdgcn_exp2f(1.4426950408889634f * (st[0][qt][j] + base0 + c[0][qt][j]));
            w[1][qt][j] = valid[1][qt][j] ? e1 : 0.f; w[0][qt][j] = valid[0][qt][j] ? e0 : 0.f;
        }
        carry[qt] += tot1 + tot0;
    }
    bf16x8 pf[2];
#pragma unroll
    for (int qt = 0; qt < 2; ++qt) {
        const uint4 pu = make_uint4(pack2(w[0][qt][0], w[0][qt][1]), pack2(w[0][qt][2], w[0][qt][3]), pack2(w[1][qt][0], w[1][qt][1]), pack2(w[1][qt][2], w[1][qt][3]));
        pf[qt] = *(const bf16x8*)&pu;
    }
#pragma unroll
    for (int dt = 0; dt < 4; ++dt) {
        bf16x8 vf;
        vf[0] = vlo[dt][0]; vf[1] = vlo[dt][1]; vf[2] = vlo[dt][2]; vf[3] = vlo[dt][3];
        vf[4] = vhi[dt][0]; vf[5] = vhi[dt][1]; vf[6] = vhi[dt][2]; vf[7] = vhi[dt][3];
        o[dt][0] = __builtin_amdgcn_mfma_f32_16x16x32_bf16(vf, pf[0], o[dt][0], 0, 0, 0);
        o[dt][1] = __builtin_amdgcn_mfma_f32_16x16x32_bf16(vf, pf[1], o[dt][1], 0, 0, 0);
    }
}

DEVI void sb_phase(const Params& p, char* smem) {
    bf16_t* Ks = (bf16_t*)smem;
    bf16_t* Vs = (bf16_t*)(smem + 55296);
    const int tid = threadIdx.x, wave = tid >> 6, lane = tid & 63, fr = lane & 15, fq = lane >> 4;
    uint4 kq0, kq1, kq2, kq3, kq4, kq5, vq0, vq1, vq2, vq3, vq4, vq5;
#define SB_KG(q_) ((kb_ + ((tid + (q_) * 512) >> 3)) >= 0 ? *(const uint4*)(Kp_ + (size_t)(kb_ + ((tid + (q_) * 512) >> 3)) * 64 + ((tid + (q_) * 512) & 7) * 8) : make_uint4(0, 0, 0, 0))
#define SB_VG(q_) ((kb_ + ((tid + (q_) * 512) % 48) * 8) >= 0 ? *(const uint4*)(Vt_ + (size_t)((tid + (q_) * 512) / 48) * 4096 + kb_ + ((tid + (q_) * 512) % 48) * 8) : make_uint4(0, 0, 0, 0))
#define SB_LOAD(u_) do { const int bh_ = (u_) >> 4, kb_ = ((u_) & 15) * 256 - 128; \
        const bf16_t* Kp_ = p.ka + (size_t)bh_ * 4096 * 64; const bf16_t* Vt_ = p.vta + (size_t)bh_ * 64 * 4096; \
        kq0 = SB_KG(0); kq1 = SB_KG(1); kq2 = SB_KG(2); kq3 = SB_KG(3); kq4 = SB_KG(4); kq5 = SB_KG(5); \
        vq0 = SB_VG(0); vq1 = SB_VG(1); vq2 = SB_VG(2); vq3 = SB_VG(3); vq4 = SB_VG(4); vq5 = SB_VG(5); } while (0)
#define SB_KS(q_) (*(uint4*)(Ks + ((tid + (q_) * 512) >> 3) * 72 + ((tid + (q_) * 512) & 7) * 8))
#define SB_VS(q_) (*(uint4*)(Vs + ((tid + (q_) * 512) / 48) * 392 + ((tid + (q_) * 512) % 48) * 8))
    int u = blockIdx.x;
    { const int u0 = u < 2048 ? u : 0; SB_LOAD(u0); }
    for (; u < 2048; u += gridDim.x) {
        const int bh = u >> 4, t0 = (u & 15) * 256, kbase = t0 - 128;
        __syncthreads();
        SB_KS(0) = kq0; SB_KS(1) = kq1; SB_KS(2) = kq2; SB_KS(3) = kq3; SB_KS(4) = kq4; SB_KS(5) = kq5;
        SB_VS(0) = vq0; SB_VS(1) = vq1; SB_VS(2) = vq2; SB_VS(3) = vq3; SB_VS(4) = vq4; SB_VS(5) = vq5;
        __syncthreads();
        { const int un = (u + (int)gridDim.x < 2048) ? u + (int)gridDim.x : u; SB_LOAD(un); }
        const int q0 = t0 + wave * 32;
        const bf16_t* Q = p.qa + (size_t)bh * 4096 * 64;
        bf16x8 qf[2][2];
#pragma unroll
        for (int qt = 0; qt < 2; ++qt)
#pragma unroll
            for (int kk = 0; kk < 2; ++kk) qf[qt][kk] = *(const bf16x8*)(Q + (size_t)(q0 + qt * 16 + fr) * 64 + kk * 32 + fq * 8);
        f32x4 o[4][2];
#pragma unroll
        for (int dt = 0; dt < 4; ++dt) { o[dt][0] = (f32x4){0.f, 0.f, 0.f, 0.f}; o[dt][1] = (f32x4){0.f, 0.f, 0.f, 0.f}; }
        float carry[2] = {0.f, 0.f};
        const int lo = kbase > 0 ? kbase : 0;
        bool done = false;
        for (int k0 = q0; k0 >= lo; k0 -= 32) {
            const int kl = k0 - kbase;
            bf16x8 kf[2][2]; bf16x4 vlo[4], vhi[4];
#pragma unroll
            for (int u2 = 0; u2 < 2; ++u2)
#pragma unroll
                for (int kk = 0; kk < 2; ++kk) kf[u2][kk] = *(const bf16x8*)(Ks + (kl + 16 * u2 + fr) * 72 + kk * 32 + fq * 8);
#pragma unroll
            for (int dt = 0; dt < 4; ++dt) {
                vlo[dt] = *(const bf16x4*)(Vs + (dt * 16 + fr) * 392 + kl + fq * 4);
                vhi[dt] = *(const bf16x4*)(Vs + (dt * 16 + fr) * 392 + kl + 16 + fq * 4);
            }
            sb_tile2(kf, vlo, vhi, qf, o, carry, k0, q0, fr, fq, k0 == q0);
            if (__all(carry[0] < SB_EXIT && carry[1] < SB_EXIT)) { done = true; break; }
        }
        if (!done && lo > 0) {
            const bf16_t* Kp = p.ka + (size_t)bh * 4096 * 64;
            const bf16_t* Vt = p.vta + (size_t)bh * 64 * 4096;
            for (int k0 = lo - 32; k0 >= 0; k0 -= 32) {
                bf16x8 kf[2][2]; bf16x4 vlo[4], vhi[4];
#pragma unroll
                for (int u2 = 0; u2 < 2; ++u2)
#pragma unroll
                    for (int kk = 0; kk < 2; ++kk) kf[u2][kk] = *(const bf16x8*)(Kp + (size_t)(k0 + 16 * u2 + fr) * 64 + kk * 32 + fq * 8);
#pragma unroll
                for (int dt = 0; dt < 4; ++dt) {
                    vlo[dt] = *(const bf16x4*)(Vt + (size_t)(dt * 16 + fr) * 4096 + k0 + fq * 4);
                    vhi[dt] = *(const bf16x4*)(Vt + (size_t)(dt * 16 + fr) * 4096 + k0 + 16 + fq * 4);
                }
                sb_tile2(kf, vlo, vhi, qf, o, carry, k0, q0, fr, fq, false);
                if (__all(carry[0] < SB_EXIT && carry[1] < SB_EXIT)) break;
            }
        }
        const int hcol = (bh & 7) * 64;
#pragma unroll
        for (int qt = 0; qt < 2; ++qt) {
            const size_t tok = (size_t)(bh >> 3) * 4096 + q0 + qt * 16 + fr;
#pragma unroll
            for (int dt = 0; dt < 4; ++dt) {
                const int dh = dt * 16 + fq * 4;
                const uint2 gu = *(const uint2*)(p.gates + tok * 1024 + hcol + dh);
                const float g0 = bf2f((bf16_t)(gu.x & 0xffff)), g1 = bf2f((bf16_t)(gu.x >> 16)), g2 = bf2f((bf16_t)(gu.y & 0xffff)), g3 = bf2f((bf16_t)(gu.y >> 16));
                const float y0 = o[dt][qt][0] * g0 * sigmoidf_(g0), y1 = o[dt][qt][1] * g1 * sigmoidf_(g1), y2 = o[dt][qt][2] * g2 * sigmoidf_(g2), y3 = o[dt][qt][3] * g3 * sigmoidf_(g3);
                *(uint2*)(p.ypre + tok * 1024 + hcol + dh) = make_uint2(pack2(y0, y1), pack2(y2, y3));
            }
        }
    }
#undef SB_LOAD
#undef SB_KG
#undef SB_VG
#undef SB_KS
#undef SB_VS
}

constexpr float SM_C = 0.125f * 1.4426950408889634f;
constexpr int LCAP = 4096;

DEVI void moba_select_phase(const Params& p, char* smem) {
    float* km = (float*)smem;
    const int tid = threadIdx.x, wave = tid >> 6, lane = tid & 63;
    for (int w = blockIdx.x; w < 256; w += gridDim.x) {
        const int bh = w >> 1, hf = w & 1;
        __syncthreads();
        for (int i = tid; i < 1024; i += 512) km[i] = p.kmean[(size_t)bh * 1024 + i];
        __syncthreads();
        bf16x8 qv[8];
        { const bf16_t* qrow = p.qb + ((size_t)bh * 4096 + wave * 256 + hf * 128 + (lane & 31)) * 64;
#pragma unroll
          for (int c = 0; c < 8; ++c) qv[c] = *(const bf16x8*)(qrow + c * 8); }
#pragma unroll 1
        for (int ws8 = 0; ws8 < 8; ++ws8) {
            const int qb = (ws8 < 4) ? wave : 15 - wave;
            const int q = qb * 256 + (hf * 4 + (ws8 & 3)) * 32 + (lane & 31);
            bf16x8 qn[8];
            { const int wn = ws8 < 7 ? ws8 + 1 : ws8; const int qbn = (wn < 4) ? wave : 15 - wave;
              const bf16_t* qrow = p.qb + ((size_t)bh * 4096 + qbn * 256 + (hf * 4 + (wn & 3)) * 32 + (lane & 31)) * 64;
#pragma unroll
              for (int c = 0; c < 8; ++c) qn[c] = *(const bf16x8*)(qrow + c * 8); }
            float b0 = -INFINITY, b1 = -INFINITY, b2 = -INFINITY; int i0 = -1, i1 = -1, i2 = -1;
            for (int n = 0; n < qb; ++n) {
                float s = 0.f;
#pragma unroll
                for (int c = 0; c < 8; ++c) {
                    const f32x4 k0 = *(const f32x4*)(km + n * 64 + c * 8), k1 = *(const f32x4*)(km + n * 64 + c * 8 + 4);
                    s += bfs2f(qv[c][0]) * k0[0]; s += bfs2f(qv[c][1]) * k0[1]; s += bfs2f(qv[c][2]) * k0[2]; s += bfs2f(qv[c][3]) * k0[3];
                    s += bfs2f(qv[c][4]) * k1[0]; s += bfs2f(qv[c][5]) * k1[1]; s += bfs2f(qv[c][6]) * k1[2]; s += bfs2f(qv[c][7]) * k1[3];
                }
                if (s > b0) { b2 = b1; i2 = i1; b1 = b0; i1 = i0; b0 = s; i0 = n; }
                else if (s > b1) { b2 = b1; i2 = i1; b1 = s; i1 = n; }
                else if (s > b2) { b2 = s; i2 = n; }
            }
            for (int n = 0; n < qb; ++n) {
                const bool pred = (lane < 32) && (i0 == n || i1 == n || i2 == n);
                const unsigned long long mask = __ballot(pred);
                if (mask == 0ull) continue;
                const int leader = __ffsll((long long)mask) - 1;
                int base = 0;
                if (lane == leader) base = atomicAdd(p.mcnt + bh * 16 + n, __popcll(mask));
                base = __shfl(base, leader);
                if (pred) {
                    const int pos = base + __popcll(mask & ((1ull << lane) - 1ull));
                    const int j = (i0 == n) ? 0 : (i1 == n) ? 1 : 2;
                    __hip_atomic_store(p.mlist + (size_t)(bh * 16 + n) * LCAP + pos, (unsigned short)(q | (j << 12)), __ATOMIC_RELAXED, __HIP_MEMORY_SCOPE_AGENT);
                }
            }
#pragma unroll
            for (int c = 0; c < 8; ++c) qv[c] = qn[c];
        }
    }
}

template <bool MASK>
DEVI void moba_subtile(const bf16_t* Kt  , const bf16_t* Vt  , const int vstr,
                       const bf16x8 (&qf)[2][2], f32x4 (&o)[4][2], float (&mrun)[2], float (&lrun)[2], const int kl0, const int ql0, const int fr, const int fq) {
    f32x4 st[4][2];
#pragma unroll
    for (int kt = 0; kt < 4; ++kt) {
        st[kt][0] = (f32x4){0.f, 0.f, 0.f, 0.f}; st[kt][1] = (f32x4){0.f, 0.f, 0.f, 0.f};
#pragma unroll
        for (int kk = 0; kk < 2; ++kk) {
            const bf16x8 kf = *(const bf16x8*)(Kt + (kt * 16 + fr) * 72 + kk * 32 + fq * 8);
            st[kt][0] = __builtin_amdgcn_mfma_f32_16x16x32_bf16(kf, qf[0][kk], st[kt][0], 0, 0, 0);
            st[kt][1] = __builtin_amdgcn_mfma_f32_16x16x32_bf16(kf, qf[1][kk], st[kt][1], 0, 0, 0);
        }
    }
    bf16x8 pf[2][2];
    float sv[2][4][4], tmax[2], mnew[2], alpha[2], psum[2];
#pragma unroll
    for (int qt = 0; qt < 2; ++qt) {
        const int ql = ql0 + qt * 16 + fr;
        tmax[qt] = -1e30f;
#pragma unroll
        for (int kt = 0; kt < 4; ++kt)
#pragma unroll
            for (int j = 0; j < 4; ++j) {
                float v = st[kt][qt][j];
                if (MASK) { const int kl = kl0 + kt * 16 + fq * 4 + j; v = (kl <= ql) ? v : -1e30f; }
                sv[qt][kt][j] = v; tmax[qt] = fmaxf(tmax[qt], v);
            }
    }
#pragma unroll
    for (int qt = 0; qt < 2; ++qt) tmax[qt] = fmaxf(tmax[qt], sx16(tmax[qt], fq));
#pragma unroll
    for (int qt = 0; qt < 2; ++qt) tmax[qt] = fmaxf(tmax[qt], sx32(tmax[qt], fq));
#pragma unroll
    for (int qt = 0; qt < 2; ++qt) { mnew[qt] = fmaxf(mrun[qt], tmax[qt]); alpha[qt] = __builtin_amdgcn_exp2f(mrun[qt] - mnew[qt]); mrun[qt] = mnew[qt]; psum[qt] = 0.f; }
#pragma unroll
    for (int kt = 0; kt < 4; ++kt)
#pragma unroll
        for (int j = 0; j < 4; ++j)
#pragma unroll
            for (int qt = 0; qt < 2; ++qt) {
                float pv = __builtin_amdgcn_exp2f(sv[qt][kt][j] - mnew[qt]);
                if (MASK) pv = (sv[qt][kt][j] > -1e29f) ? pv : 0.f;
                sv[qt][kt][j] = pv; psum[qt] += pv;
            }
#pragma unroll
    for (int qt = 0; qt < 2; ++qt) psum[qt] += sx16(psum[qt], fq);
#pragma unroll
    for (int qt = 0; qt < 2; ++qt) psum[qt] += sx32(psum[qt], fq);
#pragma unroll
    for (int qt = 0; qt < 2; ++qt) {
        lrun[qt] = lrun[qt] * alpha[qt] + psum[qt];
#pragma unroll
        for (int dt = 0; dt < 4; ++dt) o[dt][qt] *= alpha[qt];
#pragma unroll
        for (int kk2 = 0; kk2 < 2; ++kk2) {
            const uint4 pu = make_uint4(pack2(sv[qt][2 * kk2][0], sv[qt][2 * kk2][1]), pack2(sv[qt][2 * kk2][2], sv[qt][2 * kk2][3]),
                                        pack2(sv[qt][2 * kk2 + 1][0], sv[qt][2 * kk2 + 1][1]), pack2(sv[qt][2 * kk2 + 1][2], sv[qt][2 * kk2 + 1][3]));
            pf[kk2][qt] = *(const bf16x8*)&pu;
        }
    }
#pragma unroll
    for (int dt = 0; dt < 4; ++dt)
#pragma unroll
        for (int kk2 = 0; kk2 < 2; ++kk2) {
            const uint2 lo = *(const uint2*)(Vt + (dt * 16 + fr) * vstr + kk2 * 32 + fq * 4);
            const uint2 hi = *(const uint2*)(Vt + (dt * 16 + fr) * vstr + kk2 * 32 + 16 + fq * 4);
            const uint4 vu = make_uint4(lo.x, lo.y, hi.x, hi.y);
            const bf16x8 vf = *(const bf16x8*)&vu;
            o[dt][0] = __builtin_amdgcn_mfma_f32_16x16x32_bf16(vf, pf[kk2][0], o[dt][0], 0, 0, 0);
            o[dt][1] = __builtin_amdgcn_mfma_f32_16x16x32_bf16(vf, pf[kk2][1], o[dt][1], 0, 0, 0);
        }
}

DEVI void moba_past_item(const Params& p, const int bh, const int n, char* smem) {
    bf16_t* Ks = (bf16_t*)smem;
    bf16_t* Vs = (bf16_t*)(smem + 36864);
    const int tid = threadIdx.x, wave = tid >> 6, lane = tid & 63, fr = lane & 15, fq = lane >> 4;
    const bf16_t* Qg = p.qb + (size_t)bh * 4096 * 64;
    const bf16_t* Kg = p.kb + ((size_t)bh * 4096 + (size_t)n * 256) * 64;
    const bf16_t* Vtg = p.vtb + (size_t)bh * 64 * 4096 + n * 256;
    __syncthreads();
#pragma unroll
    for (int q = 0; q < 4; ++q) {
        const int i = tid + q * 512;
        *(uint4*)(Ks + (i >> 3) * 72 + (i & 7) * 8) = *(const uint4*)(Kg + (size_t)(i >> 3) * 64 + (i & 7) * 8);
        *(uint4*)(Vs + (i >> 5) * 264 + (i & 31) * 8) = *(const uint4*)(Vtg + (size_t)(i >> 5) * 4096 + (i & 31) * 8);
    }
    __syncthreads();
    const int cnt = p.mcnt[bh * 16 + n];
    const unsigned short* lst = p.mlist + (size_t)(bh * 16 + n) * LCAP;
    const int ngroups = (cnt + 31) >> 5;
    int qidx[2], slot[2]; bool valid[2];
    bf16x8 qf[2][2];
#define D2_FETCH(g_) do { _Pragma("unroll") for (int qt = 0; qt < 2; ++qt) { const int idx = (g_) * 32 + qt * 16 + fr; valid[qt] = idx < cnt; \
        const unsigned e = lst[valid[qt] ? idx : 0]; qidx[qt] = e & 4095; slot[qt] = e >> 12; \
        _Pragma("unroll") for (int kk = 0; kk < 2; ++kk) qf[qt][kk] = *(const bf16x8*)(Qg + (size_t)qidx[qt] * 64 + kk * 32 + fq * 8); } } while (0)
    if (wave < ngroups) D2_FETCH(wave);
    for (int g = wave; g < ngroups; g += 8) {
        int cq[2], cs[2]; bool cv[2]; bf16x8 cf[2][2];
#pragma unroll
        for (int qt = 0; qt < 2; ++qt) { cq[qt] = qidx[qt]; cs[qt] = slot[qt]; cv[qt] = valid[qt]; cf[qt][0] = qf[qt][0]; cf[qt][1] = qf[qt][1]; }
        { const int gn = (g + 8 < ngroups) ? g + 8 : g; D2_FETCH(gn); }
        f32x4 o[4][2];
#pragma unroll
        for (int dt = 0; dt < 4; ++dt) { o[dt][0] = (f32x4){0.f, 0.f, 0.f, 0.f}; o[dt][1] = (f32x4){0.f, 0.f, 0.f, 0.f}; }
        float mrun[2] = {-1e30f, -1e30f}, lrun[2] = {0.f, 0.f};
#pragma unroll 1
        for (int jt = 0; jt < 4; ++jt)
            moba_subtile<false>(Ks + jt * 64 * 72, Vs + jt * 64, 264, cf, o, mrun, lrun, 0, 0, fr, fq);
#pragma unroll
        for (int qt = 0; qt < 2; ++qt) {
            if (cv[qt]) {
                const size_t pair = ((size_t)bh * 4096 + cq[qt]) * 3 + cs[qt];
                const float linv = __builtin_amdgcn_rcpf(lrun[qt]);
#pragma unroll
                for (int dt = 0; dt < 4; ++dt) {
                    const f32x4 v = o[dt][qt];
                    *(uint2*)(p.part_o + pair * 64 + dt * 16 + fq * 4) = make_uint2(pack2(v[0] * linv, v[1] * linv), pack2(v[2] * linv, v[3] * linv));
                }
                if (fq == 0) __hip_atomic_store((unsigned long long*)(p.part_ml + pair * 2), ((unsigned long long)__float_as_uint(lrun[qt]) << 32) | (unsigned long long)__float_as_uint(mrun[qt]), __ATOMIC_RELAXED, __HIP_MEMORY_SCOPE_AGENT);
            }
        }
    }
#undef D2_FETCH
}

DEVI void moba_past_phase(const Params& p, char* smem) {
    for (int w = blockIdx.x; w < 256; w += gridDim.x) {
        const int bh = w >> 1, set = w & 1;
#pragma unroll 1
        for (int n = 0; n < 15; ++n) {
            const int inA = (n == 0) | (n == 3) | (n == 4) | (n == 7) | (n == 8) | (n == 11) | (n == 12);
            if (inA == set) continue;
            moba_past_item(p, bh, n, smem);
        }
    }
}

DEVI void moba_own_item(const Params& p, const int bh, const int qb, char* smem) {
    bf16_t* Ks = (bf16_t*)smem;
    bf16_t* Vs = (bf16_t*)(smem + 36864);
    const int tid = threadIdx.x, wave = tid >> 6, lane = tid & 63, fr = lane & 15, fq = lane >> 4;
    const bf16_t* Qg = p.qb + ((size_t)bh * 4096 + (size_t)qb * 256) * 64;
    const bf16_t* Kg = p.kb + ((size_t)bh * 4096 + (size_t)qb * 256) * 64;
    const bf16_t* Vtg = p.vtb + (size_t)bh * 64 * 4096 + qb * 256;
#define OWN_K(q_) (*(const uint4*)(Kg + (size_t)((tid + (q_) * 512) >> 3) * 64 + ((tid + (q_) * 512) & 7) * 8))
#define OWN_V(q_) (*(const uint4*)(Vtg + (size_t)((tid + (q_) * 512) >> 5) * 4096 + ((tid + (q_) * 512) & 31) * 8))
    const uint4 kq0 = OWN_K(0), kq1 = OWN_K(1), kq2 = OWN_K(2), kq3 = OWN_K(3);
    const uint4 vq0 = OWN_V(0), vq1 = OWN_V(1), vq2 = OWN_V(2), vq3 = OWN_V(3);
#undef OWN_K
#undef OWN_V
    bf16x8 qf[2][2];
#pragma unroll
    for (int qt = 0; qt < 2; ++qt)
#pragma unroll
        for (int kk = 0; kk < 2; ++kk) qf[qt][kk] = *(const bf16x8*)(Qg + (size_t)(wave * 32 + qt * 16 + fr) * 64 + kk * 32 + fq * 8);
    f32x4 o[4][2];
#pragma unroll
    for (int dt = 0; dt < 4; ++dt) { o[dt][0] = (f32x4){0.f, 0.f, 0.f, 0.f}; o[dt][1] = (f32x4){0.f, 0.f, 0.f, 0.f}; }
    float mrun[2] = {-1e30f, -1e30f}, lrun[2] = {0.f, 0.f};
    const int hcol = 512 + (bh & 7) * 64;
    const int nsel = qb < 3 ? qb : 3;
    float2 pml[2][3]; uint2 po[2][3][4];
#pragma unroll
    for (int qt = 0; qt < 2; ++qt) {
        const int qs = qb * 256 + wave * 32 + qt * 16 + fr;
#pragma unroll
        for (int j = 0; j < 3; ++j) {
            const size_t pair = ((size_t)bh * 4096 + qs) * 3 + j;
            pml[qt][j] = make_float2(-1e30f, 0.f);
#pragma unroll
            for (int dt = 0; dt < 4; ++dt) po[qt][j][dt] = make_uint2(0u, 0u);
            if (j < nsel) {
                pml[qt][j] = *(const float2*)(p.part_ml + pair * 2);
#pragma unroll
                for (int dt = 0; dt < 4; ++dt) po[qt][j][dt] = *(const uint2*)(p.part_o + pair * 64 + dt * 16 + fq * 4);
            }
        }
    }
    __syncthreads();
#define OWN_KS(q_) (*(uint4*)(Ks + ((tid + (q_) * 512) >> 3) * 72 + ((tid + (q_) * 512) & 7) * 8))
#define OWN_VS(q_) (*(uint4*)(Vs + ((tid + (q_) * 512) >> 5) * 264 + ((tid + (q_) * 512) & 31) * 8))
    OWN_KS(0) = kq0; OWN_KS(1) = kq1; OWN_KS(2) = kq2; OWN_KS(3) = kq3;
    OWN_VS(0) = vq0; OWN_VS(1) = vq1; OWN_VS(2) = vq2; OWN_VS(3) = vq3;
#undef OWN_KS
#undef OWN_VS
    __syncthreads();
#pragma unroll 1
    for (int jt = 0; jt < 4; ++jt) {
        if (jt * 64 + 63 <= wave * 32)        moba_subtile<false>(Ks + jt * 64 * 72, Vs + jt * 64, 264, qf, o, mrun, lrun, 0, 0, fr, fq);
        else if (jt * 64 <= wave * 32 + 31)   moba_subtile<true>(Ks + jt * 64 * 72, Vs + jt * 64, 264, qf, o, mrun, lrun, jt * 64, wave * 32, fr, fq);
    }
#pragma unroll
    for (int qt = 0; qt < 2; ++qt) {
        float m = mrun[qt], l = lrun[qt];
        f32x4 acc[4];
#pragma unroll
        for (int dt = 0; dt < 4; ++dt) acc[dt] = o[dt][qt];
#pragma unroll
        for (int j = 0; j < 3; ++j) {
            const float2 ml = pml[qt][j];
            const float M = fmaxf(m, ml.x);
            const float wo = __builtin_amdgcn_exp2f(m - M), wj = ml.y * __builtin_amdgcn_exp2f(ml.x - M);
#pragma unroll
            for (int dt = 0; dt < 4; ++dt) {
                const uint2 ou = po[qt][j][dt];
                acc[dt][0] = acc[dt][0] * wo + wj * bf2f((bf16_t)(ou.x & 0xffff)); acc[dt][1] = acc[dt][1] * wo + wj * bf2f((bf16_t)(ou.x >> 16));
                acc[dt][2] = acc[dt][2] * wo + wj * bf2f((bf16_t)(ou.y & 0xffff)); acc[dt][3] = acc[dt][3] * wo + wj * bf2f((bf16_t)(ou.y >> 16));
            }
            l = l * wo + wj; m = M;
        }
        const float linv = __builtin_amdgcn_rcpf(l);
        const size_t tok = (size_t)(bh >> 3) * 4096 + qb * 256 + wave * 32 + qt * 16 + fr;
#pragma unroll
        for (int dt = 0; dt < 4; ++dt) {
            const int dh = dt * 16 + fq * 4;
            const uint2 gu = *(const uint2*)(p.gates + tok * 1024 + hcol + dh);
            const float g0 = bf2f((bf16_t)(gu.x & 0xffff)), g1 = bf2f((bf16_t)(gu.x >> 16)), g2 = bf2f((bf16_t)(gu.y & 0xffff)), g3 = bf2f((bf16_t)(gu.y >> 16));
            const float y0 = acc[dt][0] * linv * g0 * sigmoidf_(g0), y1 = acc[dt][1] * linv * g1 * sigmoidf_(g1);
            const float y2 = acc[dt][2] * linv * g2 * sigmoidf_(g2), y3 = acc[dt][3] * linv * g3 * sigmoidf_(g3);
            *(uint2*)(p.ypre + tok * 1024 + hcol + dh) = make_uint2(pack2(y0, y1), pack2(y2, y3));
        }
    }
}

DEVI void moba_own_phase(const Params& p, char* smem) {
    for (int it = blockIdx.x; it < 2048; it += gridDim.x) moba_own_item(p, it >> 4, it & 15, smem);
}

DEVI void lru_item(const Params& p, const int item, char* smem) {
    const int b = item >> 4, n = (item >> 1) & 7, half = item & 1;
    const int tid = threadIdx.x, wave = tid >> 6, lane = tid & 63, fr = lane & 15, fq = lane >> 4;
    bf16_t* xs = (bf16_t*)smem;
    bf16_t* wa = (bf16_t*)(smem + 35840);
    bf16_t* wx = (bf16_t*)(smem + 35840 + 17408);
    float* cw = (float*)(smem + 70656);
    float* agg = cw + 640;
    float* xcw = (float*)(smem + 81408) + wave * (16 * 68);
    bf16_t* gs = (bf16_t*)(smem + 81408 + 8 * 16 * 68 * 4);
    __syncthreads();
    for (int i = tid; i < 64 * 16; i += 512) {
        const int r = i >> 4, c = i & 15;
        *(uint4*)(wa + r * 136 + c * 8) = *(const uint4*)(p.wa_t + ((size_t)(n * 128 + half * 64 + r)) * 128 + c * 8);
        *(uint4*)(wx + r * 136 + c * 8) = *(const uint4*)(p.wx_t + ((size_t)(n * 128 + half * 64 + r)) * 128 + c * 8);
    }
    cw[tid] = p.lru_conv_w[(tid >> 7) * 1024 + n * 128 + (tid & 127)];
    if (tid < 128) cw[512 + tid] = p.lru_conv_b[n * 128 + tid];
    float ba[4], bx[4], lsl[4], hstart[4];
#pragma unroll
    for (int ct = 0; ct < 4; ++ct) {
        const int C = n * 128 + half * 64 + ct * 16 + fr;
        ba[ct] = p.lru_b_a[C]; bx[ct] = p.lru_b_x[C];
        const float lam = p.lru_lambda[C];
        lsl[ct] = -8.0f * (fmaxf(-lam, 0.f) + log1pf(expf(-fabsf(lam))));
        hstart[ct] = 0.f;
    }
    const bf16_t* xbase = p.xb + ((size_t)b * 4096) * 1024 + n * 128;
    const bf16_t* gbase = p.gl + ((size_t)b * 4096) * 1024 + n * 128 + half * 64;
    uint4 xr[5], gr0, gr1;
#define LRU_LOAD(t0_) do { \
        _Pragma("unroll") for (int q = 0; q < 5; ++q) { const int i = tid + q * 512; const int r = i >> 4, c = i & 15; const int t = (t0_) - 3 + r; \
            xr[q] = make_uint4(0, 0, 0, 0); if (i < 131 * 16 && t >= 0) xr[q] = *(const uint4*)(xbase + (size_t)t * 1024 + c * 8); } \
        gr0 = *(const uint4*)(gbase + (size_t)((t0_) + (tid >> 3)) * 1024 + (tid & 7) * 8); \
        gr1 = *(const uint4*)(gbase + (size_t)((t0_) + 64 + (tid >> 3)) * 1024 + (tid & 7) * 8); } while (0)
#define LRU_STORE() do { \
        _Pragma("unroll") for (int q = 0; q < 5; ++q) { const int i = tid + q * 512; const int r = i >> 4, c = i & 15; if (i < 131 * 16) *(uint4*)(xs + r * 136 + c * 8) = xr[q]; } \
        *(uint4*)(gs + (tid >> 3) * 72 + (tid & 7) * 8) = gr0; *(uint4*)(gs + (64 + (tid >> 3)) * 72 + (tid & 7) * 8) = gr1; } while (0)
    LRU_LOAD(0);
    LRU_STORE();
    __syncthreads();
    int par = 0;
    for (int ch = 0; ch < 32; ++ch) {
        const int t0 = ch * 128;
        { const int tn = (ch + 1 < 32) ? t0 + 128 : t0; LRU_LOAD(tn); }
        f32x4 ar[4], ax[4];
#pragma unroll
        for (int ct = 0; ct < 4; ++ct) { ar[ct] = (f32x4){0.f, 0.f, 0.f, 0.f}; ax[ct] = (f32x4){0.f, 0.f, 0.f, 0.f}; }
#pragma unroll
        for (int kk = 0; kk < 4; ++kk) {
            const int c0 = kk * 32 + fq * 8;
            float xcv[8];
            { const f32x4 b0 = *(const f32x4*)(cw + 512 + c0), b1 = *(const f32x4*)(cw + 512 + c0 + 4);
              xcv[0] = b0[0]; xcv[1] = b0[1]; xcv[2] = b0[2]; xcv[3] = b0[3]; xcv[4] = b1[0]; xcv[5] = b1[1]; xcv[6] = b1[2]; xcv[7] = b1[3]; }
#pragma unroll
            for (int tap = 0; tap < 4; ++tap) {
                const bf16x8 xv = *(const bf16x8*)(xs + (wave * 16 + fr + tap) * 136 + c0);
                const f32x4 w0 = *(const f32x4*)(cw + tap * 128 + c0), w1 = *(const f32x4*)(cw + tap * 128 + c0 + 4);
#pragma unroll
                for (int e = 0; e < 4; ++e) { xcv[e] += w0[e] * bfs2f(xv[e]); xcv[4 + e] += w1[e] * bfs2f(xv[4 + e]); }
            }
            if ((kk >> 1) == half) {
                float* d = xcw + fr * 68 + (kk & 1) * 32 + fq * 8;
                *(f32x4*)d = (f32x4){xcv[0], xcv[1], xcv[2], xcv[3]}; *(f32x4*)(d + 4) = (f32x4){xcv[4], xcv[5], xcv[6], xcv[7]};
            }
            const uint4 au = make_uint4(pack2(xcv[0], xcv[1]), pack2(xcv[2], xcv[3]), pack2(xcv[4], xcv[5]), pack2(xcv[6], xcv[7]));
            const bf16x8 af = *(const bf16x8*)&au;
#pragma unroll
            for (int ct = 0; ct < 4; ++ct) {
                const bf16x8 fa = *(const bf16x8*)(wa + (ct * 16 + fr) * 136 + c0);
                const bf16x8 fx = *(const bf16x8*)(wx + (ct * 16 + fr) * 136 + c0);
                ar[ct] = __builtin_amdgcn_mfma_f32_16x16x32_bf16(af, fa, ar[ct], 0, 0, 0);
                ax[ct] = __builtin_amdgcn_mfma_f32_16x16x32_bf16(af, fx, ax[ct], 0, 0, 0);
            }
        }
        float pa[4][4], pb[4][4];
#pragma unroll
        for (int ct = 0; ct < 4; ++ct) {
            float A[4], B[4];
#pragma unroll
            for (int j = 0; j < 4; ++j) {
                const float xc = xcw[(fq * 4 + j) * 68 + ct * 16 + fr];
                const float r = sigmoidf_(ar[ct][j] + ba[ct]);
                const float ig = sigmoidf_(ax[ct][j] + bx[ct]);
                const float av = __expf(lsl[ct] * r);
                const float mult = __builtin_amdgcn_sqrtf(fmaxf(1.0f - av * av, 0.f));
                A[j] = av; B[j] = mult * ig * xc;
            }
#pragma unroll
            for (int j = 1; j < 4; ++j) { B[j] = A[j] * B[j - 1] + B[j]; A[j] = A[j] * A[j - 1]; }
            float EA = 1.f, EB = 0.f, TA = 1.f, TB = 0.f;
#pragma unroll
            for (int g = 0; g < 4; ++g) {
                const float Ag = __shfl(A[3], fr + 16 * g), Bg = __shfl(B[3], fr + 16 * g);
                if (g < fq) { EB = Ag * EB + Bg; EA = Ag * EA; }
                TB = Ag * TB + Bg; TA = Ag * TA;
            }
#pragma unroll
            for (int j = 0; j < 4; ++j) { pa[ct][j] = A[j] * EA; pb[ct][j] = A[j] * EB + B[j]; }
            if (fq == 0) { float* ag = agg + ((par * 8 + wave) * 64 + ct * 16 + fr) * 2; ag[0] = TA; ag[1] = TB; }
        }
        __syncthreads();
#pragma unroll
        for (int ct = 0; ct < 4; ++ct) {
            float h = hstart[ct], hin = 0.f;
#pragma unroll
            for (int w = 0; w < 8; ++w) {
                const float2 ab = *(const float2*)(agg + ((par * 8 + w) * 64 + ct * 16 + fr) * 2);
                if (w == wave) hin = h;
                h = ab.x * h + ab.y;
            }
            hstart[ct] = h;
            const int C = n * 128 + half * 64 + ct * 16 + fr;
#pragma unroll
            for (int j = 0; j < 4; ++j) {
                const int tl = wave * 16 + fq * 4 + j;
                const size_t tok = (size_t)b * 4096 + t0 + tl;
                const float hs = pa[ct][j] * hin + pb[ct][j];
                const float g = bf2f(gs[tl * 72 + ct * 16 + fr]);
                p.ypre[tok * 1024 + C] = f2bf(hs * g * sigmoidf_(g));
            }
        }
        __syncthreads();
        LRU_STORE();
        __syncthreads();
        par ^= 1;
    }
#undef LRU_LOAD
#undef LRU_STORE
}

DEVI void lru_phase(const Params& p, char* smem) {
    for (int it = blockIdx.x; it < 256; it += gridDim.x) { const int pr = (it & 7) + 8 * (it >> 4), hf = (it >> 3) & 1; lru_item(p, pr * 2 + hf, smem); }
}

#define GRID_SYNC_CG() do { asm volatile("s_waitcnt vmcnt(0) lgkmcnt(0)" ::: "memory"); grid.sync(); \
    if (threadIdx.x < 64) { __builtin_amdgcn_fence(__ATOMIC_ACQUIRE, "agent"); asm volatile("s_waitcnt vmcnt(0) lgkmcnt(0)" ::: "memory"); } __syncthreads(); } while (0)
DEVI void grid_barrier(unsigned* bar, const unsigned k, const unsigned xcc, const unsigned nx, const unsigned nxcd) {
    asm volatile("s_waitcnt vmcnt(0) lgkmcnt(0)" ::: "memory");
    __syncthreads();
    if (threadIdx.x == 0) {
        const unsigned old = __hip_atomic_fetch_add(bar + 64 * (17 + xcc), 1u, __ATOMIC_RELAXED, __HIP_MEMORY_SCOPE_AGENT);
        if (old + 1 == k * nx) {
            __builtin_amdgcn_fence(__ATOMIC_RELEASE, "agent");
            asm volatile("s_waitcnt vmcnt(0) lgkmcnt(0)" ::: "memory");
            __hip_atomic_fetch_add(bar, 1u, __ATOMIC_RELAXED, __HIP_MEMORY_SCOPE_AGENT);
        }
        while (__hip_atomic_load(bar, __ATOMIC_RELAXED, __HIP_MEMORY_SCOPE_AGENT) < k * nxcd) __builtin_amdgcn_s_sleep(1);
        __builtin_amdgcn_fence(__ATOMIC_ACQUIRE, "agent");
        asm volatile("s_waitcnt vmcnt(0) lgkmcnt(0)" ::: "memory");
    }
    __syncthreads();
}
#define GRID_SYNC() do { ++bar_k; grid_barrier(p.bar, bar_k, xcc, nx, nxcd); } while (0)
__global__ void __launch_bounds__(512, 2) mega_fwd(Params p) {
    extern __shared__ __attribute__((aligned(16))) char smem[];
    cg::grid_group grid = cg::this_grid();
    unsigned bar_k = 0;
    const unsigned xcc = (unsigned)__builtin_amdgcn_s_getreg((3 << 11) | 20) & 0xFu;
    if (threadIdx.x == 0) {
        __hip_atomic_fetch_add(p.bar + 64 * (1 + xcc), 1u, __ATOMIC_RELAXED, __HIP_MEMORY_SCOPE_AGENT);
        __hip_atomic_fetch_add(p.bar + 64 * 40, 1u, __ATOMIC_RELEASE, __HIP_MEMORY_SCOPE_AGENT);
        while (__hip_atomic_load(p.bar + 64 * 40, __ATOMIC_RELAXED, __HIP_MEMORY_SCOPE_AGENT) < gridDim.x) __builtin_amdgcn_s_sleep(1);
    }
    __syncthreads();
    if (p.bar == nullptr) GRID_SYNC_CG();
    unsigned nx = 0, nxcd = 0;
    for (unsigned j = 0; j < 16; ++j) { const unsigned c = __hip_atomic_load(p.bar + 64 * (1 + j), __ATOMIC_RELAXED, __HIP_MEMORY_SCOPE_AGENT); nxcd += (c != 0u); if (j == xcc) nx = c; }
    phase_a(p, smem);
    GRID_SYNC();
    prenorm_phase(p.x, p.norm_g, p.mod, p.h);
    GRID_SYNC();
    gemm_phase(p.h, p.wt_in0, NTOK, 4096, 1024, smem, Epi1{Epi1P{p.positions, p.kmean, p.gates, p.qa}});
    GRID_SYNC();
    moba_select_phase(p, smem);
    sb_phase(p, smem);
    GRID_SYNC();
    moba_past_phase(p, smem);
    GRID_SYNC();
    moba_own_phase(p, smem);
    GRID_SYNC();
    gemm_phase(p.ypre, p.wt_out0, NTOK, 1024, 1024, smem, EpiResP<false>{p.x, p.kb  , p.mod + 2048});
    GRID_SYNC();
    prenorm_bf_phase(p.kb, p.norm_g + 1024, p.mod + 16 * 3072, p.h);
    GRID_SYNC();
    gemm_phase(p.h, p.wt_in1, NTOK, 2048, 1024, smem, Epi3P{p.xb, p.gl});
    GRID_SYNC();
    lru_phase(p, smem);
    GRID_SYNC();
    gemm_phase(p.ypre, p.wt_out1, NTOK, 1024, 1024, smem, EpiResP<true>{p.kb, p.gates  , p.mod + 16 * 3072 + 2048});
    GRID_SYNC();
    final_norm_bf_phase(p.gates, p.out, p.final_g);
}

extern "C" void kernel_launch(void* const* d_in, const int* in_sizes, int n_in, void* d_out, int out_size, void* d_ws, size_t ws_size, hipStream_t stream) {
    constexpr size_t kDynLds = 147456;
    static int grid_blocks = 0;
    if (!grid_blocks) {
        hipFuncSetAttribute((const void*)mega_fwd, hipFuncAttributeMaxDynamicSharedMemorySize, (int)kDynLds);
        int dev = 0, cus = 0, per_cu = 0;
        hipGetDevice(&dev);
        hipDeviceGetAttribute(&cus, hipDeviceAttributeMultiprocessorCount, dev);
        hipOccupancyMaxActiveBlocksPerMultiprocessor(&per_cu, mega_fwd, 512, kDynLds);
        if (per_cu < 1) per_cu = 1;
        grid_blocks = cus * 1;
    }
    Params p{};
    p.x = (const float*)d_in[0]; p.c = (const float*)d_in[1]; p.positions = (const int*)d_in[2];
    p.norm_g = (const float*)d_in[3]; p.w_mod = (const float*)d_in[4]; p.b_mod = (const float*)d_in[5];
    p.attn_w_in = (const float*)d_in[6]; p.attn_w_out = (const float*)d_in[7]; p.lru_w_in = (const float*)d_in[8];
    p.lru_conv_w = (const float*)d_in[9]; p.lru_conv_b = (const float*)d_in[10]; p.lru_w_a = (const float*)d_in[11];
    p.lru_b_a = (const float*)d_in[12]; p.lru_w_x = (const float*)d_in[13]; p.lru_b_x = (const float*)d_in[14];
    p.lru_lambda = (const float*)d_in[15]; p.lru_w_out = (const float*)d_in[16]; p.final_g = (const float*)d_in[17];
    p.out = (float*)d_out;
    char* w = (char*)d_ws; size_t off = 0;
    auto take = [&](size_t bytes) { char* r = w + off; off += (bytes + 255) & ~(size_t)255; return r; };
    p.wt_in0 = (bf16_t*)take((size_t)4096 * 1024 * 2);
    p.wt_out0 = (bf16_t*)take((size_t)1024 * 1024 * 2);
    p.wt_in1 = (bf16_t*)take((size_t)2048 * 1024 * 2);
    p.wt_out1 = (bf16_t*)take((size_t)1024 * 1024 * 2);
    p.wa_t = (bf16_t*)take((size_t)8 * 128 * 128 * 2);
    p.wx_t = (bf16_t*)take((size_t)8 * 128 * 128 * 2);
    p.mod = (float*)take((size_t)2 * 16 * 3072 * 4);
    p.kmean = (float*)take((size_t)16 * 8 * 16 * 64 * 4);
    p.h = (bf16_t*)take((size_t)NTOK * 1024 * 2);
    const size_t hd = (size_t)16 * 8 * 4096 * 64 * 2;
    p.qa = (bf16_t*)take(hd); p.ka = (bf16_t*)take(hd); p.vta = (bf16_t*)take(hd);
    p.qb = (bf16_t*)take(hd); p.kb = (bf16_t*)take(hd); p.vtb = (bf16_t*)take(hd);
    p.gates = (bf16_t*)take((size_t)NTOK * 1024 * 2);
    p.ypre = (bf16_t*)take((size_t)NTOK * 1024 * 2);
    p.bar = (unsigned*)take(16384);
    p.mcnt = (int*)take((size_t)128 * 16 * 4);
    p.mlist = (unsigned short*)take((size_t)128 * 16 * LCAP * 2);
    p.part_ml = (float*)take((size_t)128 * 4096 * 3 * 2 * 4);
    p.part_o = (bf16_t*)take((size_t)128 * 4096 * 3 * 64 * 2);
    p.xb = p.qa;
    p.gl = p.vta;
    hipMemsetAsync(p.bar, 0, 16384, stream);
    void* args[] = {&p};
    hipError_t e = hipLaunchCooperativeKernel((const void*)mega_fwd, dim3(grid_blocks), dim3(512), args, kDynLds, stream);
    if (e != hipSuccess) fprintf(stderr, "cooperative launch failed: %s (grid %d)\n", hipGetErrorString(e), grid_blocks);
}
```

```cpp
#include <hip/hip_runtime.h>
#include <hip/hip_cooperative_groups.h>
#include <stdint.h>
#include <cstdio>
namespace cg = cooperative_groups;

#define DEVI __device__ __forceinline__
typedef unsigned short bf16_t;
typedef short bf16x8 __attribute__((ext_vector_type(8)));
typedef short bf16x4 __attribute__((ext_vector_type(4)));
typedef float f32x4 __attribute__((ext_vector_type(4)));

constexpr int NB = 16, SEQ = 4096, DM = 1024, NTOK = NB * SEQ;

struct Params {
    const float *x, *c; const int* positions;
    const float *norm_g, *w_mod, *b_mod, *attn_w_in, *attn_w_out, *lru_w_in, *lru_conv_w, *lru_conv_b,
        *lru_w_a, *lru_b_a, *lru_w_x, *lru_b_x, *lru_lambda, *lru_w_out, *final_g;
    float* out;
    bf16_t *wt_in0, *wt_out0, *wt_in1, *wt_out1, *wa_t, *wx_t;
    float *mod, *kmean, *part_ml; unsigned* bar; int* mcnt; unsigned short* mlist; bf16_t* part_o;
    bf16_t *h, *qa, *ka, *vta, *qb, *kb, *vtb, *gates, *ypre, *xb, *gl;
};

DEVI bf16_t f2bf(float f) { unsigned u = __float_as_uint(f); u += 0x7fffu + ((u >> 16) & 1u); return (bf16_t)(u >> 16); }
DEVI float bf2f(bf16_t h) { return __uint_as_float(((unsigned)h) << 16); }
DEVI float bfs2f(short h) { return __uint_as_float(((unsigned)(unsigned short)h) << 16); }
typedef __bf16 bf16x2_t __attribute__((ext_vector_type(2)));
typedef float f32x2_t __attribute__((ext_vector_type(2)));
DEVI unsigned pack2(float a, float b) { const f32x2_t v = {a, b}; const bf16x2_t h = __builtin_convertvector(v, bf16x2_t); return __builtin_bit_cast(unsigned, h); }
DEVI float wave_sum(float v) {
#pragma unroll
    for (int o = 32; o > 0; o >>= 1) v += __shfl_xor(v, o);
    return v;
}
DEVI float sx16(float x, int fq) { const auto r = __builtin_amdgcn_permlane16_swap(__float_as_uint(x), __float_as_uint(x), false, false); return __uint_as_float((fq & 1) ? r[0] : r[1]); }
DEVI float sx32(float x, int fq) { const auto r = __builtin_amdgcn_permlane32_swap(__float_as_uint(x), __float_as_uint(x), false, false); return __uint_as_float((fq & 2) ? r[0] : r[1]); }
typedef unsigned u32x4v __attribute__((ext_vector_type(4)));
typedef float f32x4v __attribute__((ext_vector_type(4)));
DEVI uint4 ld_nt16(const void* p) { const u32x4v w = __builtin_nontemporal_load((const u32x4v*)p); return make_uint4(w[0], w[1], w[2], w[3]); }
DEVI float4 ld_nt16f(const void* p) { const f32x4v w = __builtin_nontemporal_load((const f32x4v*)p); return make_float4(w[0], w[1], w[2], w[3]); }
DEVI void st_nt16f(void* p, const float4 v) { const f32x4v w = {v.x, v.y, v.z, v.w}; __builtin_nontemporal_store(w, (f32x4v*)p); }
DEVI void st_nt16(void* p, const uint4 v) { const u32x4v w = {v.x, v.y, v.z, v.w}; __builtin_nontemporal_store(w, (u32x4v*)p); }
DEVI float sigmoidf_(float x) { return __builtin_amdgcn_rcpf(1.0f + __expf(-x)); }

DEVI void transpose_tile(const float* __restrict__ W, bf16_t* Wt, int K, int N, int tile, float* lds) {
    const int tn = N >> 6; const int tk = tile / tn, tnn = tile - tk * tn; const int k0 = tk * 64, n0 = tnn * 64;
    const int tid = threadIdx.x;
#pragma unroll
    for (int i = 0; i < 2; ++i) {
        const int r = (tid >> 4) + i * 32, c4 = tid & 15;
        const float4 v = *(const float4*)(W + (size_t)(k0 + r) * N + n0 + c4 * 4);
        float* d = lds + r * 65 + c4 * 4; d[0] = v.x; d[1] = v.y; d[2] = v.z; d[3] = v.w;
    }
    __syncthreads();
    const int n = tid >> 3, kc = tid & 7;
    unsigned pk[4];
#pragma unroll
    for (int j = 0; j < 4; ++j) pk[j] = pack2(lds[(kc * 8 + 2 * j) * 65 + n], lds[(kc * 8 + 2 * j + 1) * 65 + n]);
    *(uint4*)(Wt + (size_t)(n0 + n) * K + k0 + kc * 8) = make_uint4(pk[0], pk[1], pk[2], pk[3]);
    __syncthreads();
}

DEVI void mod_unit(const Params& p, int unit, float* lds) {
    float* cl = lds;
    float* red = lds + 16384;
    const int tid = threadIdx.x;
    for (int i = tid; i < 4096; i += 512) ((float4*)cl)[i] = ((const float4*)p.c)[i];
    __syncthreads();
    const int l = unit / 96, n0 = (unit % 96) * 32; const int ks = tid >> 5, col = tid & 31;
    float acc[16];
#pragma unroll
    for (int b = 0; b < 16; ++b) acc[b] = 0.f;
    const float* w = p.w_mod + (size_t)l * 1024 * 3072 + n0 + col;
#pragma unroll 8
    for (int k = ks * 64; k < ks * 64 + 64; ++k) {
        const float wv = w[(size_t)k * 3072];
#pragma unroll
        for (int b = 0; b < 16; ++b) acc[b] += cl[b * 1024 + k] * wv;
    }
#pragma unroll
    for (int b = 0; b < 16; ++b) red[(ks * 16 + b) * 32 + col] = acc[b];
    __syncthreads();
    {
        const int b = tid >> 5; float s = 0.f;
#pragma unroll
        for (int k2 = 0; k2 < 16; ++k2) s += red[(k2 * 16 + b) * 32 + col];
        p.mod[(l * 16 + b) * 3072 + n0 + col] = s + p.b_mod[l * 3072 + n0 + col];
    }
    __syncthreads();
}

DEVI void phase_a(const Params& p, char* smem) {
    float* lds = (float*)smem;
    constexpr int U_MOD = 192, T_IN0 = 16 * 64, T_OUT0 = 16 * 16, T_IN1 = 16 * 32, T_OUT1 = 16 * 16, T_G = 8 * 4;
    constexpr int TOTAL = U_MOD + T_IN0 + T_OUT0 + T_IN1 + T_OUT1 + 2 * T_G;
    for (int u = blockIdx.x; u < TOTAL; u += gridDim.x) {
        int v = u;
        if (v < U_MOD) { mod_unit(p, v, lds); continue; } v -= U_MOD;
        if (v < T_IN0) { transpose_tile(p.attn_w_in, p.wt_in0, 1024, 4096, v, lds); continue; } v -= T_IN0;
        if (v < T_OUT0) { transpose_tile(p.attn_w_out, p.wt_out0, 1024, 1024, v, lds); continue; } v -= T_OUT0;
        if (v < T_IN1) { transpose_tile(p.lru_w_in, p.wt_in1, 1024, 2048, v, lds); continue; } v -= T_IN1;
        if (v < T_OUT1) { transpose_tile(p.lru_w_out, p.wt_out1, 1024, 1024, v, lds); continue; } v -= T_OUT1;
        if (v < T_G) { const int blk = v >> 2; transpose_tile(p.lru_w_a + blk * 16384, p.wa_t + blk * 16384, 128, 128, v & 3, lds); continue; } v -= T_G;
        { const int blk = v >> 2; transpose_tile(p.lru_w_x + blk * 16384, p.wx_t + blk * 16384, 128, 128, v & 3, lds); }
    }
    for (int i = blockIdx.x * 512 + threadIdx.x; i < 16 * 8 * 16 * 64; i += gridDim.x * 512) __hip_atomic_store(p.kmean + i, 0.f, __ATOMIC_RELAXED, __HIP_MEMORY_SCOPE_AGENT);
    for (int i = blockIdx.x * 512 + threadIdx.x; i < 128 * 16; i += gridDim.x * 512) __hip_atomic_store(p.mcnt + i, 0, __ATOMIC_RELAXED, __HIP_MEMORY_SCOPE_AGENT);
}

DEVI void prenorm_phase(const float* xin, const float* __restrict__ g, const float* modl, bf16_t* hout) {
    const int wave = threadIdx.x >> 6, lane = threadIdx.x & 63;
    const int stride = gridDim.x * 8;
    int row = blockIdx.x * 8 + wave;
    float4 nx[4];
#pragma unroll
    for (int i = 0; i < 4; ++i) nx[i] = ld_nt16f((const float4*)(xin + (size_t)(row < NTOK ? row : 0) * DM) + lane + 64 * i);
    for (; row < NTOK; row += stride) {
        float4 v[4]; float ss = 0.f;
#pragma unroll
        for (int i = 0; i < 4; ++i) { v[i] = nx[i]; ss += v[i].x * v[i].x + v[i].y * v[i].y + v[i].z * v[i].z + v[i].w * v[i].w; }
        { const int rn = (row + stride < NTOK) ? row + stride : row;
#pragma unroll
          for (int i = 0; i < 4; ++i) nx[i] = ld_nt16f((const float4*)(xin + (size_t)rn * DM) + lane + 64 * i); }
        ss = wave_sum(ss);
        const float rinv = rsqrtf(ss * (1.0f / 1024.0f) + 1e-6f);
        const float* md = modl + (row >> 12) * 3072;
#pragma unroll
        for (int i = 0; i < 4; ++i) {
            const int k = (lane + 64 * i) * 4;
            const float4 gg = *(const float4*)(g + k), sh = *(const float4*)(md + k), sc = *(const float4*)(md + 1024 + k);
            const float o0 = v[i].x * rinv * gg.x * (1.f + sc.x) + sh.x, o1 = v[i].y * rinv * gg.y * (1.f + sc.y) + sh.y;
            const float o2 = v[i].z * rinv * gg.z * (1.f + sc.z) + sh.z, o3 = v[i].w * rinv * gg.w * (1.f + sc.w) + sh.w;
            *(uint2*)(hout + (size_t)row * DM + k) = make_uint2(pack2(o0, o1), pack2(o2, o3));
        }
    }
}

DEVI void bf8_to_f(const uint4 u, float (&f)[8]) {
    f[0] = __uint_as_float(u.x << 16); f[1] = __uint_as_float(u.x & 0xffff0000u); f[2] = __uint_as_float(u.y << 16); f[3] = __uint_as_float(u.y & 0xffff0000u);
    f[4] = __uint_as_float(u.z << 16); f[5] = __uint_as_float(u.z & 0xffff0000u); f[6] = __uint_as_float(u.w << 16); f[7] = __uint_as_float(u.w & 0xffff0000u);
}
DEVI void prenorm_bf_phase(const bf16_t* xin, const float* __restrict__ g, const float* modl, bf16_t* hout) {
    const int wave = threadIdx.x >> 6, lane = threadIdx.x & 63;
    const int stride = gridDim.x * 8;
    int row = blockIdx.x * 8 + wave;
    uint4 nx0 = ld_nt16((const uint4*)(xin + (size_t)(row < NTOK ? row : 0) * DM) + lane), nx1 = ld_nt16((const uint4*)(xin + (size_t)(row < NTOK ? row : 0) * DM) + lane + 64);
    for (; row < NTOK; row += stride) {
        float v[2][8]; float ss = 0.f;
        bf8_to_f(nx0, v[0]); bf8_to_f(nx1, v[1]);
        { const int rn = (row + stride < NTOK) ? row + stride : row;
          nx0 = ld_nt16((const uint4*)(xin + (size_t)rn * DM) + lane); nx1 = ld_nt16((const uint4*)(xin + (size_t)rn * DM) + lane + 64); }
#pragma unroll
        for (int i = 0; i < 2; ++i)
#pragma unroll
            for (int e = 0; e < 8; ++e) ss += v[i][e] * v[i][e];
        ss = wave_sum(ss);
        const float rinv = rsqrtf(ss * (1.0f / 1024.0f) + 1e-6f);
        const float* md = modl + (row >> 12) * 3072;
#pragma unroll
        for (int i = 0; i < 2; ++i) {
            const int k = (lane + 64 * i) * 8;
            float o[8];
#pragma unroll
            for (int h2 = 0; h2 < 2; ++h2) {
                const float4 gg = *(const float4*)(g + k + 4 * h2), sh = *(const float4*)(md + k + 4 * h2), sc = *(const float4*)(md + 1024 + k + 4 * h2);
                o[4 * h2 + 0] = v[i][4 * h2 + 0] * rinv * gg.x * (1.f + sc.x) + sh.x; o[4 * h2 + 1] = v[i][4 * h2 + 1] * rinv * gg.y * (1.f + sc.y) + sh.y;
                o[4 * h2 + 2] = v[i][4 * h2 + 2] * rinv * gg.z * (1.f + sc.z) + sh.z; o[4 * h2 + 3] = v[i][4 * h2 + 3] * rinv * gg.w * (1.f + sc.w) + sh.w;
            }
            *(uint4*)(hout + (size_t)row * DM + k) = make_uint4(pack2(o[0], o[1]), pack2(o[2], o[3]), pack2(o[4], o[5]), pack2(o[6], o[7]));
        }
    }
}
DEVI void final_norm_bf_phase(const bf16_t* xin, float* out, const float* __restrict__ g) {
    const int wave = threadIdx.x >> 6, lane = threadIdx.x & 63;
    const int stride = gridDim.x * 8;
    int row = blockIdx.x * 8 + wave;
    uint4 nx0 = ld_nt16((const uint4*)(xin + (size_t)(row < NTOK ? row : 0) * DM) + lane), nx1 = ld_nt16((const uint4*)(xin + (size_t)(row < NTOK ? row : 0) * DM) + lane + 64);
    for (; row < NTOK; row += stride) {
        float v[2][8]; float ss = 0.f;
        bf8_to_f(nx0, v[0]); bf8_to_f(nx1, v[1]);
        { const int rn = (row + stride < NTOK) ? row + stride : row;
          nx0 = ld_nt16((const uint4*)(xin + (size_t)rn * DM) + lane); nx1 = ld_nt16((const uint4*)(xin + (size_t)rn * DM) + lane + 64); }
#pragma unroll
        for (int i = 0; i < 2; ++i)
#pragma unroll
            for (int e = 0; e < 8; ++e) ss += v[i][e] * v[i][e];
        ss = wave_sum(ss);
        const float rinv = rsqrtf(ss * (1.0f / 1024.0f) + 1e-6f);
#pragma unroll
        for (int i = 0; i < 2; ++i) {
            const int k = (lane + 64 * i) * 8;
#pragma unroll
            for (int h2 = 0; h2 < 2; ++h2) {
                const float4 gg = *(const float4*)(g + k + 4 * h2);
                float4 o; o.x = v[i][4 * h2 + 0] * rinv * gg.x; o.y = v[i][4 * h2 + 1] * rinv * gg.y; o.z = v[i][4 * h2 + 2] * rinv * gg.z; o.w = v[i][4 * h2 + 3] * rinv * gg.w;
                st_nt16f(out + (size_t)row * DM + k + 4 * h2, o);
            }
        }
    }
}

DEVI void final_norm_phase(float* xio, const float* __restrict__ g) {
    const int wave = threadIdx.x >> 6, lane = threadIdx.x & 63;
    for (int row = blockIdx.x * 8 + wave; row < NTOK; row += gridDim.x * 8) {
        float4* xr = (float4*)(xio + (size_t)row * DM);
        float4 v[4]; float ss = 0.f;
#pragma unroll
        for (int i = 0; i < 4; ++i) { v[i] = xr[lane + 64 * i]; ss += v[i].x * v[i].x + v[i].y * v[i].y + v[i].z * v[i].z + v[i].w * v[i].w; }
        ss = wave_sum(ss);
        const float rinv = rsqrtf(ss * (1.0f / 1024.0f) + 1e-6f);
#pragma unroll
        for (int i = 0; i < 4; ++i) {
            const float4 gg = *(const float4*)(g + (lane + 64 * i) * 4);
            float4 o; o.x = v[i].x * rinv * gg.x; o.y = v[i].y * rinv * gg.y; o.z = v[i].z * rinv * gg.z; o.w = v[i].w * rinv * gg.w;
            xr[lane + 64 * i] = o;
        }
    }
}

#define LAS __attribute__((address_space(3)))
constexpr int BM = 256, BK = 64, HALF = 128, HTB = HALF * BK * 2, NXCD = 8, WGM = 8;
DEVI int lds_byte(int r, int c) { const int st = (r >> 4) * 2 + (c >> 5), rr = r & 15, cc = c & 31, ob = rr * 64 + cc * 2; return st * 1024 + (ob ^ (((ob >> 9) & 1) << 5)); }
DEVI void stage_rc(int b, int& R, int& C) { const int st = b / 1024, sb = b % 1024, swz = sb ^ (((sb >> 9) & 1) << 5); R = (st >> 1) * 16 + swz / 64; C = (st & 1) * 32 + (swz % 64) / 2; }
DEVI int perm32(int rho) { const int n = rho >> 4, i = rho & 15; return 8 * (i >> 2) + 4 * n + (i & 3); }
struct Unit { int pm, pn; };
struct StaticOrder {
    int nM, nN, nwg, G, c;
    DEVI void init(int M, int N, int G_, int c_) { nM = M / BM; nN = N / BM; nwg = nM * nN; G = G_; c = c_; }
    DEVI bool next(int i, Unit& u) const {
        const long L = (long)i * G + c; if (L >= nwg) return false;
        int wgid = (int)L; { const int q = nwg / NXCD, r = nwg % NXCD, xcd = wgid % NXCD, off = wgid / NXCD; wgid = (xcd < r ? xcd * (q + 1) : r * (q + 1) + (xcd - r) * q) + off; }
        const int nig = WGM * nN, gid = wgid / nig, fm = gid * WGM, gsz = (nM - fm) < WGM ? (nM - fm) : WGM;
        u.pm = fm + ((wgid % nig) % gsz); u.pn = (wgid % nig) / gsz; return true;
    }
};

template <class Epi>
DEVI void gemm_phase(const bf16_t* gA, const bf16_t* gBt, const int M, const int N, const int K, char* smem, const Epi& E) {
    LAS unsigned char* lds = (LAS unsigned char*)smem;
    StaticOrder S; S.init(M, N, gridDim.x, blockIdx.x);
    int tid = threadIdx.x; asm volatile("" : "+v"(tid));
    const int wid = __builtin_amdgcn_readfirstlane(tid >> 6), lane = tid & 63, wr = wid >> 2, wc = wid & 3, fr = lane & 15, fq = lane >> 4;
    const int nt = K / BK;
    unsigned voffA[2], voffB[2];
#pragma unroll
    for (int i = 0; i < 2; ++i) { int R, C; stage_rc(tid * 16 + i * 8192, R, C); voffA[i] = (unsigned)(R * K + C) * 2u;
        const int Rb = Epi::PERM ? ((R & ~31) + perm32(R & 31)) : R; voffB[i] = (unsigned)(Rb * K + C) * 2u; }
    const size_t kstep = (size_t)(BK * 2);
    const size_t hstep = (size_t)HALF * K * 2;
    const size_t tstep = 2 * hstep;
    const unsigned ldsw = (unsigned)wid * 1024u;
    const int aoff = lds_byte(wr * 64 + fr, fq * 8), boff = lds_byte(wc * 32 + fr, fq * 8);
#define PG8_SA(b, h) (((b) * 2 + (h)) * HTB)
#define PG8_SB(b, h) ((4 + (b) * 2 + (h)) * HTB)
#define PG8_STAGE(bufoff, gbase, voff) do { _Pragma("unroll") for (int _i = 0; _i < 2; ++_i) \
        __builtin_amdgcn_global_load_lds((const __attribute__((address_space(1))) unsigned*)((const char*)(gbase) + (voff)[_i]), (LAS unsigned*)(lds + (bufoff) + ldsw + _i * 8192), 16, 0, 0); } while (0)
#define PG8_LDA(dst, b, h) do { _Pragma("unroll") for (int m = 0; m < 4; ++m) _Pragma("unroll") for (int k = 0; k < 2; ++k) dst[m][k] = *(const LAS bf16x8*)(lds + PG8_SA(b, h) + aoff + m * 2048 + k * 1024); } while (0)
#define PG8_LDB(dst, b, h) do { _Pragma("unroll") for (int n = 0; n < 2; ++n) _Pragma("unroll") for (int k = 0; k < 2; ++k) dst[n][k] = *(const LAS bf16x8*)(lds + PG8_SB(b, h) + boff + n * 2048 + k * 1024); } while (0)
#define PG8_MMA(ai, bj, At, Bt) do { __builtin_amdgcn_s_setprio(1); _Pragma("unroll") for (int m = 0; m < 4; ++m) _Pragma("unroll") for (int n = 0; n < 2; ++n) _Pragma("unroll") for (int k = 0; k < 2; ++k) \
        acc[ai][bj][m][n] = __builtin_amdgcn_mfma_f32_16x16x32_bf16(Bt[n][k], At[m][k], acc[ai][bj][m][n], 0, 0, 0); __builtin_amdgcn_s_setprio(0); } while (0)
#define PG8_WAIT_V(n) asm volatile("s_waitcnt vmcnt(" #n ")" ::: "memory")
#define PG8_WAIT_L(n) asm volatile("s_waitcnt lgkmcnt(" #n ")" ::: "memory")
#define PG8_BAR __builtin_amdgcn_s_barrier()
#define PG8_SCHED __builtin_amdgcn_sched_barrier(0)
    Unit cur, nxt; int ui = 0;
    if (!S.next(0, cur)) return;
    f32x4 acc[2][2][4][2];
#pragma unroll
    for (int a = 0; a < 2; ++a)
#pragma unroll
        for (int b = 0; b < 2; ++b)
#pragma unroll
            for (int m = 0; m < 4; ++m)
#pragma unroll
                for (int n = 0; n < 2; ++n) acc[a][b][m][n] = (f32x4){0.f, 0.f, 0.f, 0.f};
    bf16x8 At[4][2], B0[2][2], B1[2][2];
    const char* cA = (const char*)gA + (size_t)cur.pm * tstep; const char* cB = (const char*)gBt + (size_t)cur.pn * tstep;
    PG8_STAGE(PG8_SB(0, 0), cB, voffB); PG8_STAGE(PG8_SB(0, 1), cB + hstep, voffB); PG8_STAGE(PG8_SA(0, 0), cA, voffA); PG8_STAGE(PG8_SA(0, 1), cA + hstep, voffA);
    if (wr == 1) PG8_BAR;
    PG8_WAIT_V(2); PG8_BAR;
    PG8_STAGE(PG8_SB(1, 0), cB + kstep, voffB); PG8_STAGE(PG8_SA(1, 0), cA + kstep, voffA); PG8_STAGE(PG8_SB(1, 1), cB + hstep + kstep, voffB);
    PG8_WAIT_V(6); PG8_BAR;
    for (;;) {
        const bool has_next = S.next(ui + 1, nxt);
        const char* nA = has_next ? (const char*)gA + (size_t)nxt.pm * tstep : cA; const char* nB = has_next ? (const char*)gBt + (size_t)nxt.pn * tstep : cB;
        for (int t = 0; t < nt; t += 2) {
            const bool last = (t == nt - 2);
            const char* a1 = cA + (size_t)(t + 1) * kstep;
            const char* a2 = last ? nA : cA + (size_t)(t + 2) * kstep; const char* b2 = last ? nB : cB + (size_t)(t + 2) * kstep;
            const char* a3 = a2 + kstep; const char* b3 = b2 + kstep;
            PG8_LDB(B0, 0, 0); PG8_LDB(B1, 0, 1); PG8_SCHED; PG8_LDA(At, 0, 0); PG8_STAGE(PG8_SA(1, 1), a1 + hstep, voffA);
            PG8_WAIT_V(8); PG8_WAIT_L(0); PG8_BAR; PG8_MMA(0, 0, At, B0); PG8_MMA(0, 1, At, B1); PG8_BAR; PG8_SCHED;
            PG8_LDA(At, 0, 1); PG8_STAGE(PG8_SB(0, 0), b2, voffB); PG8_STAGE(PG8_SB(0, 1), b2 + hstep, voffB); PG8_STAGE(PG8_SA(0, 0), a2, voffA);
            PG8_WAIT_V(8); PG8_WAIT_L(0); PG8_BAR; PG8_MMA(1, 0, At, B0); PG8_MMA(1, 1, At, B1); PG8_BAR; PG8_SCHED;
            PG8_LDB(B0, 1, 0); PG8_LDB(B1, 1, 1); PG8_SCHED; PG8_LDA(At, 1, 0); PG8_STAGE(PG8_SA(0, 1), a2 + hstep, voffA);
            PG8_WAIT_V(8); PG8_WAIT_L(0); PG8_BAR; PG8_MMA(0, 0, At, B0); PG8_MMA(0, 1, At, B1); PG8_BAR; PG8_SCHED;
            PG8_LDA(At, 1, 1); PG8_STAGE(PG8_SB(1, 0), b3, voffB); PG8_STAGE(PG8_SB(1, 1), b3 + hstep, voffB); PG8_STAGE(PG8_SA(1, 0), a3, voffA);
            PG8_WAIT_V(8); PG8_WAIT_L(0); PG8_BAR; PG8_MMA(1, 0, At, B0); PG8_MMA(1, 1, At, B1); PG8_BAR; PG8_SCHED;
        }
        if (wr == 0) PG8_BAR;
        E(acc, cur.pm * BM, cur.pn * BM, wr, wc, fr, fq);
        PG8_WAIT_V(0);
        if (!has_next) break;
#pragma unroll
        for (int a = 0; a < 2; ++a)
#pragma unroll
            for (int b = 0; b < 2; ++b)
#pragma unroll
                for (int m = 0; m < 4; ++m)
#pragma unroll
                    for (int n = 0; n < 2; ++n) acc[a][b][m][n] = (f32x4){0.f, 0.f, 0.f, 0.f};
        cur = nxt; cA = nA; cB = nB; ++ui;
        if (wr == 1) PG8_BAR;
    }
    PG8_WAIT_V(0);
    PG8_BAR;
#undef PG8_SA
#undef PG8_SB
#undef PG8_STAGE
#undef PG8_LDA
#undef PG8_LDB
#undef PG8_MMA
}

constexpr size_t HD = (size_t)16 * 8 * 4096 * 64;
struct Epi1P { const int* positions; float* kmean; bf16_t* gates; bf16_t* qkv; };
struct Epi1 {
    static constexpr bool PERM = true;
    Epi1P p;
    DEVI void operator()(f32x4 (&acc)[2][2][4][2], int brow, int bcol, int wr, int wc, int fr, int fq) const {
        const int grp = bcol >> 9, cbase = bcol & 511;
        const int b = brow >> 12, s0 = brow & 4095;
        if ((grp == 3 || grp == 4) && ((wc & 1) == 0)) {
            const float invt[8] = {1.0f, 0.19392274474868576f, 0.03760603093086393f, 0.007292664737217109f,
                                   0.001414213562373095f, 0.0002742481756762073f, 5.318295896944988e-05f, 1.031338537721246e-05f};
#pragma unroll
            for (int ai = 0; ai < 2; ++ai)
#pragma unroll
                for (int m = 0; m < 4; ++m) {
                    const int s = s0 + ai * 128 + wr * 64 + m * 16 + fr;
                    const float pos = (float)p.positions[b * 4096 + s];
#pragma unroll
                    for (int n = 0; n < 2; ++n)
#pragma unroll
                        for (int j = 0; j < 4; ++j) {
                            const float ang = pos * invt[n * 4 + j];
                            const float rvf = __builtin_amdgcn_fractf(ang * 0.15915494309189535f);
                            const float sn = __builtin_amdgcn_sinf(rvf), cs = __builtin_amdgcn_cosf(rvf);
#pragma unroll
                            for (int bj = 0; bj < 2; ++bj) {
                                const float v = acc[ai][bj][m][n][j];
                                const float pr = sx16(v, fq);
                                const float rot = (fq == 0) ? (v * cs - pr * sn) : (v * cs + pr * sn);
                                acc[ai][bj][m][n][j] = (fq < 2) ? rot : v;
                            }
                        }
                }
        }
        if (grp == 4) {
            const int nblk = s0 >> 8;
#pragma unroll
            for (int bj = 0; bj < 2; ++bj)
#pragma unroll
                for (int n = 0; n < 2; ++n)
#pragma unroll
                    for (int j = 0; j < 4; ++j) {
                        float cs = 0.f;
#pragma unroll
                        for (int ai = 0; ai < 2; ++ai)
#pragma unroll
                            for (int m = 0; m < 4; ++m) cs += acc[ai][bj][m][n][j];
                        cs += __shfl_xor(cs, 1); cs += __shfl_xor(cs, 2); cs += __shfl_xor(cs, 4); cs += __shfl_xor(cs, 8);
                        if (fr == 0) {
                            const int colg = cbase + bj * 128 + wc * 32 + fq * 8 + n * 4 + j;
                            atomicAdd(p.kmean + ((size_t)((b * 8 + (colg >> 6)) * 16 + nblk)) * 64 + (colg & 63), cs);
                        }
                    }
        }
        if (grp >= 6) {
#pragma unroll
            for (int ai = 0; ai < 2; ++ai)
#pragma unroll
                for (int m = 0; m < 4; ++m) {
                    const size_t tok = (size_t)brow + ai * 128 + wr * 64 + m * 16 + fr;
#pragma unroll
                    for (int bj = 0; bj < 2; ++bj) {
                        const int gc = (grp - 6) * 512 + cbase + bj * 128 + wc * 32 + fq * 8;
                        const f32x4 v0 = acc[ai][bj][m][0], v1 = acc[ai][bj][m][1];
                        st_nt16(p.gates + tok * 1024 + gc, make_uint4(pack2(v0[0], v0[1]), pack2(v0[2], v0[3]), pack2(v1[0], v1[1]), pack2(v1[2], v1[3])));
                    }
                }
        } else if (grp == 2 || grp == 5) {
            bf16_t* dst = p.qkv + (size_t)grp * HD;
#pragma unroll
            for (int ai = 0; ai < 2; ++ai)
#pragma unroll
                for (int m = 0; m < 4; ++m) {
                    const int s = s0 + ai * 128 + wr * 64 + m * 16 + fr;
#pragma unroll
                    for (int bj = 0; bj < 2; ++bj)
#pragma unroll
                        for (int n = 0; n < 2; ++n) {
                            const int colg = cbase + bj * 128 + wc * 32 + fq * 8 + n * 4;
                            const f32x4 v = acc[ai][bj][m][n];
                            bf16_t* d0 = dst + ((size_t)((b * 8 + (colg >> 6)) * 64 + (colg & 63))) * 4096 + s;
#pragma unroll
                            for (int j = 0; j < 4; ++j) d0[(size_t)j * 4096] = f2bf(v[j]);
                        }
                }
        } else {
            bf16_t* dst = p.qkv + (size_t)grp * HD;
            const float qsc = (grp == 0) ? 0.125f : (grp == 3) ? (0.125f * 1.4426950408889634f) : 1.0f;
#pragma unroll
            for (int ai = 0; ai < 2; ++ai)
#pragma unroll
                for (int m = 0; m < 4; ++m) {
                    const int s = s0 + ai * 128 + wr * 64 + m * 16 + fr;
#pragma unroll
                    for (int bj = 0; bj < 2; ++bj) {
                        const int colg = cbase + bj * 128 + wc * 32 + fq * 8;
                        const f32x4 v0 = acc[ai][bj][m][0], v1 = acc[ai][bj][m][1];
                        st_nt16(dst + ((size_t)((b * 8 + (colg >> 6)) * 4096 + s)) * 64 + (colg & 63),
                            make_uint4(pack2(v0[0] * qsc, v0[1] * qsc), pack2(v0[2] * qsc, v0[3] * qsc), pack2(v1[0] * qsc, v1[1] * qsc), pack2(v1[2] * qsc, v1[3] * qsc)));
                    }
                }
        }
    }
};

struct EpiRes {
    static constexpr bool PERM = false;
    const float* base; float* out; const float* gate;
    DEVI void operator()(f32x4 (&acc)[2][2][4][2], int brow, int bcol, int wr, int wc, int fr, int fq) const {
        const float* gt = gate + (brow >> 12) * 3072;
#pragma unroll
        for (int ai = 0; ai < 2; ++ai)
#pragma unroll
            for (int m = 0; m < 4; ++m) {
                const size_t row = (size_t)brow + ai * 128 + wr * 64 + m * 16 + fr;
#pragma unroll
                for (int bj = 0; bj < 2; ++bj)
#pragma unroll
                    for (int n = 0; n < 2; ++n) {
                        const int col = bcol + bj * 128 + wc * 32 + n * 16 + fq * 4;
                        const float4 bs = *(const float4*)(base + row * DM + col);
                        const float4 g = *(const float4*)(gt + col);
                        const f32x4 v = acc[ai][bj][m][n];
                        float4 o; o.x = bs.x + g.x * v[0]; o.y = bs.y + g.y * v[1]; o.z = bs.z + g.z * v[2]; o.w = bs.w + g.w * v[3];
                        *(float4*)(out + row * DM + col) = o;
                    }
            }
    }
};

template <bool BASE_BF16> struct EpiResP {
    static constexpr bool PERM = true;
    const void* base; bf16_t* outb; const float* gate;
    DEVI void operator()(f32x4 (&acc)[2][2][4][2], int brow, int bcol, int wr, int wc, int fr, int fq) const {
        const float* gt = gate + (brow >> 12) * 3072;
        float4 gv[2][2];
#pragma unroll
        for (int bj = 0; bj < 2; ++bj) { const int c0 = bcol + bj * 128 + wc * 32 + fq * 8; gv[bj][0] = *(const float4*)(gt + c0); gv[bj][1] = *(const float4*)(gt + c0 + 4); }
#pragma unroll
        for (int ai = 0; ai < 2; ++ai)
#pragma unroll
            for (int m = 0; m < 4; ++m) {
                const size_t row = (size_t)brow + ai * 128 + wr * 64 + m * 16 + fr;
#pragma unroll
                for (int bj = 0; bj < 2; ++bj) {
                    const int col = bcol + bj * 128 + wc * 32 + fq * 8;
                    float b[8];
                    if (BASE_BF16) bf8_to_f(*(const uint4*)((const bf16_t*)base + row * DM + col), b);
                    else { const float4 b0 = *(const float4*)((const float*)base + row * DM + col), b1 = *(const float4*)((const float*)base + row * DM + col + 4);
                           b[0] = b0.x; b[1] = b0.y; b[2] = b0.z; b[3] = b0.w; b[4] = b1.x; b[5] = b1.y; b[6] = b1.z; b[7] = b1.w; }
                    const float4 g0 = gv[bj][0], g1 = gv[bj][1];
                    const f32x4 v0 = acc[ai][bj][m][0], v1 = acc[ai][bj][m][1];
                    *(uint4*)(outb + row * DM + col) = make_uint4(pack2(b[0] + g0.x * v0[0], b[1] + g0.y * v0[1]), pack2(b[2] + g0.z * v0[2], b[3] + g0.w * v0[3]),
                                                                   pack2(b[4] + g1.x * v1[0], b[5] + g1.y * v1[1]), pack2(b[6] + g1.z * v1[2], b[7] + g1.w * v1[3]));
                }
            }
    }
};
struct Epi3P {
    static constexpr bool PERM = true;
    bf16_t *xb, *gl;
    DEVI void operator()(f32x4 (&acc)[2][2][4][2], int brow, int bcol, int wr, int wc, int fr, int fq) const {
        bf16_t* dst = (bcol < 1024) ? xb : gl; const int cb = bcol & 1023;
#pragma unroll
        for (int ai = 0; ai < 2; ++ai)
#pragma unroll
            for (int m = 0; m < 4; ++m) {
                const size_t row = (size_t)brow + ai * 128 + wr * 64 + m * 16 + fr;
#pragma unroll
                for (int bj = 0; bj < 2; ++bj) {
                    const int col = cb + bj * 128 + wc * 32 + fq * 8;
                    const f32x4 v0 = acc[ai][bj][m][0], v1 = acc[ai][bj][m][1];
                    st_nt16(dst + row * DM + col, make_uint4(pack2(v0[0], v0[1]), pack2(v0[2], v0[3]), pack2(v1[0], v1[1]), pack2(v1[2], v1[3])));
                }
            }
    }
};

template <bool BASE_BF16> struct EpiResB {   static constexpr bool PERM = false;
    const void* base; bf16_t* outb; const float* gate;
    DEVI void operator()(f32x4 (&acc)[2][2][4][2], int brow, int bcol, int wr, int wc, int fr, int fq) const {
        const float* gt = gate + (brow >> 12) * 3072;
#pragma unroll
        for (int ai = 0; ai < 2; ++ai)
#pragma unroll
            for (int m = 0; m < 4; ++m) {
                const size_t row = (size_t)brow + ai * 128 + wr * 64 + m * 16 + fr;
#pragma unroll
                for (int bj = 0; bj < 2; ++bj)
#pragma unroll
                    for (int n = 0; n < 2; ++n) {
                        const int col = bcol + bj * 128 + wc * 32 + n * 16 + fq * 4;
                        float b0, b1, b2, b3;
                        if (BASE_BF16) { const uint2 u = *(const uint2*)((const bf16_t*)base + row * DM + col);
                            b0 = __uint_as_float(u.x << 16); b1 = __uint_as_float(u.x & 0xffff0000u); b2 = __uint_as_float(u.y << 16); b3 = __uint_as_float(u.y & 0xffff0000u); }
                        else { const float4 bs = *(const float4*)((const float*)base + row * DM + col); b0 = bs.x; b1 = bs.y; b2 = bs.z; b3 = bs.w; }
                        const float4 g = *(const float4*)(gt + col);
                        const f32x4 v = acc[ai][bj][m][n];
                        *(uint2*)(outb + row * DM + col) = make_uint2(pack2(b0 + g.x * v[0], b1 + g.y * v[1]), pack2(b2 + g.z * v[2], b3 + g.w * v[3]));
                    }
            }
    }
};

struct Epi3 {   static constexpr bool PERM = false;
    bf16_t *xb, *gl;
    DEVI void operator()(f32x4 (&acc)[2][2][4][2], int brow, int bcol, int wr, int wc, int fr, int fq) const {
        bf16_t* dst = (bcol < 1024) ? xb : gl; const int cb = bcol & 1023;
#pragma unroll
        for (int ai = 0; ai < 2; ++ai)
#pragma unroll
            for (int m = 0; m < 4; ++m) {
                const size_t row = (size_t)brow + ai * 128 + wr * 64 + m * 16 + fr;
#pragma unroll
                for (int bj = 0; bj < 2; ++bj)
#pragma unroll
                    for (int n = 0; n < 2; ++n) {
                        const int col = cb + bj * 128 + wc * 32 + n * 16 + fq * 4;
                        const f32x4 v = acc[ai][bj][m][n];
                        *(uint2*)(dst + row * DM + col) = make_uint2(pack2(v[0], v[1]), pack2(v[2], v[3]));
                    }
            }
    }
};

constexpr float SB_EXIT = -40.0f;
DEVI void sb_tile(const bf16x8 (&kf)[2][2], const bf16x4 (&vlo)[4], const bf16x4 (&vhi)[4], const bf16x8 (&qf)[2], f32x4 (&o)[4], float& carry, const int k0, const int t, const int fq) {
    f32x4 st[2];
#pragma unroll
    for (int u2 = 0; u2 < 2; ++u2) {
        st[u2] = (f32x4){0.f, 0.f, 0.f, 0.f};
#pragma unroll
        for (int kk = 0; kk < 2; ++kk) st[u2] = __builtin_amdgcn_mfma_f32_16x16x32_bf16(kf[u2][kk], qf[kk], st[u2], 0, 0, 0);
    }
    float w[2][4];
#pragma unroll
    for (int u2 = 1; u2 >= 0; --u2) {
        float z[4], c[4]; bool valid[4];
#pragma unroll
        for (int j = 0; j < 4; ++j) {
            const int key = k0 + 16 * u2 + fq * 4 + j;
            z[j] = st[u2][j]; valid[j] = key < t;
            const float sp = fmaxf(z[j], 0.f) + 0.6931471805599453f * __builtin_amdgcn_logf(1.0f + __builtin_amdgcn_exp2f(-1.4426950408889634f * fabsf(z[j])));
            c[j] = valid[j] ? -sp : 0.f;
        }
        c[2] += c[3]; c[1] += c[2]; c[0] += c[1];
        const float T = c[0];
        const float a = T + sx16(T, fq);
        const float b2 = sx32(a, fq);
        const float above = ((fq & 1) ? 0.f : 1.f) * (a - T) + ((fq & 2) ? 0.f : 1.f) * b2;
        const float base = carry + above;
#pragma unroll
        for (int j = 0; j < 4; ++j) w[u2][j] = valid[j] ? __builtin_amdgcn_exp2f(1.4426950408889634f * (z[j] + base + c[j])) : 0.f;
        carry += a + b2;
    }
    bf16x8 pf;
    { const uint4 pu = make_uint4(pack2(w[0][0], w[0][1]), pack2(w[0][2], w[0][3]), pack2(w[1][0], w[1][1]), pack2(w[1][2], w[1][3])); pf = *(const bf16x8*)&pu; }
#pragma unroll
    for (int dt = 0; dt < 4; ++dt) {
        bf16x8 vf;
        vf[0] = vlo[dt][0]; vf[1] = vlo[dt][1]; vf[2] = vlo[dt][2]; vf[3] = vlo[dt][3];
        vf[4] = vhi[dt][0]; vf[5] = vhi[dt][1]; vf[6] = vhi[dt][2]; vf[7] = vhi[dt][3];
        o[dt] = __builtin_amdgcn_mfma_f32_16x16x32_bf16(vf, pf, o[dt], 0, 0, 0);
    }
}

DEVI void sb_tile2(const bf16x8 (&kf)[2][2], const bf16x4 (&vlo)[4], const bf16x4 (&vhi)[4], const bf16x8 (&qf)[2][2], f32x4 (&o)[4][2], float (&carry)[2], const int k0, const int tq0, const int fr, const int fq, const bool masked) {
    f32x4 st[2][2];
#pragma unroll
    for (int u2 = 0; u2 < 2; ++u2)
#pragma unroll
        for (int qt = 0; qt < 2; ++qt) st[u2][qt] = __builtin_amdgcn_mfma_f32_16x16x32_bf16(kf[u2][0], qf[qt][0], (f32x4){0.f, 0.f, 0.f, 0.f}, 0, 0, 0);
#pragma unroll
    for (int u2 = 0; u2 < 2; ++u2)
#pragma unroll
        for (int qt = 0; qt < 2; ++qt) st[u2][qt] = __builtin_amdgcn_mfma_f32_16x16x32_bf16(kf[u2][1], qf[qt][1], st[u2][qt], 0, 0, 0);
    float c[2][2][4]; bool valid[2][2][4];
#pragma unroll
    for (int u2 = 0; u2 < 2; ++u2)
#pragma unroll
        for (int qt = 0; qt < 2; ++qt)
#pragma unroll
            for (int j = 0; j < 4; ++j) {
                const float z = st[u2][qt][j];
                const float sp = fmaxf(z, 0.f) + 0.6931471805599453f * __builtin_amdgcn_logf(1.0f + __builtin_amdgcn_exp2f(-1.4426950408889634f * fabsf(z)));
                valid[u2][qt][j] = masked ? ((k0 + 16 * u2 + fq * 4 + j) < (tq0 + qt * 16 + fr)) : true;
                c[u2][qt][j] = valid[u2][qt][j] ? -sp : 0.f;
            }
#pragma unroll
    for (int u2 = 0; u2 < 2; ++u2)
#pragma unroll
        for (int qt = 0; qt < 2; ++qt) { c[u2][qt][2] += c[u2][qt][3]; c[u2][qt][1] += c[u2][qt][2]; c[u2][qt][0] += c[u2][qt][1]; }
    float a[2][2], b2[2][2];
#pragma unroll
    for (int u2 = 0; u2 < 2; ++u2)
#pragma unroll
        for (int qt = 0; qt < 2; ++qt) a[u2][qt] = c[u2][qt][0] + sx16(c[u2][qt][0], fq);
#pragma unroll
    for (int u2 = 0; u2 < 2; ++u2)
#pragma unroll
        for (int qt = 0; qt < 2; ++qt) b2[u2][qt] = sx32(a[u2][qt], fq);
    const float m1 = (fq & 1) ? 0.f : 1.f, m2 = (fq & 2) ? 0.f : 1.f;
    float w[2][2][4];
#pragma unroll
    for (int qt = 0; qt < 2; ++qt) {
        const float tot1 = a[1][qt] + b2[1][qt], tot0 = a[0][qt] + b2[0][qt];
        const float base1 = carry[qt] + m1 * (a[1][qt] - c[1][qt][0]) + m2 * b2[1][qt];
        const float base0 = carry[qt] + tot1 + m1 * (a[0][qt] - c[0][qt][0]) + m2 * b2[0][qt];
#pragma unroll
        for (int j = 0; j < 4; ++j) {
            const float e1 = __builtin_amdgcn_exp2f(1.4426950408889634f * (st[1][qt][j] + base1 + c[1][qt][j]));
            const float e0 = __builtin_amdgcn_exp2f(1.4426950408889634f * (st[0][qt][j] + base0 + c[0][qt][j]));
            w[1][qt][j] = valid[1][qt][j] ? e1 : 0.f; w[0][qt][j] = valid[0][qt][j] ? e0 : 0.f;
        }
        carry[qt] += tot1 + tot0;
    }
    bf16x8 pf[2];
#pragma unroll
    for (int qt = 0; qt < 2; ++qt) {
        const uint4 pu = make_uint4(pack2(w[0][qt][0], w[0][qt][1]), pack2(w[0][qt][2], w[0][qt][3]), pack2(w[1][qt][0], w[1][qt][1]), pack2(w[1][qt][2], w[1][qt][3]));
        pf[qt] = *(const bf16x8*)&pu;
    }
#pragma unroll
    for (int dt = 0; dt < 4; ++dt) {
        bf16x8 vf;
        vf[0] = vlo[dt][0]; vf[1] = vlo[dt][1]; vf[2] = vlo[dt][2]; vf[3] = vlo[dt][3];
        vf[4] = vhi[dt][0]; vf[5] = vhi[dt][1]; vf[6] = vhi[dt][2]; vf[7] = vhi[dt][3];
        o[dt][0] = __builtin_amdgcn_mfma_f32_16x16x32_bf16(vf, pf[0], o[dt][0], 0, 0, 0);
        o[dt][1] = __builtin_amdgcn_mfma_f32_16x16x32_bf16(vf, pf[1], o[dt][1], 0, 0, 0);
    }
}

DEVI void sb_phase(const Params& p, char* smem) {
    bf16_t* Ks = (bf16_t*)smem;
    bf16_t* Vs = (bf16_t*)(smem + 55296);
    const int tid = threadIdx.x, wave = tid >> 6, lane = tid & 63, fr = lane & 15, fq = lane >> 4;
    uint4 kq0, kq1, kq2, kq3, kq4, kq5, vq0, vq1, vq2, vq3, vq4, vq5;
#define SB_KG(q_) ((kb_ + ((tid + (q_) * 512) >> 3)) >= 0 ? *(const uint4*)(Kp_ + (size_t)(kb_ + ((tid + (q_) * 512) >> 3)) * 64 + ((tid + (q_) * 512) & 7) * 8) : make_uint4(0, 0, 0, 0))
#define SB_VG(q_) ((kb_ + ((tid + (q_) * 512) % 48) * 8) >= 0 ? *(const uint4*)(Vt_ + (size_t)((tid + (q_) * 512) / 48) * 4096 + kb_ + ((tid + (q_) * 512) % 48) * 8) : make_uint4(0, 0, 0, 0))
#define SB_LOAD(u_) do { const int bh_ = (u_) >> 4, kb_ = ((u_) & 15) * 256 - 128; \
        const bf16_t* Kp_ = p.ka + (size_t)bh_ * 4096 * 64; const bf16_t* Vt_ = p.vta + (size_t)bh_ * 64 * 4096; \
        kq0 = SB_KG(0); kq1 = SB_KG(1); kq2 = SB_KG(2); kq3 = SB_KG(3); kq4 = SB_KG(4); kq5 = SB_KG(5); \
        vq0 = SB_VG(0); vq1 = SB_VG(1); vq2 = SB_VG(2); vq3 = SB_VG(3); vq4 = SB_VG(4); vq5 = SB_VG(5); } while (0)
#define SB_KS(q_) (*(uint4*)(Ks + ((tid + (q_) * 512) >> 3) * 72 + ((tid + (q_) * 512) & 7) * 8))
#define SB_VS(q_) (*(uint4*)(Vs + ((tid + (q_) * 512) / 48) * 392 + ((tid + (q_) * 512) % 48) * 8))
    int u = blockIdx.x;
    { const int u0 = u < 2048 ? u : 0; SB_LOAD(u0); }
    for (; u < 2048; u += gridDim.x) {
        const int bh = u >> 4, t0 = (u & 15) * 256, kbase = t0 - 128;
        __syncthreads();
        SB_KS(0) = kq0; SB_KS(1) = kq1; SB_KS(2) = kq2; SB_KS(3) = kq3; SB_KS(4) = kq4; SB_KS(5) = kq5;
        SB_VS(0) = vq0; SB_VS(1) = vq1; SB_VS(2) = vq2; SB_VS(3) = vq3; SB_VS(4) = vq4; SB_VS(5) = vq5;
        __syncthreads();
        { const int un = (u + (int)gridDim.x < 2048) ? u + (int)gridDim.x : u; SB_LOAD(un); }
        const int q0 = t0 + wave * 32;
        const bf16_t* Q = p.qa + (size_t)bh * 4096 * 64;
        bf16x8 qf[2][2];
#pragma unroll
        for (int qt = 0; qt < 2; ++qt)
#pragma unroll
            for (int kk = 0; kk < 2; ++kk) qf[qt][kk] = *(const bf16x8*)(Q + (size_t)(q0 + qt * 16 + fr) * 64 + kk * 32 + fq * 8);
        f32x4 o[4][2];
#pragma unroll
        for (int dt = 0; dt < 4; ++dt) { o[dt][0] = (f32x4){0.f, 0.f, 0.f, 0.f}; o[dt][1] = (f32x4){0.f, 0.f, 0.f, 0.f}; }
        float carry[2] = {0.f, 0.f};
        const int lo = kbase > 0 ? kbase : 0;
        bool done = false;
        for (int k0 = q0; k0 >= lo; k0 -= 32) {
            const int kl = k0 - kbase;
            bf16x8 kf[2][2]; bf16x4 vlo[4], vhi[4];
#pragma unroll
            for (int u2 = 0; u2 < 2; ++u2)
#pragma unroll
                for (int kk = 0; kk < 2; ++kk) kf[u2][kk] = *(const bf16x8*)(Ks + (kl + 16 * u2 + fr) * 72 + kk * 32 + fq * 8);
#pragma unroll
            for (int dt = 0; dt < 4; ++dt) {
                vlo[dt] = *(const bf16x4*)(Vs + (dt * 16 + fr) * 392 + kl + fq * 4);
                vhi[dt] = *(const bf16x4*)(Vs + (dt * 16 + fr) * 392 + kl + 16 + fq * 4);
            }
            sb_tile2(kf, vlo, vhi, qf, o, carry, k0, q0, fr, fq, k0 == q0);
            if (__all(carry[0] < SB_EXIT && carry[1] < SB_EXIT)) { done = true; break; }
        }
        if (!done && lo > 0) {
            const bf16_t* Kp = p.ka + (size_t)bh * 4096 * 64;
            const bf16_t* Vt = p.vta + (size_t)bh * 64 * 4096;
            for (int k0 = lo - 32; k0 >= 0; k0 -= 32) {
                bf16x8 kf[2][2]; bf16x4 vlo[4], vhi[4];
#pragma unroll
                for (int u2 = 0; u2 < 2; ++u2)
#pragma unroll
                    for (int kk = 0; kk < 2; ++kk) kf[u2][kk] = *(const bf16x8*)(Kp + (size_t)(k0 + 16 * u2 + fr) * 64 + kk * 32 + fq * 8);
#pragma unroll
                for (int dt = 0; dt < 4; ++dt) {
                    vlo[dt] = *(const bf16x4*)(Vt + (size_t)(dt * 16 + fr) * 4096 + k0 + fq * 4);
                    vhi[dt] = *(const bf16x4*)(Vt + (size_t)(dt * 16 + fr) * 4096 + k0 + 16 + fq * 4);
                }
                sb_tile2(kf, vlo, vhi, qf, o, carry, k0, q0, fr, fq, false);
                if (__all(carry[0] < SB_EXIT && carry[1] < SB_EXIT)) break;
            }
        }
        const int hcol = (bh & 7) * 64;
#pragma unroll
        for (int qt = 0; qt < 2; ++qt) {
            const size_t tok = (size_t)(bh >> 3) * 4096 + q0 + qt * 16 + fr;
#pragma unroll
            for (int dt = 0; dt < 4; ++dt) {
                const int dh = dt * 16 + fq * 4;
                const uint2 gu = *(const uint2*)(p.gates + tok * 1024 + hcol + dh);
                const float g0 = bf2f((bf16_t)(gu.x & 0xffff)), g1 = bf2f((bf16_t)(gu.x >> 16)), g2 = bf2f((bf16_t)(gu.y & 0xffff)), g3 = bf2f((bf16_t)(gu.y >> 16));
                const float y0 = o[dt][qt][0] * g0 * sigmoidf_(g0), y1 = o[dt][qt][1] * g1 * sigmoidf_(g1), y2 = o[dt][qt][2] * g2 * sigmoidf_(g2), y3 = o[dt][qt][3] * g3 * sigmoidf_(g3);
                *(uint2*)(p.ypre + tok * 1024 + hcol + dh) = make_uint2(pack2(y0, y1), pack2(y2, y3));
            }
        }
    }
#undef SB_LOAD
#undef SB_KG
#undef SB_VG
#undef SB_KS
#undef SB_VS
}

constexpr float SM_C = 0.125f * 1.4426950408889634f;
constexpr int LCAP = 4096;

DEVI void moba_select_phase(const Params& p, char* smem) {
    float* km = (float*)smem;
    const int tid = threadIdx.x, wave = tid >> 6, lane = tid & 63;
    for (int w = blockIdx.x; w < 256; w += gridDim.x) {
        const int bh = w >> 1, hf = w & 1;
        __syncthreads();
        for (int i = tid; i < 1024; i += 512) km[i] = p.kmean[(size_t)bh * 1024 + i];
        __syncthreads();
        bf16x8 qv[8];
        { const bf16_t* qrow = p.qb + ((size_t)bh * 4096 + wave * 256 + hf * 128 + (lane & 31)) * 64;
#pragma unroll
          for (int c = 0; c < 8; ++c) qv[c] = *(const bf16x8*)(qrow + c * 8); }
#pragma unroll 1
        for (int ws8 = 0; ws8 < 8; ++ws8) {
            const int qb = (ws8 < 4) ? wave : 15 - wave;
            const int q = qb * 256 + (hf * 4 + (ws8 & 3)) * 32 + (lane & 31);
            bf16x8 qn[8];
            { const int wn = ws8 < 7 ? ws8 + 1 : ws8; const int qbn = (wn < 4) ? wave : 15 - wave;
              const bf16_t* qrow = p.qb + ((size_t)bh * 4096 + qbn * 256 + (hf * 4 + (wn & 3)) * 32 + (lane & 31)) * 64;
#pragma unroll
              for (int c = 0; c < 8; ++c) qn[c] = *(const bf16x8*)(qrow + c * 8); }
            float b0 = -INFINITY, b1 = -INFINITY, b2 = -INFINITY; int i0 = -1, i1 = -1, i2 = -1;
            for (int n = 0; n < qb; ++n) {
                float s = 0.f;
#pragma unroll
                for (int c = 0; c < 8; ++c) {
                    const f32x4 k0 = *(const f32x4*)(km + n * 64 + c * 8), k1 = *(const f32x4*)(km + n * 64 + c * 8 + 4);
                    s += bfs2f(qv[c][0]) * k0[0]; s += bfs2f(qv[c][1]) * k0[1]; s += bfs2f(qv[c][2]) * k0[2]; s += bfs2f(qv[c][3]) * k0[3];
                    s += bfs2f(qv[c][4]) * k1[0]; s += bfs2f(qv[c][5]) * k1[1]; s += bfs2f(qv[c][6]) * k1[2]; s += bfs2f(qv[c][7]) * k1[3];
                }
                if (s > b0) { b2 = b1; i2 = i1; b1 = b0; i1 = i0; b0 = s; i0 = n; }
                else if (s > b1) { b2 = b1; i2 = i1; b1 = s; i1 = n; }
                else if (s > b2) { b2 = s; i2 = n; }
            }
            for (int n = 0; n < qb; ++n) {
                const bool pred = (lane < 32) && (i0 == n || i1 == n || i2 == n);
                const unsigned long long mask = __ballot(pred);
                if (mask == 0ull) continue;
                const int leader = __ffsll((long long)mask) - 1;
                int base = 0;
                if (lane == leader) base = atomicAdd(p.mcnt + bh * 16 + n, __popcll(mask));
                base = __shfl(base, leader);
                if (pred) {
                    const int pos = base + __popcll(mask & ((1ull << lane) - 1ull));
                    const int j = (i0 == n) ? 0 : (i1 == n) ? 1 : 2;
                    __hip_atomic_store(p.mlist + (size_t)(bh * 16 + n) * LCAP + pos, (unsigned short)(q | (j << 12)), __ATOMIC_RELAXED, __HIP_MEMORY_SCOPE_AGENT);
                }
            }
#pragma unroll
            for (int c = 0; c < 8; ++c) qv[c] = qn[c];
        }
    }
}

template <bool MASK>
DEVI void moba_subtile(const bf16_t* Kt  , const bf16_t* Vt  , const int vstr,
                       const bf16x8 (&qf)[2][2], f32x4 (&o)[4][2], float (&mrun)[2], float (&lrun)[2], const int kl0, const int ql0, const int fr, const int fq) {
    f32x4 st[4][2];
#pragma unroll
    for (int kt = 0; kt < 4; ++kt) {
        st[kt][0] = (f32x4){0.f, 0.f, 0.f, 0.f}; st[kt][1] = (f32x4){0.f, 0.f, 0.f, 0.f};
#pragma unroll
        for (int kk = 0; kk < 2; ++kk) {
            const bf16x8 kf = *(const bf16x8*)(Kt + (kt * 16 + fr) * 72 + kk * 32 + fq * 8);
            st[kt][0] = __builtin_amdgcn_mfma_f32_16x16x32_bf16(kf, qf[0][kk], st[kt][0], 0, 0, 0);
            st[kt][1] = __builtin_amdgcn_mfma_f32_16x16x32_bf16(kf, qf[1][kk], st[kt][1], 0, 0, 0);
        }
    }
    bf16x8 pf[2][2];
    float sv[2][4][4], tmax[2], mnew[2], alpha[2], psum[2];
#pragma unroll
    for (int qt = 0; qt < 2; ++qt) {
        const int ql = ql0 + qt * 16 + fr;
        tmax[qt] = -1e30f;
#pragma unroll
        for (int kt = 0; kt < 4; ++kt)
#pragma unroll
            for (int j = 0; j < 4; ++j) {
                float v = st[kt][qt][j];
                if (MASK) { const int kl = kl0 + kt * 16 + fq * 4 + j; v = (kl <= ql) ? v : -1e30f; }
                sv[qt][kt][j] = v; tmax[qt] = fmaxf(tmax[qt], v);
            }
    }
#pragma unroll
    for (int qt = 0; qt < 2; ++qt) tmax[qt] = fmaxf(tmax[qt], sx16(tmax[qt], fq));
#pragma unroll
    for (int qt = 0; qt < 2; ++qt) tmax[qt] = fmaxf(tmax[qt], sx32(tmax[qt], fq));
#pragma unroll
    for (int qt = 0; qt < 2; ++qt) { mnew[qt] = fmaxf(mrun[qt], tmax[qt]); alpha[qt] = __builtin_amdgcn_exp2f(mrun[qt] - mnew[qt]); mrun[qt] = mnew[qt]; psum[qt] = 0.f; }
#pragma unroll
    for (int kt = 0; kt < 4; ++kt)
#pragma unroll
        for (int j = 0; j < 4; ++j)
#pragma unroll
            for (int qt = 0; qt < 2; ++qt) {
                float pv = __builtin_amdgcn_exp2f(sv[qt][kt][j] - mnew[qt]);
                if (MASK) pv = (sv[qt][kt][j] > -1e29f) ? pv : 0.f;
                sv[qt][kt][j] = pv; psum[qt] += pv;
            }
#pragma unroll
    for (int qt = 0; qt < 2; ++qt) psum[qt] += sx16(psum[qt], fq);
#pragma unroll
    for (int qt = 0; qt < 2; ++qt) psum[qt] += sx32(psum[qt], fq);
#pragma unroll
    for (int qt = 0; qt < 2; ++qt) {
        lrun[qt] = lrun[qt] * alpha[qt] + psum[qt];
#pragma unroll
        for (int dt = 0; dt < 4; ++dt) o[dt][qt] *= alpha[qt];
#pragma unroll
        for (int kk2 = 0; kk2 < 2; ++kk2) {
            const uint4 pu = make_uint4(pack2(sv[qt][2 * kk2][0], sv[qt][2 * kk2][1]), pack2(sv[qt][2 * kk2][2], sv[qt][2 * kk2][3]),
                                        pack2(sv[qt][2 * kk2 + 1][0], sv[qt][2 * kk2 + 1][1]), pack2(sv[qt][2 * kk2 + 1][2], sv[qt][2 * kk2 + 1][3]));
            pf[kk2][qt] = *(const bf16x8*)&pu;
        }
    }
#pragma unroll
    for (int dt = 0; dt < 4; ++dt)
#pragma unroll
        for (int kk2 = 0; kk2 < 2; ++kk2) {
            const uint2 lo = *(const uint2*)(Vt + (dt * 16 + fr) * vstr + kk2 * 32 + fq * 4);
            const uint2 hi = *(const uint2*)(Vt + (dt * 16 + fr) * vstr + kk2 * 32 + 16 + fq * 4);
            const uint4 vu = make_uint4(lo.x, lo.y, hi.x, hi.y);
            const bf16x8 vf = *(const bf16x8*)&vu;
            o[dt][0] = __builtin_amdgcn_mfma_f32_16x16x32_bf16(vf, pf[kk2][0], o[dt][0], 0, 0, 0);
            o[dt][1] = __builtin_amdgcn_mfma_f32_16x16x32_bf16(vf, pf[kk2][1], o[dt][1], 0, 0, 0);
        }
}

DEVI void moba_past_item(const Params& p, const int bh, const int n, char* smem) {
    bf16_t* Ks = (bf16_t*)smem;
    bf16_t* Vs = (bf16_t*)(smem + 36864);
    const int tid = threadIdx.x, wave = tid >> 6, lane = tid & 63, fr = lane & 15, fq = lane >> 4;
    const bf16_t* Qg = p.qb + (size_t)bh * 4096 * 64;
    const bf16_t* Kg = p.kb + ((size_t)bh * 4096 + (size_t)n * 256) * 64;
    const bf16_t* Vtg = p.vtb + (size_t)bh * 64 * 4096 + n * 256;
    __syncthreads();
#pragma unroll
    for (int q = 0; q < 4; ++q) {
        const int i = tid + q * 512;
        *(uint4*)(Ks + (i >> 3) * 72 + (i & 7) * 8) = *(const uint4*)(Kg + (size_t)(i >> 3) * 64 + (i & 7) * 8);
        *(uint4*)(Vs + (i >> 5) * 264 + (i & 31) * 8) = *(const uint4*)(Vtg + (size_t)(i >> 5) * 4096 + (i & 31) * 8);
    }
    __syncthreads();
    const int cnt = p.mcnt[bh * 16 + n];
    const unsigned short* lst = p.mlist + (size_t)(bh * 16 + n) * LCAP;
    const int ngroups = (cnt + 31) >> 5;
    int qidx[2], slot[2]; bool valid[2];
    bf16x8 qf[2][2];
#define D2_FETCH(g_) do { _Pragma("unroll") for (int qt = 0; qt < 2; ++qt) { const int idx = (g_) * 32 + qt * 16 + fr; valid[qt] = idx < cnt; \
        const unsigned e = lst[valid[qt] ? idx : 0]; qidx[qt] = e & 4095; slot[qt] = e >> 12; \
        _Pragma("unroll") for (int kk = 0; kk < 2; ++kk) qf[qt][kk] = *(const bf16x8*)(Qg + (size_t)qidx[qt] * 64 + kk * 32 + fq * 8); } } while (0)
    if (wave < ngroups) D2_FETCH(wave);
    for (int g = wave; g < ngroups; g += 8) {
        int cq[2], cs[2]; bool cv[2]; bf16x8 cf[2][2];
#pragma unroll
        for (int qt = 0; qt < 2; ++qt) { cq[qt] = qidx[qt]; cs[qt] = slot[qt]; cv[qt] = valid[qt]; cf[qt][0] = qf[qt][0]; cf[qt][1] = qf[qt][1]; }
        { const int gn = (g + 8 < ngroups) ? g + 8 : g; D2_FETCH(gn); }
        f32x4 o[4][2];
#pragma unroll
        for (int dt = 0; dt < 4; ++dt) { o[dt][0] = (f32x4){0.f, 0.f, 0.f, 0.f}; o[dt][1] = (f32x4){0.f, 0.f, 0.f, 0.f}; }
        float mrun[2] = {-1e30f, -1e30f}, lrun[2] = {0.f, 0.f};
#pragma unroll 1
        for (int jt = 0; jt < 4; ++jt)
            moba_subtile<false>(Ks + jt * 64 * 72, Vs + jt * 64, 264, cf, o, mrun, lrun, 0, 0, fr, fq);
#pragma unroll
        for (int qt = 0; qt < 2; ++qt) {
            if (cv[qt]) {
                const size_t pair = ((size_t)bh * 4096 + cq[qt]) * 3 + cs[qt];
                const float linv = __builtin_amdgcn_rcpf(lrun[qt]);
#pragma unroll
                for (int dt = 0; dt < 4; ++dt) {
                    const f32x4 v = o[dt][qt];
                    *(uint2*)(p.part_o + pair * 64 + dt * 16 + fq * 4) = make_uint2(pack2(v[0] * linv, v[1] * linv), pack2(v[2] * linv, v[3] * linv));
                }
                if (fq == 0) __hip_atomic_store((unsigned long long*)(p.part_ml + pair * 2), ((unsigned long long)__float_as_uint(lrun[qt]) << 32) | (unsigned long long)__float_as_uint(mrun[qt]), __ATOMIC_RELAXED, __HIP_MEMORY_SCOPE_AGENT);
            }
        }
    }
#undef D2_FETCH
}

DEVI void moba_past_phase(const Params& p, char* smem) {
    for (int w = blockIdx.x; w < 256; w += gridDim.x) {
        const int bh = w >> 1, set = w & 1;
#pragma unroll 1
        for (int n = 0; n < 15; ++n) {
            const int inA = (n == 0) | (n == 3) | (n == 4) | (n == 7) | (n == 8) | (n == 11) | (n == 12);
            if (inA == set) continue;
            moba_past_item(p, bh, n, smem);
        }
    }
}

DEVI void moba_own_item(const Params& p, const int bh, const int qb, char* smem) {
    bf16_t* Ks = (bf16_t*)smem;
    bf16_t* Vs = (bf16_t*)(smem + 36864);
    const int tid = threadIdx.x, wave = tid >> 6, lane = tid & 63, fr = lane & 15, fq = lane >> 4;
    const bf16_t* Qg = p.qb + ((size_t)bh * 4096 + (size_t)qb * 256) * 64;
    const bf16_t* Kg = p.kb + ((size_t)bh * 4096 + (size_t)qb * 256) * 64;
    const bf16_t* Vtg = p.vtb + (size_t)bh * 64 * 4096 + qb * 256;
#define OWN_K(q_) (*(const uint4*)(Kg + (size_t)((tid + (q_) * 512) >> 3) * 64 + ((tid + (q_) * 512) & 7) * 8))
#define OWN_V(q_) (*(const uint4*)(Vtg + (size_t)((tid + (q_) * 512) >> 5) * 4096 + ((tid + (q_) * 512) & 31) * 8))
    const uint4 kq0 = OWN_K(0), kq1 = OWN_K(1), kq2 = OWN_K(2), kq3 = OWN_K(3);
    const uint4 vq0 = OWN_V(0), vq1 = OWN_V(1), vq2 = OWN_V(2), vq3 = OWN_V(3);
#undef OWN_K
#undef OWN_V
    bf16x8 qf[2][2];
#pragma unroll
    for (int qt = 0; qt < 2; ++qt)
#pragma unroll
        for (int kk = 0; kk < 2; ++kk) qf[qt][kk] = *(const bf16x8*)(Qg + (size_t)(wave * 32 + qt * 16 + fr) * 64 + kk * 32 + fq * 8);
    f32x4 o[4][2];
#pragma unroll
    for (int dt = 0; dt < 4; ++dt) { o[dt][0] = (f32x4){0.f, 0.f, 0.f, 0.f}; o[dt][1] = (f32x4){0.f, 0.f, 0.f, 0.f}; }
    float mrun[2] = {-1e30f, -1e30f}, lrun[2] = {0.f, 0.f};
    const int hcol = 512 + (bh & 7) * 64;
    const int nsel = qb < 3 ? qb : 3;
    float2 pml[2][3]; uint2 po[2][3][4];
#pragma unroll
    for (int qt = 0; qt < 2; ++qt) {
        const int qs = qb * 256 + wave * 32 + qt * 16 + fr;
#pragma unroll
        for (int j = 0; j < 3; ++j) {
            const size_t pair = ((size_t)bh * 4096 + qs) * 3 + j;
            pml[qt][j] = make_float2(-1e30f, 0.f);
#pragma unroll
            for (int dt = 0; dt < 4; ++dt) po[qt][j][dt] = make_uint2(0u, 0u);
            if (j < nsel) {
                pml[qt][j] = *(const float2*)(p.part_ml + pair * 2);
#pragma unroll
                for (int dt = 0; dt < 4; ++dt) po[qt][j][dt] = *(const uint2*)(p.part_o + pair * 64 + dt * 16 + fq * 4);
            }
        }
    }
    __syncthreads();
#define OWN_KS(q_) (*(uint4*)(Ks + ((tid + (q_) * 512) >> 3) * 72 + ((tid + (q_) * 512) & 7) * 8))
#define OWN_VS(q_) (*(uint4*)(Vs + ((tid + (q_) * 512) >> 5) * 264 + ((tid + (q_) * 512) & 31) * 8))
    OWN_KS(0) = kq0; OWN_KS(1) = kq1; OWN_KS(2) = kq2; OWN_KS(3) = kq3;
    OWN_VS(0) = vq0; OWN_VS(1) = vq1; OWN_VS(2) = vq2; OWN_VS(3) = vq3;
#undef OWN_KS
#undef OWN_VS
    __syncthreads();
#pragma unroll 1
    for (int jt = 0; jt < 4; ++jt) {
        if (jt * 64 + 63 <= wave * 32)        moba_subtile<false>(Ks + jt * 64 * 72, Vs + jt * 64, 264, qf, o, mrun, lrun, 0, 0, fr, fq);
        else if (jt * 64 <= wave * 32 + 31)   moba_subtile<true>(Ks + jt * 64 * 72, Vs + jt * 64, 264, qf, o, mrun, lrun, jt * 64, wave * 32, fr, fq);
    }
#pragma unroll
    for (int qt = 0; qt < 2; ++qt) {
        float m = mrun[qt], l = lrun[qt];
        f32x4 acc[4];
#pragma unroll
        for (int dt = 0; dt < 4; ++dt) acc[dt] = o[dt][qt];
#pragma unroll
        for (int j = 0; j < 3; ++j) {
            const float2 ml = pml[qt][j];
            const float M = fmaxf(m, ml.x);
            const float wo = __builtin_amdgcn_exp2f(m - M), wj = ml.y * __builtin_amdgcn_exp2f(ml.x - M);
#pragma unroll
            for (int dt = 0; dt < 4; ++dt) {
                const uint2 ou = po[qt][j][dt];
                acc[dt][0] = acc[dt][0] * wo + wj * bf2f((bf16_t)(ou.x & 0xffff)); acc[dt][1] = acc[dt][1] * wo + wj * bf2f((bf16_t)(ou.x >> 16));
                acc[dt][2] = acc[dt][2] * wo + wj * bf2f((bf16_t)(ou.y & 0xffff)); acc[dt][3] = acc[dt][3] * wo + wj * bf2f((bf16_t)(ou.y >> 16));
            }
            l = l * wo + wj; m = M;
        }
        const float linv = __builtin_amdgcn_rcpf(l);
        const size_t tok = (size_t)(bh >> 3) * 4096 + qb * 256 + wave * 32 + qt * 16 + fr;
#pragma unroll
        for (int dt = 0; dt < 4; ++dt) {
            const int dh = dt * 16 + fq * 4;
            const uint2 gu = *(const uint2*)(p.gates + tok * 1024 + hcol + dh);
            const float g0 = bf2f((bf16_t)(gu.x & 0xffff)), g1 = bf2f((bf16_t)(gu.x >> 16)), g2 = bf2f((bf16_t)(gu.y & 0xffff)), g3 = bf2f((bf16_t)(gu.y >> 16));
            const float y0 = acc[dt][0] * linv * g0 * sigmoidf_(g0), y1 = acc[dt][1] * linv * g1 * sigmoidf_(g1);
            const float y2 = acc[dt][2] * linv * g2 * sigmoidf_(g2), y3 = acc[dt][3] * linv * g3 * sigmoidf_(g3);
            *(uint2*)(p.ypre + tok * 1024 + hcol + dh) = make_uint2(pack2(y0, y1), pack2(y2, y3));
        }
    }
}

DEVI void moba_own_phase(const Params& p, char* smem) {
    for (int it = blockIdx.x; it < 2048; it += gridDim.x) moba_own_item(p, it >> 4, it & 15, smem);
}

DEVI void lru_item(const Params& p, const int item, char* smem) {
    const int b = item >> 4, n = (item >> 1) & 7, half = item & 1;
    const int tid = threadIdx.x, wave = tid >> 6, lane = tid & 63, fr = lane & 15, fq = lane >> 4;
    bf16_t* xs = (bf16_t*)smem;
    bf16_t* wa = (bf16_t*)(smem + 35840);
    bf16_t* wx = (bf16_t*)(smem + 35840 + 17408);
    float* cw = (float*)(smem + 70656);
    float* agg = cw + 640;
    float* xcw = (float*)(smem + 81408) + wave * (16 * 68);
    bf16_t* gs = (bf16_t*)(smem + 81408 + 8 * 16 * 68 * 4);
    __syncthreads();
    for (int i = tid; i < 64 * 16; i += 512) {
        const int r = i >> 4, c = i & 15;
        *(uint4*)(wa + r * 136 + c * 8) = *(const uint4*)(p.wa_t + ((size_t)(n * 128 + half * 64 + r)) * 128 + c * 8);
        *(uint4*)(wx + r * 136 + c * 8) = *(const uint4*)(p.wx_t + ((size_t)(n * 128 + half * 64 + r)) * 128 + c * 8);
    }
    cw[tid] = p.lru_conv_w[(tid >> 7) * 1024 + n * 128 + (tid & 127)];
    if (tid < 128) cw[512 + tid] = p.lru_conv_b[n * 128 + tid];
    float ba[4], bx[4], lsl[4], hstart[4];
#pragma unroll
    for (int ct = 0; ct < 4; ++ct) {
        const int C = n * 128 + half * 64 + ct * 16 + fr;
        ba[ct] = p.lru_b_a[C]; bx[ct] = p.lru_b_x[C];
        const float lam = p.lru_lambda[C];
        lsl[ct] = -8.0f * (fmaxf(-lam, 0.f) + log1pf(expf(-fabsf(lam))));
        hstart[ct] = 0.f;
    }
    const bf16_t* xbase = p.xb + ((size_t)b * 4096) * 1024 + n * 128;
    const bf16_t* gbase = p.gl + ((size_t)b * 4096) * 1024 + n * 128 + half * 64;
    uint4 xr[5], gr0, gr1;
#define LRU_LOAD(t0_) do { \
        _Pragma("unroll") for (int q = 0; q < 5; ++q) { const int i = tid + q * 512; const int r = i >> 4, c = i & 15; const int t = (t0_) - 3 + r; \
            xr[q] = make_uint4(0, 0, 0, 0); if (i < 131 * 16 && t >= 0) xr[q] = *(const uint4*)(xbase + (size_t)t * 1024 + c * 8); } \
        gr0 = *(const uint4*)(gbase + (size_t)((t0_) + (tid >> 3)) * 1024 + (tid & 7) * 8); \
        gr1 = *(const uint4*)(gbase + (size_t)((t0_) + 64 + (tid >> 3)) * 1024 + (tid & 7) * 8); } while (0)
#define LRU_STORE() do { \
        _Pragma("unroll") for (int q = 0; q < 5; ++q) { const int i = tid + q * 512; const int r = i >> 4, c = i & 15; if (i < 131 * 16) *(uint4*)(xs + r * 136 + c * 8) = xr[q]; } \
        *(uint4*)(gs + (tid >> 3) * 72 + (tid & 7) * 8) = gr0; *(uint4*)(gs + (64 + (tid >> 3)) * 72 + (tid & 7) * 8) = gr1; } while (0)
    LRU_LOAD(0);
    LRU_STORE();
    __syncthreads();
    int par = 0;
    for (int ch = 0; ch < 32; ++ch) {
        const int t0 = ch * 128;
        { const int tn = (ch + 1 < 32) ? t0 + 128 : t0; LRU_LOAD(tn); }
        f32x4 ar[4], ax[4];
#pragma unroll
        for (int ct = 0; ct < 4; ++ct) { ar[ct] = (f32x4){0.f, 0.f, 0.f, 0.f}; ax[ct] = (f32x4){0.f, 0.f, 0.f, 0.f}; }
#pragma unroll
        for (int kk = 0; kk < 4; ++kk) {
            const int c0 = kk * 32 + fq * 8;
            float xcv[8];
            { const f32x4 b0 = *(const f32x4*)(cw + 512 + c0), b1 = *(const f32x4*)(cw + 512 + c0 + 4);
              xcv[0] = b0[0]; xcv[1] = b0[1]; xcv[2] = b0[2]; xcv[3] = b0[3]; xcv[4] = b1[0]; xcv[5] = b1[1]; xcv[6] = b1[2]; xcv[7] = b1[3]; }
#pragma unroll
            for (int tap = 0; tap < 4; ++tap) {
                const bf16x8 xv = *(const bf16x8*)(xs + (wave * 16 + fr + tap) * 136 + c0);
                const f32x4 w0 = *(const f32x4*)(cw + tap * 128 + c0), w1 = *(const f32x4*)(cw + tap * 128 + c0 + 4);
#pragma unroll
                for (int e = 0; e < 4; ++e) { xcv[e] += w0[e] * bfs2f(xv[e]); xcv[4 + e] += w1[e] * bfs2f(xv[4 + e]); }
            }
            if ((kk >> 1) == half) {
                float* d = xcw + fr * 68 + (kk & 1) * 32 + fq * 8;
                *(f32x4*)d = (f32x4){xcv[0], xcv[1], xcv[2], xcv[3]}; *(f32x4*)(d + 4) = (f32x4){xcv[4], xcv[5], xcv[6], xcv[7]};
            }
            const uint4 au = make_uint4(pack2(xcv[0], xcv[1]), pack2(xcv[2], xcv[3]), pack2(xcv[4], xcv[5]), pack2(xcv[6], xcv[7]));
            const bf16x8 af = *(const bf16x8*)&au;
#pragma unroll
            for (int ct = 0; ct < 4; ++ct) {
                const bf16x8 fa = *(const bf16x8*)(wa + (ct * 16 + fr) * 136 + c0);
                const bf16x8 fx = *(const bf16x8*)(wx + (ct * 16 + fr) * 136 + c0);
                ar[ct] = __builtin_amdgcn_mfma_f32_16x16x32_bf16(af, fa, ar[ct], 0, 0, 0);
                ax[ct] = __builtin_amdgcn_mfma_f32_16x16x32_bf16(af, fx, ax[ct], 0, 0, 0);
            }
        }
        float pa[4][4], pb[4][4];
#pragma unroll
        for (int ct = 0; ct < 4; ++ct) {
            float A[4], B[4];
#pragma unroll
            for (int j = 0; j < 4; ++j) {
                const float xc = xcw[(fq * 4 + j) * 68 + ct * 16 + fr];
                const float r = sigmoidf_(ar[ct][j] + ba[ct]);
                const float ig = sigmoidf_(ax[ct][j] + bx[ct]);
                const float av = __expf(lsl[ct] * r);
                const float mult = __builtin_amdgcn_sqrtf(fmaxf(1.0f - av * av, 0.f));
                A[j] = av; B[j] = mult * ig * xc;
            }
#pragma unroll
            for (int j = 1; j < 4; ++j) { B[j] = A[j] * B[j - 1] + B[j]; A[j] = A[j] * A[j - 1]; }
            float EA = 1.f, EB = 0.f, TA = 1.f, TB = 0.f;
#pragma unroll
            for (int g = 0; g < 4; ++g) {
                const float Ag = __shfl(A[3], fr + 16 * g), Bg = __shfl(B[3], fr + 16 * g);
                if (g < fq) { EB = Ag * EB + Bg; EA = Ag * EA; }
                TB = Ag * TB + Bg; TA = Ag * TA;
            }
#pragma unroll
            for (int j = 0; j < 4; ++j) { pa[ct][j] = A[j] * EA; pb[ct][j] = A[j] * EB + B[j]; }
            if (fq == 0) { float* ag = agg + ((par * 8 + wave) * 64 + ct * 16 + fr) * 2; ag[0] = TA; ag[1] = TB; }
        }
        __syncthreads();
#pragma unroll
        for (int ct = 0; ct < 4; ++ct) {
            float h = hstart[ct], hin = 0.f;
#pragma unroll
            for (int w = 0; w < 8; ++w) {
                const float2 ab = *(const float2*)(agg + ((par * 8 + w) * 64 + ct * 16 + fr) * 2);
                if (w == wave) hin = h;
                h = ab.x * h + ab.y;
            }
            hstart[ct] = h;
            const int C = n * 128 + half * 64 + ct * 16 + fr;
#pragma unroll
            for (int j = 0; j < 4; ++j) {
                const int tl = wave * 16 + fq * 4 + j;
                const size_t tok = (size_t)b * 4096 + t0 + tl;
                const float hs = pa[ct][j] * hin + pb[ct][j];
                const float g = bf2f(gs[tl * 72 + ct * 16 + fr]);
                p.ypre[tok * 1024 + C] = f2bf(hs * g * sigmoidf_(g));
            }
        }
        __syncthreads();
        LRU_STORE();
        __syncthreads();
        par ^= 1;
    }
#undef LRU_LOAD
#undef LRU_STORE
}

DEVI void lru_phase(const Params& p, char* smem) {
    for (int it = blockIdx.x; it < 256; it += gridDim.x) { const int pr = (it & 7) + 8 * (it >> 4), hf = (it >> 3) & 1; lru_item(p, pr * 2 + hf, smem); }
}

#define GRID_SYNC_CG() do { asm volatile("s_waitcnt vmcnt(0) lgkmcnt(0)" ::: "memory"); grid.sync(); \
    if (threadIdx.x < 64) { __builtin_amdgcn_fence(__ATOMIC_ACQUIRE, "agent"); asm volatile("s_waitcnt vmcnt(0) lgkmcnt(0)" ::: "memory"); } __syncthreads(); } while (0)
DEVI void grid_barrier(unsigned* bar, const unsigned k, const unsigned xcc, const unsigned nx, const unsigned nxcd) {
    asm volatile("s_waitcnt vmcnt(0) lgkmcnt(0)" ::: "memory");
    __syncthreads();
    if (threadIdx.x == 0) {
        const unsigned old = __hip_atomic_fetch_add(bar + 64 * (17 + xcc), 1u, __ATOMIC_RELAXED, __HIP_MEMORY_SCOPE_AGENT);
        if (old + 1 == k * nx) {
            __builtin_amdgcn_fence(__ATOMIC_RELEASE, "agent");
            asm volatile("s_waitcnt vmcnt(0) lgkmcnt(0)" ::: "memory");
            __hip_atomic_fetch_add(bar, 1u, __ATOMIC_RELAXED, __HIP_MEMORY_SCOPE_AGENT);
        }
        while (__hip_atomic_load(bar, __ATOMIC_RELAXED, __HIP_MEMORY_SCOPE_AGENT) < k * nxcd) __builtin_amdgcn_s_sleep(1);
        __builtin_amdgcn_fence(__ATOMIC_ACQUIRE, "agent");
        asm volatile("s_waitcnt vmcnt(0) lgkmcnt(0)" ::: "memory");
    }
    __syncthreads();
}
#define GRID_SYNC() do { ++bar_k; grid_barrier(p.bar, bar_k, xcc, nx, nxcd); } while (0)
__global__ void __launch_bounds__(512, 2) mega_fwd(Params p) {
    extern __shared__ __attribute__((aligned(16))) char smem[];
    cg::grid_group grid = cg::this_grid();
    unsigned bar_k = 0;
    const unsigned xcc = (unsigned)__builtin_amdgcn_s_getreg((3 << 11) | 20) & 0xFu;
    if (threadIdx.x == 0) {
        __hip_atomic_fetch_add(p.bar + 64 * (1 + xcc), 1u, __ATOMIC_RELAXED, __HIP_MEMORY_SCOPE_AGENT);
        __hip_atomic_fetch_add(p.bar + 64 * 40, 1u, __ATOMIC_RELEASE, __HIP_MEMORY_SCOPE_AGENT);
        while (__hip_atomic_load(p.bar + 64 * 40, __ATOMIC_RELAXED, __HIP_MEMORY_SCOPE_AGENT) < gridDim.x) __builtin_amdgcn_s_sleep(1);
    }
    __syncthreads();
    if (p.bar == nullptr) GRID_SYNC_CG();
    unsigned nx = 0, nxcd = 0;
    for (unsigned j = 0; j < 16; ++j) { const unsigned c = __hip_atomic_load(p.bar + 64 * (1 + j), __ATOMIC_RELAXED, __HIP_MEMORY_SCOPE_AGENT); nxcd += (c != 0u); if (j == xcc) nx = c; }
    phase_a(p, smem);
    GRID_SYNC();
    prenorm_phase(p.x, p.norm_g, p.mod, p.h);
    GRID_SYNC();
    gemm_phase(p.h, p.wt_in0, NTOK, 4096, 1024, smem, Epi1{Epi1P{p.positions, p.kmean, p.gates, p.qa}});
    GRID_SYNC();
    moba_select_phase(p, smem);
    sb_phase(p, smem);
    GRID_SYNC();
    moba_past_phase(p, smem);
    GRID_SYNC();
    moba_own_phase(p, smem);
    GRID_SYNC();
    gemm_phase(p.ypre, p.wt_out0, NTOK, 1024, 1024, smem, EpiResP<false>{p.x, p.kb  , p.mod + 2048});
    GRID_SYNC();
    prenorm_bf_phase(p.kb, p.norm_g + 1024, p.mod + 16 * 3072, p.h);
    GRID_SYNC();
    gemm_phase(p.h, p.wt_in1, NTOK, 2048, 1024, smem, Epi3P{p.xb, p.gl});
    GRID_SYNC();
    lru_phase(p, smem);
    GRID_SYNC();
    gemm_phase(p.ypre, p.wt_out1, NTOK, 1024, 1024, smem, EpiResP<true>{p.kb, p.gates  , p.mod + 16 * 3072 + 2048});
    GRID_SYNC();
    final_norm_bf_phase(p.gates, p.out, p.final_g);
}

extern "C" void kernel_launch(void* const* d_in, const int* in_sizes, int n_in, void* d_out, int out_size, void* d_ws, size_t ws_size, hipStream_t stream) {
    constexpr size_t kDynLds = 147456;
    static int grid_blocks = 0;
    if (!grid_blocks) {
        hipFuncSetAttribute((const void*)mega_fwd, hipFuncAttributeMaxDynamicSharedMemorySize, (int)kDynLds);
        int dev = 0, cus = 0, per_cu = 0;
        hipGetDevice(&dev);
        hipDeviceGetAttribute(&cus, hipDeviceAttributeMultiprocessorCount, dev);
        hipOccupancyMaxActiveBlocksPerMultiprocessor(&per_cu, mega_fwd, 512, kDynLds);
        if (per_cu < 1) per_cu = 1;
        grid_blocks = cus * 1;
    }
    Params p{};
    p.x = (const float*)d_in[0]; p.c = (const float*)d_in[1]; p.positions = (const int*)d_in[2];
    p.norm_g = (const float*)d_in[3]; p.w_mod = (const float*)d_in[4]; p.b_mod = (const float*)d_in[5];
    p.attn_w_in = (const float*)d_in[6]; p.attn_w_out = (const float*)d_in[7]; p.lru_w_in = (const float*)d_in[8];
    p.lru_conv_w = (const float*)d_in[9]; p.lru_conv_b = (const float*)d_in[10]; p.lru_w_a = (const float*)d_in[11];
    p.lru_b_a = (const float*)d_in[12]; p.lru_w_x = (const float*)d_in[13]; p.lru_b_x = (const float*)d_in[14];
    p.lru_lambda = (const float*)d_in[15]; p.lru_w_out = (const float*)d_in[16]; p.final_g = (const float*)d_in[17];
    p.out = (float*)d_out;
    char* w = (char*)d_ws; size_t off = 0;
    auto take = [&](size_t bytes) { char* r = w + off; off += (bytes + 255) & ~(size_t)255; return r; };
    p.wt_in0 = (bf16_t*)take((size_t)4096 * 1024 * 2);
    p.wt_out0 = (bf16_t*)take((size_t)1024 * 1024 * 2);
    p.wt_in1 = (bf16_t*)take((size_t)2048 * 1024 * 2);
    p.wt_out1 = (bf16_t*)take((size_t)1024 * 1024 * 2);
    p.wa_t = (bf16_t*)take((size_t)8 * 128 * 128 * 2);
    p.wx_t = (bf16_t*)take((size_t)8 * 128 * 128 * 2);
    p.mod = (float*)take((size_t)2 * 16 * 3072 * 4);
    p.kmean = (float*)take((size_t)16 * 8 * 16 * 64 * 4);
    p.h = (bf16_t*)take((size_t)NTOK * 1024 * 2);
    const size_t hd = (size_t)16 * 8 * 4096 * 64 * 2;
    p.qa = (bf16_t*)take(hd); p.ka = (bf16_t*)take(hd); p.vta = (bf16_t*)take(hd);
    p.qb = (bf16_t*)take(hd); p.kb = (bf16_t*)take(hd); p.vtb = (bf16_t*)take(hd);
    p.gates = (bf16_t*)take((size_t)NTOK * 1024 * 2);
    p.ypre = (bf16_t*)take((size_t)NTOK * 1024 * 2);
    p.bar = (unsigned*)take(16384);
    p.mcnt = (int*)take((size_t)128 * 16 * 4);
    p.mlist = (unsigned short*)take((size_t)128 * 16 * LCAP * 2);
    p.part_ml = (float*)take((size_t)128 * 4096 * 3 * 2 * 4);
    p.part_o = (bf16_t*)take((size_t)128 * 4096 * 3 * 64 * 2);
    p.xb = p.qa;
    p.gl = p.vta;
    hipMemsetAsync(p.bar, 0, 16384, stream);
    void* args[] = {&p};
    hipError_t e = hipLaunchCooperativeKernel((const void*)mega_fwd, dim3(grid_blocks), dim3(512), args, kDynLds, stream);
    if (e != hipSuccess) fprintf(stderr, "cooperative launch failed: %s (grid %d)\n", hipGetErrorString(e), grid_blocks);
}
```
